# Optimizing an MI355X kernel written in HIP

```python
import jax, jax.numpy as jnp
from jax import lax
import numpy as np

D_MODEL = 1024
BATCH = 1
SEQ = 16384
DEPTH = 4
DEC_BATCH = 32
DEC_SEQ = 16
PAST_LEN = 4096

CHUNK = 64
N_META = 16
Q_BLOCK = 128
EPS = 1e-6
F32 = jnp.float32

MLA_HEADS = 8
QK_NOPE = 64
QK_ROPE = 32
V_HEAD = 64
Q_LORA = 384
KV_LORA = 256
ROPE_THETA = 10000.0
MLA_SCALE = (QK_NOPE + QK_ROPE) ** -0.5
MLA_WIDTH = MLA_HEADS * V_HEAD

GDN_HEADS = 4
GDN_DK = 128
GDN_DV = 128
CONV_W = 4
GDN_WIDTH = GDN_HEADS * GDN_DV
GDN_QKV = GDN_HEADS * (2 * GDN_DK + GDN_DV)

MIX_WIDTH = MLA_WIDTH + GDN_WIDTH
D_FF = -(-8 * D_MODEL // (3 * 256)) * 256

OFF_KV = Q_LORA
OFF_PE = OFF_KV + KV_LORA
OFF_QKV = OFF_PE + QK_ROPE
OFF_Z = OFF_QKV + GDN_QKV
OFF_B = OFF_Z + GDN_WIDTH
OFF_A = OFF_B + GDN_HEADS
IN_WIDTH = OFF_A + GDN_HEADS
IN_OFFSETS = (OFF_KV, OFF_PE, OFF_QKV, OFF_Z, OFF_B, OFF_A)

kernel_name = 'hybrid_mla_gdn_streaming_step'


def rmsnorm(x, w):
    xf = x.astype(F32)
    y = xf * lax.rsqrt(jnp.mean(xf * xf, axis=-1, keepdims=True) + EPS)
    return (y * w.astype(F32)).astype(x.dtype)


def l2norm(x):
    xf = x.astype(F32)
    return xf * lax.rsqrt(jnp.sum(xf * xf, axis=-1, keepdims=True) + EPS)


def rope(x, pos):
    half = QK_ROPE // 2
    inv = ROPE_THETA ** (-jnp.arange(half, dtype=F32) / half)
    ang = pos[:, None] * inv[None, :]
    c = jnp.cos(ang)[None, :, None, :]
    s = jnp.sin(ang)[None, :, None, :]
    xf = x.astype(F32)
    x1, x2 = xf[..., :half], xf[..., half:]
    return jnp.concatenate([x1 * c - x2 * s, x1 * s + x2 * c], axis=-1).astype(x.dtype)


def causal_conv(xpad, w):
    L = xpad.shape[1] - (CONV_W - 1)
    y = xpad[:, 0:L] * w[0]
    for i in range(1, CONV_W):
        y = y + xpad[:, i:i + L] * w[i]
    return jax.nn.silu(y)


def mixer_front(x, pre_w, w_in_l, q_norm_l, kv_norm_l, w_uq_l):
    B, L, _ = x.shape
    xn = rmsnorm(x, pre_w)
    c_q, c_kv, k_rope, qkv, z, b, a = jnp.split(xn @ w_in_l, IN_OFFSETS, axis=-1)
    q = (rmsnorm(c_q, q_norm_l) @ w_uq_l).reshape(B, L, MLA_HEADS, QK_NOPE + QK_ROPE)
    return q, rmsnorm(c_kv, kv_norm_l), k_rope, qkv, z, b, a


def mla_prompt(q, c_kv, k_rope, w_uk_l, w_uv_l, pos, cid):
    B, L = q.shape[:2]
    q_pe = rope(q[..., QK_NOPE:], pos)
    k_pe = rope(k_rope[:, :, None, :], pos)
    k_nope = jnp.einsum('blc,chd->blhd', c_kv, w_uk_l)
    v = jnp.einsum('blc,chd->blhd', c_kv, w_uv_l)
    qf = jnp.concatenate([q[..., :QK_NOPE], q_pe], axis=-1)
    kf = jnp.concatenate([k_nope, jnp.broadcast_to(k_pe, (B, L, MLA_HEADS, QK_ROPE))], axis=-1)
    s_m = jnp.einsum('bqhd,bkhd->bhqk', qf[:, :N_META], kf[:, :N_META]).astype(F32) * MLA_SCALE
    o_m = jnp.einsum('bhqk,bkhd->bqhd', jax.nn.softmax(s_m, axis=-1).astype(v.dtype), v[:, :N_META])
    nq = (L - N_META) // Q_BLOCK
    qb = qf[:, N_META:].reshape(B, nq, Q_BLOCK, MLA_HEADS, QK_NOPE + QK_ROPE).transpose(1, 0, 2, 3, 4)
    qcid = cid[N_META:].reshape(nq, Q_BLOCK)

    def attend(args):
        qblk, qc = args
        s = jnp.einsum('bqhd,bkhd->bhqk', qblk, kf).astype(F32) * MLA_SCALE
        s = jnp.where((cid[None, :] <= qc[:, None])[None, None], s, -jnp.inf)
        p = jax.nn.softmax(s, axis=-1).astype(v.dtype)
        return jnp.einsum('bhqk,bkhd->bqhd', p, v)

    o_f = lax.map(attend, (qb, qcid))
    o_f = o_f.transpose(1, 0, 2, 3, 4).reshape(B, L - N_META, MLA_HEADS, V_HEAD)
    return jnp.concatenate([o_m, o_f], axis=1), k_pe[:, :, 0]


def mla_sample(q, c_kv, k_rope, cache_lat, cache_pe, w_uk_l, w_uv_l, pos):
    q_pe = rope(q[..., QK_NOPE:], pos)
    k_pe = rope(k_rope[:, :, None, :], pos)[:, :, 0]
    cache_lat = cache_lat.astype(c_kv.dtype)
    cache_pe = cache_pe.astype(k_pe.dtype)
    q_lat = jnp.einsum('bthd,chd->bthc', q[..., :QK_NOPE], w_uk_l)
    s_past = jnp.einsum('bthc,bsc->bhts', q_lat, cache_lat) + jnp.einsum('bthr,bsr->bhts', q_pe, cache_pe)
    s_new = jnp.einsum('bthc,bsc->bhts', q_lat, c_kv) + jnp.einsum('bthr,bsr->bhts', q_pe, k_pe)
    s = jnp.concatenate([s_past, s_new], axis=-1).astype(F32) * MLA_SCALE
    p = jax.nn.softmax(s, axis=-1).astype(c_kv.dtype)
    P = cache_lat.shape[1]
    o_lat = jnp.einsum('bhts,bsc->bthc', p[..., :P], cache_lat) + jnp.einsum('bhts,bsc->bthc', p[..., P:], c_kv)
    return jnp.einsum('bthc,chd->bthd', o_lat, w_uv_l), k_pe


def gdn_prepare(u, b, a, a_log_l, dt_bias_l):
    B, L, _ = u.shape
    q, k, v = jnp.split(u.astype(F32), [GDN_HEADS * GDN_DK, 2 * GDN_HEADS * GDN_DK], axis=-1)
    q = l2norm(q.reshape(B, L, GDN_HEADS, GDN_DK)) * (GDN_DK ** -0.5)
    k = l2norm(k.reshape(B, L, GDN_HEADS, GDN_DK))
    v = v.reshape(B, L, GDN_HEADS, GDN_DV)
    beta = jax.nn.sigmoid(b.astype(F32))
    g = -jnp.exp(a_log_l.astype(F32)) * jax.nn.softplus(a.astype(F32) + dt_bias_l.astype(F32))
    return q, k, v, g, beta


def gdn_chunked(q, k, v, g, beta, s0, chunk):
    B, L, H, DK = q.shape
    N = L // chunk
    blk = lambda t: t.reshape((B, N, chunk) + t.shape[2:]).transpose((1, 0, 3, 2) + tuple(range(4, t.ndim + 1)))
    q, k, v, g, beta = blk(q), blk(k), blk(v), blk(g), blk(beta)
    gc = jnp.cumsum(g, axis=-1)
    tri = jnp.tril(jnp.ones((chunk, chunk), bool))
    strict = jnp.tril(jnp.ones((chunk, chunk), bool), k=-1)
    decay = jnp.exp(jnp.where(tri, gc[..., :, None] - gc[..., None, :], -jnp.inf))
    kk = jnp.einsum('nbhid,nbhjd->nbhij', k, k)
    m = jnp.where(strict, beta[..., :, None] * kk * decay, 0.0)
    eye = jnp.eye(chunk, dtype=F32)
    t_mat = lax.linalg.triangular_solve(eye + m, jnp.broadcast_to(eye, m.shape), left_side=True, lower=True)
    u = jnp.einsum('nbhij,nbhjd->nbhid', t_mat, v * beta[..., None])
    w = jnp.einsum('nbhij,nbhjd->nbhid', t_mat, k * (beta * jnp.exp(gc))[..., None])
    qk = jnp.einsum('nbhid,nbhjd->nbhij', q, k) * decay
    qg = q * jnp.exp(gc)[..., None]
    kd = k * jnp.exp(gc[..., -1:] - gc)[..., None]
    glast = jnp.exp(gc[..., -1])

    def step(S, xs):
        u_c, w_c, qk_c, qg_c, kd_c, gl_c = xs
        v_new = u_c - jnp.einsum('bhcd,bhde->bhce', w_c, S)
        o = jnp.einsum('bhcd,bhde->bhce', qg_c, S) + jnp.einsum('bhij,bhje->bhie', qk_c, v_new)
        S = S * gl_c[..., None, None] + jnp.einsum('bhcd,bhce->bhde', kd_c, v_new)
        return S, o

    S, o = lax.scan(step, s0, (u, w, qk, qg, kd, glast))
    o = o.transpose(1, 0, 3, 2, 4).reshape(B, L, H, o.shape[-1])
    return o, S


def gdn_output(o, z, norm_l):
    B, L = o.shape[:2]
    zf = z.astype(F32).reshape(B, L, GDN_HEADS, GDN_DV)
    return (rmsnorm(o, norm_l) * jax.nn.silu(zf)).reshape(B, L, GDN_WIDTH)


def mixer_back(x, o_mla, o_gdn, w_o_l, post_mix_l, pre_ffn_l, w_gate_l, w_up_l, w_down_l, post_ffn_l):
    B, L, _ = x.shape
    mix = jnp.concatenate([o_mla.reshape(B, L, MLA_WIDTH).astype(x.dtype), o_gdn.astype(x.dtype)], axis=-1)
    h = x + rmsnorm(mix @ w_o_l, post_mix_l)
    hn = rmsnorm(h, pre_ffn_l)
    f = (jax.nn.silu(hn @ w_gate_l) * (hn @ w_up_l)) @ w_down_l
    return h + rmsnorm(f, post_ffn_l)


def setup_inputs(seed: int = 0) -> dict:
    key = jax.random.key(seed)
    k = jax.random.split(key, 32)
    nrm = lambda i, shape, scale: jax.random.normal(k[i], shape, F32) * scale
    gain = lambda i, shape: 1.0 + 0.02 * jax.random.normal(k[i], shape, F32)
    dt = jnp.exp(jax.random.uniform(k[14], (DEPTH, GDN_HEADS), F32, np.log(1e-3), np.log(1e-1)))
    return {
        'x_prompt': nrm(0, (BATCH, SEQ, D_MODEL), 1.0),
        'x_sample': nrm(1, (DEC_BATCH, DEC_SEQ, D_MODEL), 1.0),
        'cache_mla_latent': nrm(2, (DEPTH, DEC_BATCH, PAST_LEN, KV_LORA), 1.0),
        'cache_mla_krope': nrm(3, (DEPTH, DEC_BATCH, PAST_LEN, QK_ROPE), 1.0),
        'state_gdn': nrm(4, (DEPTH, DEC_BATCH, GDN_HEADS, GDN_DK, GDN_DV), 0.1),
        'state_gdn_conv': nrm(5, (DEPTH, DEC_BATCH, CONV_W - 1, GDN_QKV), 1.0),
        'meta_tokens': nrm(6, (N_META, D_MODEL), 1.0),
        'pre_mix_norm': gain(7, (DEPTH, D_MODEL)),
        'w_in': nrm(8, (DEPTH, D_MODEL, IN_WIDTH), D_MODEL ** -0.5),
        'q_norm': gain(9, (DEPTH, Q_LORA)),
        'kv_norm': gain(10, (DEPTH, KV_LORA)),
        'w_uq': nrm(11, (DEPTH, Q_LORA, MLA_HEADS * (QK_NOPE + QK_ROPE)), Q_LORA ** -0.5),
        'w_uk': nrm(12, (DEPTH, KV_LORA, MLA_HEADS, QK_NOPE), KV_LORA ** -0.5),
        'w_uv': nrm(13, (DEPTH, KV_LORA, MLA_HEADS, V_HEAD), KV_LORA ** -0.5),
        'conv_w': nrm(15, (DEPTH, CONV_W, GDN_QKV), CONV_W ** -0.5),
        'a_log': jnp.log(jax.random.uniform(k[16], (DEPTH, GDN_HEADS), F32, 1.0, 16.0)),
        'dt_bias': jnp.log(jnp.expm1(dt)),
        'gdn_norm': gain(17, (DEPTH, GDN_DV)),
        'w_o': nrm(18, (DEPTH, MIX_WIDTH, D_MODEL), MIX_WIDTH ** -0.5),
        'post_mix_norm': gain(19, (DEPTH, D_MODEL)),
        'pre_ffn_norm': gain(20, (DEPTH, D_MODEL)),
        'w_gate': nrm(21, (DEPTH, D_MODEL, D_FF), D_MODEL ** -0.5),
        'w_up': nrm(22, (DEPTH, D_MODEL, D_FF), D_MODEL ** -0.5),
        'w_down': nrm(23, (DEPTH, D_FF, D_MODEL), D_FF ** -0.5),
        'post_ffn_norm': gain(24, (DEPTH, D_MODEL)),
    }


def reference(x_prompt, x_sample, cache_mla_latent, cache_mla_krope, state_gdn, state_gdn_conv,
              meta_tokens, pre_mix_norm, w_in, q_norm, kv_norm, w_uq, w_uk, w_uv,
              conv_w, a_log, dt_bias, gdn_norm, w_o, post_mix_norm,
              pre_ffn_norm, w_gate, w_up, w_down, post_ffn_norm):
    B = x_prompt.shape[0]
    T = x_sample.shape[1]
    xp = jnp.concatenate([jnp.broadcast_to(meta_tokens.astype(x_prompt.dtype)[None], (B, N_META, D_MODEL)), x_prompt], axis=1)
    L = xp.shape[1]
    idx = jnp.arange(L)
    cid = jnp.where(idx < N_META, -1, (idx - N_META) // CHUNK)
    pos_p = idx.astype(F32)
    pos_s = (N_META + PAST_LEN + jnp.arange(T)).astype(F32)
    gpad = (-N_META) % CHUNK
    padf = lambda t: jnp.pad(t, ((0, 0), (gpad, 0)) + ((0, 0),) * (t.ndim - 2))
    xs = x_sample
    p_lat, p_pe, p_gdn, p_conv = [], [], [], []
    s_lat, s_pe, s_gdn, s_conv = [], [], [], []
    for l in range(DEPTH):
        q, ckv, kr, qkv, z, b, a = mixer_front(xp, pre_mix_norm[l], w_in[l], q_norm[l], kv_norm[l], w_uq[l])
        o_mla, kpe = mla_prompt(q, ckv, kr, w_uk[l], w_uv[l], pos_p, cid)
        qkv_pad = jnp.pad(qkv, ((0, 0), (CONV_W - 1, 0), (0, 0)))
        qg, kg, vg, gg, bg = gdn_prepare(causal_conv(qkv_pad, conv_w[l]), b, a, a_log[l], dt_bias[l])
        o_g, s_fin = gdn_chunked(padf(qg), padf(kg), padf(vg), padf(gg), padf(bg),
                                 jnp.zeros((B, GDN_HEADS, GDN_DK, GDN_DV), F32), CHUNK)
        o_g = gdn_output(o_g[:, gpad:], z, gdn_norm[l])
        xp = mixer_back(xp, o_mla, o_g, w_o[l], post_mix_norm[l], pre_ffn_norm[l], w_gate[l], w_up[l], w_down[l], post_ffn_norm[l])
        p_lat.append(ckv)
        p_pe.append(kpe)
        p_gdn.append(s_fin)
        p_conv.append(qkv_pad[:, -(CONV_W - 1):])
        q, ckv, kr, qkv, z, b, a = mixer_front(xs, pre_mix_norm[l], w_in[l], q_norm[l], kv_norm[l], w_uq[l])
        o_mla, kpe = mla_sample(q, ckv, kr, cache_mla_latent[l], cache_mla_krope[l], w_uk[l], w_uv[l], pos_s)
        hist = jnp.concatenate([state_gdn_conv[l].astype(qkv.dtype), qkv], axis=1)
        qg, kg, vg, gg, bg = gdn_prepare(causal_conv(hist, conv_w[l]), b, a, a_log[l], dt_bias[l])
        o_g, s_new = gdn_chunked(qg, kg, vg, gg, bg, state_gdn[l].astype(F32), T)
        o_g = gdn_output(o_g, z, gdn_norm[l])
        xs = mixer_back(xs, o_mla, o_g, w_o[l], post_mix_norm[l], pre_ffn_norm[l], w_gate[l], w_up[l], w_down[l], post_ffn_norm[l])
        s_lat.append(ckv)
        s_pe.append(kpe)
        s_gdn.append(s_new)
        s_conv.append(hist[:, -(CONV_W - 1):])
    y_prompt = xp[:, N_META:]
    y_sample = xs
    new_prompt_latent = jnp.stack(p_lat)
    new_prompt_krope = jnp.stack(p_pe)
    new_prompt_gdn = jnp.stack(p_gdn)
    new_prompt_conv = jnp.stack(p_conv)
    new_sample_latent = jnp.stack(s_lat)
    new_sample_krope = jnp.stack(s_pe)
    new_sample_gdn = jnp.stack(s_gdn)
    new_sample_conv = jnp.stack(s_conv)
    return (y_prompt, y_sample, new_prompt_latent, new_prompt_krope, new_prompt_gdn, new_prompt_conv,
            new_sample_latent, new_sample_krope, new_sample_gdn, new_sample_conv)
```

```cpp
#include <hip/hip_runtime.h>
#include <hip/hip_cooperative_groups.h>
#include <cstdio>
namespace cg = cooperative_groups;

#ifndef ONE_LAUNCH
#define ONE_LAUNCH 1
#endif
#ifndef PROBE_MASK
#define PROBE_MASK 0
#endif
#ifndef PROBE_FLAGS
#define PROBE_FLAGS 0
#endif

#define DI __device__ __forceinline__
typedef unsigned short ushort_t;
typedef short bf16x8 __attribute__((ext_vector_type(8)));
typedef short s16x4 __attribute__((ext_vector_type(4)));
typedef float f32x16 __attribute__((ext_vector_type(16)));
typedef float f32x2v __attribute__((ext_vector_type(2)));
typedef __bf16 bf16x2v __attribute__((ext_vector_type(2)));
typedef unsigned u32x4 __attribute__((ext_vector_type(4)));
#define MFMA(a, b, c) __builtin_amdgcn_mfma_f32_32x32x16_bf16((a), (b), (c), 0, 0, 0)

constexpr int DM = 1024, LTOK = 16400, DEPTH = 4, DECB = 32, DECT = 16, PAST = 4096;
constexpr int POFF = 48, PEND = 16448, SOFF = 16512, MTOT = 17024;
constexpr int NCH = 257, NITEM = NCH * 4;
constexpr int INP = 2816, DFF = 2816;
constexpr int OFF_KV = 384, OFF_PE = 640, OFF_QKV = 672, OFF_Z = 2208, OFF_B = 2720, OFF_A = 2724, INW = 2728;
constexpr float EPS = 1e-6f;
constexpr float QSCALE = 0.10206207261596577f * 1.4426950408889634f;
constexpr int SMEM_BYTES = 75776 + 16;

constexpr size_t OUT_YP = 0;
constexpr size_t OUT_YS = OUT_YP + (size_t)16384 * 1024;
constexpr size_t OUT_PLAT = OUT_YS + (size_t)512 * 1024;
constexpr size_t OUT_PPE = OUT_PLAT + (size_t)4 * LTOK * 256;
constexpr size_t OUT_PGDN = OUT_PPE + (size_t)4 * LTOK * 32;
constexpr size_t OUT_PCONV = OUT_PGDN + (size_t)4 * 4 * 128 * 128;
constexpr size_t OUT_SLAT = OUT_PCONV + (size_t)4 * 3 * 1536;
constexpr size_t OUT_SPE = OUT_SLAT + (size_t)4 * 32 * 16 * 256;
constexpr size_t OUT_SGDN = OUT_SPE + (size_t)4 * 32 * 16 * 32;
constexpr size_t OUT_SCONV = OUT_SGDN + (size_t)4 * 32 * 4 * 128 * 128;

constexpr size_t al256(size_t x) { return (x + 255) & ~(size_t)255; }
constexpr size_t E_WT_IN = 0;
constexpr size_t E_WT_UQ = E_WT_IN + (size_t)2816 * 1024;
constexpr size_t E_WUQ_BF = E_WT_UQ + (size_t)768 * 384;
constexpr size_t E_WT_UKV = E_WUQ_BF + (size_t)384 * 768;
constexpr size_t E_WUK_BF = E_WT_UKV + (size_t)1024 * 256;
constexpr size_t E_WUV_BF = E_WUK_BF + (size_t)256 * 512;
constexpr size_t E_WABS = E_WUV_BF + (size_t)256 * 512;
constexpr size_t E_WT_O = E_WABS + (size_t)2048 * 384;
constexpr size_t E_WT_OS = E_WT_O + (size_t)1024 * 1024;
constexpr size_t E_WT_GU = E_WT_OS + (size_t)1024 * 2560;
constexpr size_t E_WT_DOWN = E_WT_GU + (size_t)5632 * 1024;
constexpr size_t E_WL = E_WT_DOWN + (size_t)1024 * 2816;

constexpr size_t O_CTR = 0;
constexpr size_t O_BAR = 1024;
constexpr size_t O_W = 16384;
constexpr size_t O_X = al256(O_W + 4 * E_WL * 2);
constexpr size_t O_XN = al256(O_X + (size_t)MTOT * 1024 * 4);
constexpr size_t O_PROJ = al256(O_XN + (size_t)MTOT * 1024 * 2);
constexpr size_t O_CQN = al256(O_PROJ + (size_t)MTOT * INP * 4);
constexpr size_t O_CKV = al256(O_CQN + (size_t)MTOT * 384 * 2);
constexpr size_t O_KPE = al256(O_CKV + (size_t)MTOT * 256 * 2);
constexpr size_t O_QF = al256(O_KPE + (size_t)MTOT * 32 * 2);
constexpr size_t O_QL = al256(O_QF + (size_t)MTOT * 768 * 2);
constexpr size_t O_KF = al256(O_QL + (size_t)512 * 2048 * 2);
constexpr size_t O_VV = al256(O_KF + (size_t)SOFF * 768 * 2);
constexpr size_t O_GQ = al256(O_VV + (size_t)SOFF * 512 * 2);
constexpr size_t O_GK = al256(O_GQ + (size_t)MTOT * 512 * 4);
constexpr size_t O_GV = al256(O_GK + (size_t)MTOT * 512 * 4);
constexpr size_t O_GB = al256(O_GV + (size_t)MTOT * 512 * 4);
constexpr size_t O_GG = al256(O_GB + (size_t)MTOT * 4 * 4);
constexpr size_t O_UT = al256(O_GG + (size_t)MTOT * 4 * 4);
constexpr size_t O_WN = al256(O_UT + (size_t)NITEM * 8192 * 4);
constexpr size_t O_QG = al256(O_WN + (size_t)NITEM * 8192 * 2);
constexpr size_t O_KDT = al256(O_QG + (size_t)NITEM * 8192 * 2);
constexpr size_t O_QKM = al256(O_KDT + (size_t)NITEM * 8192 * 2);
constexpr size_t O_GL = al256(O_QKM + (size_t)NITEM * 4096 * 2);
constexpr size_t O_OG = al256(O_GL + (size_t)NITEM * 4);
constexpr size_t O_MIX = al256(O_OG + (size_t)MTOT * 512 * 4);
constexpr size_t O_MIXS = al256(O_MIX + (size_t)MTOT * 1024 * 2);
constexpr size_t O_PO = al256(O_MIXS + (size_t)512 * 2560 * 2);
constexpr size_t O_PML = al256(O_PO + (size_t)32 * 8 * 128 * 256 * 4);
constexpr size_t O_OMIX = al256(O_PML + (size_t)32 * 8 * 128 * 2 * 4);
constexpr size_t O_ACT = al256(O_OMIX + (size_t)MTOT * 1024 * 4);
constexpr size_t O_X2 = al256(O_ACT + (size_t)MTOT * DFF * 2);
constexpr size_t O_AN = al256(O_X2 + (size_t)MTOT * 1024 * 4);
constexpr size_t O_BN = al256(O_AN + (size_t)NITEM * 16384 * 2);
constexpr size_t O_SPK = al256(O_BN + (size_t)NITEM * 16384 * 4);
constexpr size_t O_END = al256(O_SPK + (size_t)NITEM * 32768);

struct Params {
  const float *x_prompt, *x_sample, *cache_lat, *cache_pe, *state_gdn, *state_conv, *meta, *pre_mix, *w_in, *q_norm,
      *kv_norm, *w_uq, *w_uk, *w_uv, *conv_w, *a_log, *dt_bias, *gdn_norm, *w_o, *post_mix, *pre_ffn, *w_gate, *w_up,
      *w_down, *post_ffn;
  float* out;
  char* ws;
};

DI unsigned pk2(float a, float b) { f32x2v f = {a, b}; bf16x2v r = __builtin_convertvector(f, bf16x2v); return __builtin_bit_cast(unsigned, r); }
DI ushort_t f2bf(float x) { return (ushort_t)(pk2(x, 0.f) & 0xffffu); }
DI float bf2f(ushort_t u) { return __uint_as_float(((unsigned)u) << 16); }
DI int crow(int reg, int h) { return (reg & 3) + 8 * (reg >> 2) + 4 * h; }
DI f32x16 zero16() { f32x16 z;
#pragma unroll
  for (int i = 0; i < 16; ++i) z[i] = 0.f; return z; }
template <int S> DI bf16x8 pack8(const f32x16& x) {
  u32x4 p;
  p[0] = pk2(x[8 * S + 0], x[8 * S + 1]); p[1] = pk2(x[8 * S + 2], x[8 * S + 3]);
  p[2] = pk2(x[8 * S + 4], x[8 * S + 5]); p[3] = pk2(x[8 * S + 6], x[8 * S + 7]);
  return __builtin_bit_cast(bf16x8, p);
}
DI float wave_sum(float v) {
#pragma unroll
  for (int d = 32; d >= 1; d >>= 1) v += __shfl_xor(v, d, 64);
  return v;
}
DI float swap_max(float m) { auto rr = __builtin_amdgcn_permlane32_swap(__float_as_uint(m), __float_as_uint(m), false, false); return fmaxf(__uint_as_float(rr[0]), __uint_as_float(rr[1])); }
DI float swap_sum(float m) { auto rr = __builtin_amdgcn_permlane32_swap(__float_as_uint(m), __float_as_uint(m), false, false); return __uint_as_float(rr[0]) + __uint_as_float(rr[1]); }
typedef short v4i16_t __attribute__((ext_vector_type(4)));
DI s16x4 vtr(const ushort_t* p) { return __builtin_bit_cast(s16x4, __builtin_amdgcn_ds_read_tr16_b64_v4i16((__attribute__((address_space(3))) v4i16_t*)p)); }
DI bf16x8 cat8(s16x4 lo, s16x4 hi) { return __builtin_shufflevector(lo, hi, 0, 1, 2, 3, 4, 5, 6, 7); }
DI bf16x8 fragP(const ushort_t* base, int h) { s16x4 lo = *(const s16x4*)(base + 4 * h); s16x4 hi = *(const s16x4*)(base + 8 + 4 * h); return cat8(lo, hi); }
DI unsigned xcc_id_early() { return (unsigned)__builtin_amdgcn_s_getreg((3 << 11) | 20) & 0xFu; }
DI int get_tid() { int t = threadIdx.x; asm volatile("" : "+v"(t)); return t; }
DI float siluf(float x) { return x * __builtin_amdgcn_rcpf(1.f + __expf(-x)); }
DI float row_pos(int row) { return row < SOFF ? (float)(row - POFF) : (float)(16 + PAST + ((row - SOFF) & 15)); }
DI bool row_valid(int row) { return row >= SOFF || (row >= POFF && row < PEND); }
DI float rope_inv(int j) { return exp2f(-(float)j * (13.287712379549449f / 16.f)); }

constexpr int GP = 72;
template <class Epi>
DI void gemm_tile(const ushort_t* __restrict__ A, int lda, const ushort_t* __restrict__ Wt, int ldb, int K, int m0, int n0,
                  char* smem, Epi epi) {
  ushort_t* L0 = (ushort_t*)smem;
  ushort_t* L1 = L0 + 256 * GP;
  const int tid = get_tid(), lane = tid & 63, wave = tid >> 6, r = lane & 31, h = lane >> 5;
  const int wm = wave >> 1, wn = wave & 1;
  const int lrow = tid >> 3, lcol = (tid & 7) * 8;
  const ushort_t* Ag = A + (size_t)(m0 + lrow) * lda + lcol;
  const ushort_t* Bg = Wt + (size_t)(n0 + lrow) * ldb + lcol;
  const size_t a32 = (size_t)32 * lda, b32 = (size_t)32 * ldb;
  u32x4 pa0, pa1, pa2, pa3, pb0, pb1, pb2, pb3;
  u32x4 qa0, qa1, qa2, qa3, qb0, qb1, qb2, qb3;
#define G_LOAD0(kk) { pa0 = *(const u32x4*)(Ag + (kk)); pa1 = *(const u32x4*)(Ag + a32 + (kk)); pa2 = *(const u32x4*)(Ag + 2 * a32 + (kk)); pa3 = *(const u32x4*)(Ag + 3 * a32 + (kk)); \
                      pb0 = *(const u32x4*)(Bg + (kk)); pb1 = *(const u32x4*)(Bg + b32 + (kk)); pb2 = *(const u32x4*)(Bg + 2 * b32 + (kk)); pb3 = *(const u32x4*)(Bg + 3 * b32 + (kk)); }
#define G_LOAD1(kk) { qa0 = *(const u32x4*)(Ag + (kk)); qa1 = *(const u32x4*)(Ag + a32 + (kk)); qa2 = *(const u32x4*)(Ag + 2 * a32 + (kk)); qa3 = *(const u32x4*)(Ag + 3 * a32 + (kk)); \
                      qb0 = *(const u32x4*)(Bg + (kk)); qb1 = *(const u32x4*)(Bg + b32 + (kk)); qb2 = *(const u32x4*)(Bg + 2 * b32 + (kk)); qb3 = *(const u32x4*)(Bg + 3 * b32 + (kk)); }
#define L_STORE0(L) { ushort_t* la = (L) + lrow * GP + lcol; ushort_t* lb = la + 128 * GP; \
                      *(u32x4*)(la) = pa0; *(u32x4*)(la + 32 * GP) = pa1; *(u32x4*)(la + 64 * GP) = pa2; *(u32x4*)(la + 96 * GP) = pa3; \
                      *(u32x4*)(lb) = pb0; *(u32x4*)(lb + 32 * GP) = pb1; *(u32x4*)(lb + 64 * GP) = pb2; *(u32x4*)(lb + 96 * GP) = pb3; }
#define L_STORE1(L) { ushort_t* la = (L) + lrow * GP + lcol; ushort_t* lb = la + 128 * GP; \
                      *(u32x4*)(la) = qa0; *(u32x4*)(la + 32 * GP) = qa1; *(u32x4*)(la + 64 * GP) = qa2; *(u32x4*)(la + 96 * GP) = qa3; \
                      *(u32x4*)(lb) = qb0; *(u32x4*)(lb + 32 * GP) = qb1; *(u32x4*)(lb + 64 * GP) = qb2; *(u32x4*)(lb + 96 * GP) = qb3; }
#define G_COMPUTE(L) { const ushort_t* As = (L); const ushort_t* Bs = (L) + 128 * GP; \
    _Pragma("unroll") for (int ks = 0; ks < 4; ++ks) { \
      const bf16x8 af0 = *(const bf16x8*)(As + (64 * wm + r) * GP + ks * 16 + h * 8); \
      const bf16x8 af1 = *(const bf16x8*)(As + (64 * wm + 32 + r) * GP + ks * 16 + h * 8); \
      const bf16x8 bf0 = *(const bf16x8*)(Bs + (64 * wn + r) * GP + ks * 16 + h * 8); \
      const bf16x8 bf1 = *(const bf16x8*)(Bs + (64 * wn + 32 + r) * GP + ks * 16 + h * 8); \
      acc00 = MFMA(bf0, af0, acc00); acc01 = MFMA(bf1, af0, acc01); acc10 = MFMA(bf0, af1, acc10); acc11 = MFMA(bf1, af1, acc11); } }
  f32x16 acc00 = zero16(), acc01 = zero16(), acc10 = zero16(), acc11 = zero16();
  __syncthreads();
  G_LOAD0(0);
  if (K > 64) G_LOAD1(64);
  L_STORE0(L0);
  if (K > 128) G_LOAD0(128);
  __syncthreads();
  for (int k0 = 0; k0 < K; k0 += 128) {
    G_COMPUTE(L0);
    if (k0 + 64 < K) {
      L_STORE1(L1);
      if (k0 + 192 < K) G_LOAD1(k0 + 192);
      __syncthreads();
      G_COMPUTE(L1);
      if (k0 + 128 < K) {
        L_STORE0(L0);
        if (k0 + 256 < K) G_LOAD0(k0 + 256);
      }
      __syncthreads();
    }
  }
#undef G_LOAD0
#undef G_LOAD1
#undef L_STORE0
#undef L_STORE1
#undef G_COMPUTE
  epi(m0 + 64 * wm + r, n0 + 64 * wn, acc00, acc01, h);
  epi(m0 + 64 * wm + 32 + r, n0 + 64 * wn, acc10, acc11, h);
}

template <class Epi>
DI void gemm_tile_w(const ushort_t* __restrict__ A, int lda, const ushort_t* __restrict__ Wt, int ldb, int K, int m0, int n0,
                    char* smem, Epi epi) {
  ushort_t* As = (ushort_t*)smem;
  ushort_t* Bs = As + 128 * GP;
  const int tid = get_tid(), lane = tid & 63, wave = tid >> 6, r = lane & 31, h = lane >> 5;
  const int wm = wave >> 1, wn = wave & 1;
  const int lrow = tid >> 3, lcol = (tid & 7) * 8;
  const ushort_t* Ag = A + (size_t)(m0 + lrow) * lda + lcol;
  const ushort_t* Bg = Wt + (size_t)(n0 + lrow) * ldb + lcol;
  const size_t a32 = (size_t)32 * lda, b32 = (size_t)32 * ldb;
  u32x4 ra[4], rb[8];
#pragma unroll
  for (int i = 0; i < 4; ++i) ra[i] = *(const u32x4*)(Ag + i * a32);
#pragma unroll
  for (int i = 0; i < 8; ++i) rb[i] = *(const u32x4*)(Bg + i * b32);
  f32x16 acc[2][4];
#pragma unroll
  for (int mi = 0; mi < 2; ++mi)
#pragma unroll
    for (int ni = 0; ni < 4; ++ni) acc[mi][ni] = zero16();
  for (int k0 = 0; k0 < K; k0 += 64) {
    __syncthreads();
#pragma unroll
    for (int i = 0; i < 4; ++i) *(u32x4*)(As + (lrow + 32 * i) * GP + lcol) = ra[i];
#pragma unroll
    for (int i = 0; i < 8; ++i) *(u32x4*)(Bs + (lrow + 32 * i) * GP + lcol) = rb[i];
    __syncthreads();
    if (k0 + 64 < K) {
#pragma unroll
      for (int i = 0; i < 4; ++i) ra[i] = *(const u32x4*)(Ag + i * a32 + k0 + 64);
#pragma unroll
      for (int i = 0; i < 8; ++i) rb[i] = *(const u32x4*)(Bg + i * b32 + k0 + 64);
    }
#pragma unroll
    for (int ks = 0; ks < 4; ++ks) {
      bf16x8 af[2], bfv[4];
#pragma unroll
      for (int mi = 0; mi < 2; ++mi) af[mi] = *(const bf16x8*)(As + (64 * wm + 32 * mi + r) * GP + ks * 16 + h * 8);
#pragma unroll
      for (int ni = 0; ni < 4; ++ni) bfv[ni] = *(const bf16x8*)(Bs + (128 * wn + 32 * ni + r) * GP + ks * 16 + h * 8);
#pragma unroll
      for (int mi = 0; mi < 2; ++mi)
#pragma unroll
        for (int ni = 0; ni < 4; ++ni) acc[mi][ni] = MFMA(bfv[ni], af[mi], acc[mi][ni]);
    }
  }
#pragma unroll
  for (int mi = 0; mi < 2; ++mi) {
    epi(m0 + 64 * wm + 32 * mi + r, n0 + 128 * wn, acc[mi][0], acc[mi][1], h);
    epi(m0 + 64 * wm + 32 * mi + r, n0 + 128 * wn + 64, acc[mi][2], acc[mi][3], h);
  }
}

struct EpiF32 {
  float* C; int ldc;
  DI void operator()(int m, int nb, const f32x16& a0, const f32x16& a1, int h) const {
#pragma unroll
    for (int g = 0; g < 4; ++g) {
      *(float4*)(C + (size_t)m * ldc + nb + 8 * g + 4 * h) = make_float4(a0[4 * g], a0[4 * g + 1], a0[4 * g + 2], a0[4 * g + 3]);
      *(float4*)(C + (size_t)m * ldc + nb + 32 + 8 * g + 4 * h) = make_float4(a1[4 * g], a1[4 * g + 1], a1[4 * g + 2], a1[4 * g + 3]);
    }
  }
};
struct EpiBF16 {
  ushort_t* C; int ldc; float scale;
  DI void operator()(int m, int nb, const f32x16& a0, const f32x16& a1, int h) const {
#pragma unroll
    for (int g = 0; g < 4; ++g) {
      *(uint2*)(C + (size_t)m * ldc + nb + 8 * g + 4 * h) = make_uint2(pk2(a0[4 * g] * scale, a0[4 * g + 1] * scale), pk2(a0[4 * g + 2] * scale, a0[4 * g + 3] * scale));
      *(uint2*)(C + (size_t)m * ldc + nb + 32 + 8 * g + 4 * h) = make_uint2(pk2(a1[4 * g] * scale, a1[4 * g + 1] * scale), pk2(a1[4 * g + 2] * scale, a1[4 * g + 3] * scale));
    }
  }
};
struct EpiQ {
  ushort_t* QF;
  DI void one(int m, int nb, f32x16 a, int h) const {
    if ((nb % 96) == 64) {
      const float pos = row_pos(m);
#pragma unroll
      for (int i = 0; i < 8; ++i) {
        const int j = crow(i, h);
        float sn, cs; sincosf(pos * rope_inv(j), &sn, &cs);
        const float x1 = a[i], x2 = a[i + 8];
        a[i] = x1 * cs - x2 * sn; a[i + 8] = x1 * sn + x2 * cs;
      }
    }
#pragma unroll
    for (int g = 0; g < 4; ++g)
      *(uint2*)(QF + (size_t)m * 768 + nb + 8 * g + 4 * h) = make_uint2(pk2(a[4 * g] * QSCALE, a[4 * g + 1] * QSCALE), pk2(a[4 * g + 2] * QSCALE, a[4 * g + 3] * QSCALE));
  }
  DI void operator()(int m, int nb, const f32x16& a0, const f32x16& a1, int h) const { one(m, nb, a0, h); one(m, nb + 32, a1, h); }
};
struct EpiKV {
  ushort_t* KF; ushort_t* VV;
  DI void one(int m, int nb, const f32x16& a, int h) const {
#pragma unroll
    for (int g = 0; g < 4; ++g) {
      const int n = nb + 8 * g + 4 * h;
      uint2 v = make_uint2(pk2(a[4 * g], a[4 * g + 1]), pk2(a[4 * g + 2], a[4 * g + 3]));
      if (n < 512) *(uint2*)(KF + (size_t)m * 768 + (n >> 6) * 96 + (n & 63)) = v;
      else *(uint2*)(VV + (size_t)m * 512 + (n - 512)) = v;
    }
  }
  DI void operator()(int m, int nb, const f32x16& a0, const f32x16& a1, int h) const { one(m, nb, a0, h); one(m, nb + 32, a1, h); }
};
struct EpiSwiGLU {
  ushort_t* ACT;
  DI void operator()(int m, int nb, const f32x16& a0, const f32x16& a1, int h) const {
    const int cb = nb >> 1;
#pragma unroll
    for (int g = 0; g < 4; ++g) {
      float v0 = siluf(a0[4 * g]) * a1[4 * g], v1 = siluf(a0[4 * g + 1]) * a1[4 * g + 1];
      float v2 = siluf(a0[4 * g + 2]) * a1[4 * g + 2], v3 = siluf(a0[4 * g + 3]) * a1[4 * g + 3];
      *(uint2*)(ACT + (size_t)m * DFF + cb + 8 * g + 4 * h) = make_uint2(pk2(v0, v1), pk2(v2, v3));
    }
  }
};

DI void tconv_tile(const float* __restrict__ src, int K, int N, ushort_t* dst, int ldd, int mode, ushort_t* dst2, int kt, int nt, char* smem) {
  float* tile = (float*)smem;
  const int tid = get_tid();
  const int k0 = kt * 64, n0 = nt * 64;
  __syncthreads();
#pragma unroll
  for (int it = 0; it < 16; ++it) {
    int k = it * 4 + (tid >> 6), n = tid & 63;
    float v = (n0 + n < N) ? src[(size_t)(k0 + k) * N + n0 + n] : 0.f;
    tile[k * 65 + n] = v;
  }
  __syncthreads();
#pragma unroll
  for (int it = 0; it < 16; ++it) {
    int n = it * 4 + (tid >> 6), k = tid & 63;
    int gn = n0 + n;
    int row = gn;
    if (mode == 1) row = (gn >> 5) * 64 + (gn & 31);
    else if (mode == 2) row = (gn >> 5) * 64 + 32 + (gn & 31);
    ushort_t v = f2bf(tile[k * 65 + n]);
    dst[(size_t)row * ldd + k0 + k] = v;
    if (mode == 3 && k0 >= 512) dst2[(size_t)gn * 2560 + 2048 + (k0 - 512) + k] = v;
  }
}

DI void norm_store_row(const float (&v)[16], float* Xrow, ushort_t* XNrow, const float* w, int lane, bool valid) {
  float ss = 0.f;
#pragma unroll
  for (int i = 0; i < 16; ++i) ss += v[i] * v[i];
  ss = wave_sum(ss);
  const float rstd = rsqrtf(ss * (1.f / 1024.f) + EPS);
#pragma unroll
  for (int j = 0; j < 4; ++j) {
    const int c = 4 * lane + 256 * j;
    float4 wv = *(const float4*)(w + c);
    float o0 = valid ? v[4 * j] : 0.f, o1 = valid ? v[4 * j + 1] : 0.f, o2 = valid ? v[4 * j + 2] : 0.f, o3 = valid ? v[4 * j + 3] : 0.f;
    if (Xrow) *(float4*)(Xrow + c) = make_float4(o0, o1, o2, o3);
    *(uint2*)(XNrow + c) = make_uint2(pk2(o0 * rstd * wv.x, o1 * rstd * wv.y), pk2(o2 * rstd * wv.z, o3 * rstd * wv.w));
  }
}

DI void phase_prep0(const Params& P, char* smem) {
  ushort_t* W = (ushort_t*)(P.ws + O_W);
  const int tid = get_tid();
  if (blockIdx.x == 0 && tid < 64) ((int*)(P.ws + O_CTR))[tid] = 0;
  constexpr int T_IN = 704, T_UQ = 72, T_UK = 32, T_UV = 32, T_O = 256, T_G = 704, T_U = 704, T_D = 704;
  constexpr int TL = T_IN + T_UQ + T_UK + T_UV + T_O + T_G + T_U + T_D;
  for (int t = blockIdx.x; t < TL * 4; t += gridDim.x) {
    const int l = t / TL; int rm = t % TL;
    ushort_t* Wl = W + (size_t)l * E_WL;
    if (rm < T_IN) { tconv_tile(P.w_in + (size_t)l * 1024 * INW, 1024, INW, Wl + E_WT_IN, 1024, 0, nullptr, rm / 44, rm % 44, smem); continue; }
    rm -= T_IN;
    if (rm < T_UQ) { tconv_tile(P.w_uq + (size_t)l * 384 * 768, 384, 768, Wl + E_WT_UQ, 384, 0, nullptr, rm / 12, rm % 12, smem); continue; }
    rm -= T_UQ;
    if (rm < T_UK) { tconv_tile(P.w_uk + (size_t)l * 256 * 512, 256, 512, Wl + E_WT_UKV, 256, 0, nullptr, rm / 8, rm % 8, smem); continue; }
    rm -= T_UK;
    if (rm < T_UV) { tconv_tile(P.w_uv + (size_t)l * 256 * 512, 256, 512, Wl + E_WT_UKV + (size_t)512 * 256, 256, 0, nullptr, rm / 8, rm % 8, smem); continue; }
    rm -= T_UV;
    if (rm < T_O) { tconv_tile(P.w_o + (size_t)l * 1024 * 1024, 1024, 1024, Wl + E_WT_O, 1024, 3, Wl + E_WT_OS, rm / 16, rm % 16, smem); continue; }
    rm -= T_O;
    if (rm < T_G) { tconv_tile(P.w_gate + (size_t)l * 1024 * DFF, 1024, DFF, Wl + E_WT_GU, 1024, 1, nullptr, rm / 44, rm % 44, smem); continue; }
    rm -= T_G;
    if (rm < T_U) { tconv_tile(P.w_up + (size_t)l * 1024 * DFF, 1024, DFF, Wl + E_WT_GU, 1024, 2, nullptr, rm / 44, rm % 44, smem); continue; }
    rm -= T_U;
    tconv_tile(P.w_down + (size_t)l * DFF * 1024, DFF, 1024, Wl + E_WT_DOWN, DFF, 0, nullptr, rm / 16, rm % 16, smem);
  }
  const int gt = blockIdx.x * 256 + tid, gs = gridDim.x * 256;
  for (int l = 0; l < 4; ++l) {
    ushort_t* Wl = W + (size_t)l * E_WL;
    for (int i = gt; i < 384 * 768; i += gs) Wl[E_WUQ_BF + i] = f2bf(P.w_uq[(size_t)l * 384 * 768 + i]);
    for (int i = gt; i < 256 * 512; i += gs) { Wl[E_WUK_BF + i] = f2bf(P.w_uk[(size_t)l * 256 * 512 + i]); Wl[E_WUV_BF + i] = f2bf(P.w_uv[(size_t)l * 256 * 512 + i]); }
  }
  float* X = (float*)(P.ws + O_X);
  ushort_t* XN = (ushort_t*)(P.ws + O_XN);
  const int lane = tid & 63, gw = blockIdx.x * 4 + (tid >> 6), nw = gridDim.x * 4;
  for (int row = gw; row < MTOT; row += nw) {
    const bool valid = row_valid(row);
    const float* src = nullptr;
    if (valid) {
      if (row >= SOFF) src = P.x_sample + (size_t)(row - SOFF) * 1024;
      else if (row < POFF + 16) src = P.meta + (size_t)(row - POFF) * 1024;
      else src = P.x_prompt + (size_t)(row - POFF - 16) * 1024;
    }
    float v[16];
#pragma unroll
    for (int j = 0; j < 4; ++j) {
      float4 t = valid ? *(const float4*)(src + 4 * lane + 256 * j) : make_float4(0.f, 0.f, 0.f, 0.f);
      v[4 * j] = t.x; v[4 * j + 1] = t.y; v[4 * j + 2] = t.z; v[4 * j + 3] = t.w;
    }
    norm_store_row(v, X + (size_t)row * 1024, XN + (size_t)row * 1024, P.pre_mix, lane, valid);
  }
}

DI void phase_prep1(const Params& P, char* smem) {
  ushort_t* W = (ushort_t*)(P.ws + O_W);
  for (int t = blockIdx.x; t < 4 * 176; t += gridDim.x) {
    const int l = t / 176; int rm = t % 176;
    ushort_t* Wl = W + (size_t)l * E_WL;
    if (rm < 48) {
      const int hd = rm / 6, mt = (rm % 6) / 3, nt = rm % 3;
      gemm_tile(Wl + E_WUK_BF + hd * 64, 512, Wl + E_WUQ_BF + hd * 96, 768, 64, mt * 128, nt * 128, smem,
                EpiBF16{Wl + E_WABS + (size_t)hd * 256 * 384, 384, 1.f});
    } else {
      rm -= 48;
      const int hd = rm / 16, mt = (rm % 16) / 2, nt = rm % 2;
      gemm_tile(Wl + E_WT_O + hd * 64, 1024, Wl + E_WUV_BF + hd * 64, 512, 64, mt * 128, nt * 128, smem,
                EpiBF16{Wl + E_WT_OS + hd * 256, 2560, 1.f});
    }
  }
}

DI void phase_rowpass(const Params& P, int l) {
  const ushort_t* PROJ = (const ushort_t*)(P.ws + O_PROJ);
  ushort_t* CQN = (ushort_t*)(P.ws + O_CQN); ushort_t* CKV = (ushort_t*)(P.ws + O_CKV); ushort_t* KPE = (ushort_t*)(P.ws + O_KPE);
  ushort_t* KF = (ushort_t*)(P.ws + O_KF);
  float* GQ = (float*)(P.ws + O_GQ); float* GK = (float*)(P.ws + O_GK); float* GV = (float*)(P.ws + O_GV);
  float* GB = (float*)(P.ws + O_GB); float* GG = (float*)(P.ws + O_GG);
  const int tid = get_tid(), lane = tid & 63, gw = blockIdx.x * 4 + (tid >> 6), nw = gridDim.x * 4;
  const float* cw = P.conv_w + (size_t)l * 4 * 1536;
  for (int row = gw; row < MTOT; row += nw) {
    const ushort_t* pr = PROJ + (size_t)row * INP;
    const bool isP = row < SOFF, valid = row_valid(row);
    const int tok = row - POFF, sb = (row - SOFF) >> 4, st = (row - SOFF) & 15;
    const float pos = row_pos(row);
    {
      float v[6], ss = 0.f;
#pragma unroll
      for (int j = 0; j < 6; ++j) { v[j] = bf2f(pr[lane + 64 * j]); ss += v[j] * v[j]; }
      ss = wave_sum(ss);
      const float rstd = rsqrtf(ss * (1.f / 384.f) + EPS);
#pragma unroll
      for (int j = 0; j < 6; ++j) CQN[(size_t)row * 384 + lane + 64 * j] = f2bf(v[j] * rstd * P.q_norm[l * 384 + lane + 64 * j]);
    }
    {
      float v[4], ss = 0.f;
#pragma unroll
      for (int j = 0; j < 4; ++j) { v[j] = bf2f(pr[OFF_KV + lane + 64 * j]); ss += v[j] * v[j]; }
      ss = wave_sum(ss);
      const float rstd = rsqrtf(ss * (1.f / 256.f) + EPS);
      float* olat = nullptr;
      if (valid) olat = isP ? P.out + OUT_PLAT + ((size_t)l * LTOK + tok) * 256 : P.out + OUT_SLAT + (((size_t)l * 32 + sb) * 16 + st) * 256;
#pragma unroll
      for (int j = 0; j < 4; ++j) {
        const float o = v[j] * rstd * P.kv_norm[l * 256 + lane + 64 * j];
        CKV[(size_t)row * 256 + lane + 64 * j] = f2bf(o);
        if (valid) olat[lane + 64 * j] = o;
      }
    }
    {
      const float x = bf2f(pr[OFF_PE + (lane & 31)]);
      const float pt = __shfl_xor(x, 16, 64);
      float sn, cs; sincosf(pos * rope_inv(lane & 15), &sn, &cs);
      const float o = ((lane & 31) < 16) ? (x * cs - pt * sn) : (pt * sn + x * cs);
      if (lane < 32) {
        const ushort_t ob = f2bf(o);
        KPE[(size_t)row * 32 + lane] = ob;
        if (valid) {
          if (isP) P.out[OUT_PPE + ((size_t)l * LTOK + tok) * 32 + lane] = o;
          else P.out[OUT_SPE + (((size_t)l * 32 + sb) * 16 + st) * 32 + lane] = o;
        }
        if (isP) {
#pragma unroll
          for (int hh = 0; hh < 8; ++hh) KF[(size_t)row * 768 + hh * 96 + 64 + lane] = ob;
        }
      }
    }
    {
      const float* cs = P.state_conv + ((size_t)l * 32 + (isP ? 0 : sb)) * 3 * 1536;
#pragma unroll 4
      for (int s = 0; s < 12; ++s) {
        float u2[2];
#pragma unroll
        for (int e = 0; e < 2; ++e) {
          const int ch = s * 128 + e * 64 + lane;
          float y = 0.f;
          if (valid) {
            const float x0 = bf2f(pr[OFF_QKV + ch]);
            float xm1, xm2, xm3;
            if (isP) {
              xm1 = bf2f(pr[OFF_QKV + ch - INP]); xm2 = bf2f(pr[OFF_QKV + ch - 2 * INP]); xm3 = bf2f(pr[OFF_QKV + ch - 3 * INP]);
              if (row >= PEND - 3) P.out[OUT_PCONV + ((size_t)l * 3 + (row - (PEND - 3))) * 1536 + ch] = x0;
            } else {
              xm1 = (st >= 1) ? bf2f(pr[OFF_QKV + ch - INP]) : cs[(size_t)(2 + st) * 1536 + ch];
              xm2 = (st >= 2) ? bf2f(pr[OFF_QKV + ch - 2 * INP]) : cs[(size_t)(1 + st) * 1536 + ch];
              xm3 = (st >= 3) ? bf2f(pr[OFF_QKV + ch - 3 * INP]) : cs[(size_t)(st) * 1536 + ch];
              if (st >= 13) P.out[OUT_SCONV + (((size_t)l * 32 + sb) * 3 + (st - 13)) * 1536 + ch] = x0;
            }
            y = cw[3 * 1536 + ch] * x0 + cw[2 * 1536 + ch] * xm1 + cw[1 * 1536 + ch] * xm2 + cw[ch] * xm3;
          }
          u2[e] = siluf(y);
        }
        const float a = u2[0], b = u2[1];
        if (s < 8) {
          const float ss = wave_sum(a * a + b * b);
          float sc = rsqrtf(ss + EPS);
          if (s < 4) sc *= 0.08838834764831845f;
          float* dst = (s < 4 ? GQ : GK) + (size_t)row * 512 + (s & 3) * 128;
          dst[lane] = a * sc; dst[lane + 64] = b * sc;
        } else {
          float* dst = GV + (size_t)row * 512 + (s - 8) * 128;
          dst[lane] = a; dst[lane + 64] = b;
        }
      }
    }
    if (lane < 4) {
      float beta = 0.f, g = 0.f;
      if (valid) {
        const float bb = bf2f(pr[OFF_B + lane]), aa = bf2f(pr[OFF_A + lane]) + P.dt_bias[l * 4 + lane];
        beta = 1.f / (1.f + expf(-bb));
        const float sp = aa > 20.f ? aa : log1pf(expf(aa));
        g = -expf(P.a_log[l * 4 + lane]) * sp;
      }
      GB[(size_t)row * 4 + lane] = beta; GG[(size_t)row * 4 + lane] = g;
    }
  }
}

DI void gdn_prep(const Params& P, int item, char* smem) {
  const float* GQ = (const float*)(P.ws + O_GQ); const float* GK = (const float*)(P.ws + O_GK); const float* GV = (const float*)(P.ws + O_GV);
  const float* GB = (const float*)(P.ws + O_GB); const float* GG = (const float*)(P.ws + O_GG);
  float* UT = (float*)(P.ws + O_UT) + (size_t)item * 8192;
  ushort_t* WN = (ushort_t*)(P.ws + O_WN) + (size_t)item * 8192;
  ushort_t* QG = (ushort_t*)(P.ws + O_QG) + (size_t)item * 8192;
  ushort_t* AN = (ushort_t*)(P.ws + O_AN) + (size_t)item * 16384;
  float* BN = (float*)(P.ws + O_BN) + (size_t)item * 16384;
  ushort_t* WTs = (ushort_t*)smem;
  ushort_t* UTs = WTs + 128 * 72;
  ushort_t* KDTs = (ushort_t*)(smem + 53248);
  ushort_t* QKM = (ushort_t*)(P.ws + O_QKM) + (size_t)item * 4096;
  float* GL = (float*)(P.ws + O_GL);
  ushort_t* Ks = (ushort_t*)smem;
  ushort_t* Qs = Ks + 64 * 136;
  float* Ms = (float*)(smem + 34816);
  float* gcs = (float*)(smem + 52224);
  float* bts = gcs + 64;
  float* egs = bts + 64;
  const int tid = get_tid(), lane = tid & 63, wave = tid >> 6, r = lane & 31, h = lane >> 5;
  const int n = item >> 2, hd = item & 3, row0 = 64 * n;
  __syncthreads();
  if (wave == 0) {
    float x = GG[(size_t)(row0 + lane) * 4 + hd];
    const float bt = GB[(size_t)(row0 + lane) * 4 + hd];
#pragma unroll
    for (int d = 1; d < 64; d <<= 1) { float y = __shfl_up(x, d, 64); if (lane >= d) x += y; }
    gcs[lane] = x; bts[lane] = bt; egs[lane] = expf(x);
    if (lane == 63) GL[item] = expf(x);
  }
#pragma unroll
  for (int i = 0; i < 8; ++i) {
    const int idx = tid + 256 * i, row = idx >> 5, c4 = (idx & 31) * 4;
    const float4 kv = *(const float4*)(GK + (size_t)(row0 + row) * 512 + hd * 128 + c4);
    const float4 qv = *(const float4*)(GQ + (size_t)(row0 + row) * 512 + hd * 128 + c4);
    *(uint2*)(Ks + row * 136 + c4) = make_uint2(pk2(kv.x, kv.y), pk2(kv.z, kv.w));
    *(uint2*)(Qs + row * 136 + c4) = make_uint2(pk2(qv.x, qv.y), pk2(qv.z, qv.w));
  }
  __syncthreads();
  {
    const int bi = wave >> 1, bj = wave & 1;
    f32x16 kk = zero16(), qk = zero16();
#pragma unroll
    for (int s = 0; s < 8; ++s) {
      const bf16x8 bfr = *(const bf16x8*)(Ks + (32 * bj + r) * 136 + 16 * s + 8 * h);
      const bf16x8 ak = *(const bf16x8*)(Ks + (32 * bi + r) * 136 + 16 * s + 8 * h);
      const bf16x8 aq = *(const bf16x8*)(Qs + (32 * bi + r) * 136 + 16 * s + 8 * h);
      kk = MFMA(ak, bfr, kk); qk = MFMA(aq, bfr, qk);
    }
    const int j = 32 * bj + r;
    const float gcj = gcs[j];
#pragma unroll
    for (int rg = 0; rg < 16; ++rg) {
      const int i = 32 * bi + crow(rg, h);
      const float dec = (j <= i) ? expf(gcs[i] - gcj) : 0.f;
      Ms[i * 68 + j] = (j < i) ? bts[i] * kk[rg] * dec : 0.f;
      QKM[i * 64 + j] = f2bf(qk[rg] * dec);
    }
  }
#pragma unroll
  for (int i = 0; i < 8; ++i) {
    const int idx = tid + 256 * i, row = idx >> 5, c4 = (idx & 31) * 4;
    const float4 qv = *(const float4*)(GQ + (size_t)(row0 + row) * 512 + hd * 128 + c4);
    const float e = egs[row];
    *(uint2*)(QG + row * 128 + c4) = make_uint2(pk2(qv.x * e, qv.y * e), pk2(qv.z * e, qv.w * e));
  }
  {
    const int dk = tid & 127, ch = tid >> 7;
    const float gl = gcs[63];
    unsigned pkd[16];
#pragma unroll
    for (int cc = 0; cc < 16; ++cc) {
      const int c0 = 32 * ch + 2 * cc;
      const float a = GK[(size_t)(row0 + c0) * 512 + hd * 128 + dk] * expf(gl - gcs[c0]);
      const float b = GK[(size_t)(row0 + c0 + 1) * 512 + hd * 128 + dk] * expf(gl - gcs[c0 + 1]);
      pkd[cc] = pk2(a, b);
    }
#pragma unroll
    for (int q4 = 0; q4 < 4; ++q4)
      *(uint4*)(KDTs + dk * 72 + 32 * ch + 8 * q4) = make_uint4(pkd[4 * q4], pkd[4 * q4 + 1], pkd[4 * q4 + 2], pkd[4 * q4 + 3]);
  }
  __syncthreads();
  {
    const int col = tid & 127;
    const bool isW = tid >= 128;
    float x[64];
#pragma unroll
    for (int c = 0; c < 64; ++c) {
      const float bt = bts[c];
      x[c] = isW ? GK[(size_t)(row0 + c) * 512 + hd * 128 + col] * (bt * egs[c]) : GV[(size_t)(row0 + c) * 512 + hd * 128 + col] * bt;
    }
#pragma unroll
    for (int i = 1; i < 64; ++i) {
      float acc = x[i];
#pragma unroll
      for (int j = 0; j < i; ++j) acc -= Ms[i * 68 + j] * x[j];
      x[i] = acc;
    }
    __syncthreads();
    if (!isW) {
#pragma unroll
      for (int c = 0; c < 64; c += 4) *(float4*)(UT + col * 64 + c) = make_float4(x[c], x[c + 1], x[c + 2], x[c + 3]);
#pragma unroll
      for (int c = 0; c < 64; c += 8)
        *(uint4*)(UTs + col * 72 + c) = make_uint4(pk2(x[c], x[c + 1]), pk2(x[c + 2], x[c + 3]), pk2(x[c + 4], x[c + 5]), pk2(x[c + 6], x[c + 7]));
    } else {
#pragma unroll
      for (int c = 0; c < 64; ++c) WN[c * 128 + col] = f2bf(-x[c]);
#pragma unroll
      for (int c = 0; c < 64; c += 8)
        *(uint4*)(WTs + col * 72 + c) = make_uint4(pk2(-x[c], -x[c + 1]), pk2(-x[c + 2], -x[c + 3]), pk2(-x[c + 4], -x[c + 5]), pk2(-x[c + 6], -x[c + 7]));
    }
  }
  __syncthreads();
  {
    const int bi = wave;
    const float gl = expf(gcs[63]);
    bf16x8 kf[4];
#pragma unroll
    for (int sx = 0; sx < 4; ++sx) kf[sx] = *(const bf16x8*)(KDTs + (32 * bi + r) * 72 + 16 * sx + 8 * h);
#pragma unroll
    for (int bj = 0; bj < 4; ++bj) {
      f32x16 ab = zero16(), aa = zero16();
#pragma unroll
      for (int sx = 0; sx < 4; ++sx) {
        ab = MFMA(kf[sx], *(const bf16x8*)(UTs + (32 * bj + r) * 72 + 16 * sx + 8 * h), ab);
        aa = MFMA(*(const bf16x8*)(WTs + (32 * bj + r) * 72 + 16 * sx + 8 * h), kf[sx], aa);
      }
#pragma unroll
      for (int g = 0; g < 4; ++g) {
        *(float4*)(BN + (((bi * 4 + bj) * 4 + g) * 64 + lane) * 4) = make_float4(ab[4 * g], ab[4 * g + 1], ab[4 * g + 2], ab[4 * g + 3]);
        float a0 = aa[4 * g], a1 = aa[4 * g + 1], a2 = aa[4 * g + 2], a3 = aa[4 * g + 3];
        if (bi == bj) {
          const int jb = 8 * g + 4 * h;
          if (jb == r) a0 += gl;
          if (jb + 1 == r) a1 += gl;
          if (jb + 2 == r) a2 += gl;
          if (jb + 3 == r) a3 += gl;
        }
        *(uint2*)(AN + (32 * bi + r) * 128 + 32 * bj + 8 * g + 4 * h) = make_uint2(pk2(a0, a1), pk2(a2, a3));
      }
    }
  }
}

DI void gdn_sample(const Params& P, int l, int item, char* smem) {
  const float* GQ = (const float*)(P.ws + O_GQ); const float* GK = (const float*)(P.ws + O_GK); const float* GV = (const float*)(P.ws + O_GV);
  const float* GB = (const float*)(P.ws + O_GB); const float* GG = (const float*)(P.ws + O_GG);
  float* OG = (float*)(P.ws + O_OG);
  float* ks = (float*)smem;
  float* qs = ks + 2048;
  float* vs = qs + 2048;
  float* egb = vs + 2048;
  float* red = egb + 32;
  float* red2 = red + 256;
  const int tid = get_tid(), dv = tid & 127, half = tid >> 7;
  const int b = item >> 2, hd = item & 3, row0 = SOFF + 16 * b;
  __syncthreads();
#pragma unroll
  for (int i = 0; i < 8; ++i) {
    const int idx = tid + 256 * i, t = idx >> 7, c = idx & 127;
    ks[idx] = GK[(size_t)(row0 + t) * 512 + hd * 128 + c];
    qs[idx] = GQ[(size_t)(row0 + t) * 512 + hd * 128 + c];
    vs[idx] = GV[(size_t)(row0 + t) * 512 + hd * 128 + c];
  }
  if (tid < 16) { egb[2 * tid] = expf(GG[(size_t)(row0 + tid) * 4 + hd]); egb[2 * tid + 1] = GB[(size_t)(row0 + tid) * 4 + hd]; }
  const size_t sbase = ((((size_t)l * 32 + b) * 4 + hd) * 128 + 64 * half) * 128 + dv;
  float S[64];
#pragma unroll
  for (int i = 0; i < 64; ++i) S[i] = P.state_gdn[sbase + (size_t)i * 128];
  __syncthreads();
  for (int t = 0; t < 16; ++t) {
    const float eg = egb[2 * t], bt = egb[2 * t + 1];
    const float* kt = ks + t * 128 + 64 * half;
    const float* qt = qs + t * 128 + 64 * half;
    float acc = 0.f;
#pragma unroll
    for (int i = 0; i < 64; ++i) { S[i] *= eg; acc += kt[i] * S[i]; }
    red[half * 128 + dv] = acc;
    __syncthreads();
    const float kS = red[dv] + red[128 + dv];
    const float d = bt * (vs[t * 128 + dv] - kS);
    float acc2 = 0.f;
#pragma unroll
    for (int i = 0; i < 64; ++i) { S[i] += kt[i] * d; acc2 += qt[i] * S[i]; }
    red2[half * 128 + dv] = acc2;
    __syncthreads();
    if (half == 0) OG[(size_t)(row0 + t) * 512 + hd * 128 + dv] = red2[dv] + red2[128 + dv];
  }
#pragma unroll
  for (int i = 0; i < 64; ++i) P.out[OUT_SGDN + sbase + (size_t)i * 128] = S[i];
}

DI void gdn_scan(const Params& P, int l, int item, char* smem) {
  const ushort_t* ANg = (const ushort_t*)(P.ws + O_AN);
  const float* BNg = (const float*)(P.ws + O_BN);
  u32x4* SPK = (u32x4*)(P.ws + O_SPK);
  ushort_t* ST = (ushort_t*)smem;
  const int tid = get_tid(), lane = tid & 63, b = tid >> 6, r = lane & 31, h = lane >> 5;
  const int hd = item >> 2, dvs = item & 3;
  __syncthreads();
  for (int i = tid; i < 32 * 136 / 2; i += 256) ((unsigned*)ST)[i] = 0u;
  {
    const u32x4 z = {0u, 0u, 0u, 0u};
    SPK[((((size_t)(0 * 4 + hd) * 4 + dvs) * 4 + b) * 2 + 0) * 64 + lane] = z;
    SPK[((((size_t)(0 * 4 + hd) * 4 + dvs) * 4 + b) * 2 + 1) * 64 + lane] = z;
  }
  bf16x8 Ac[8]; f32x16 Bc;
  {
    const int it = hd;
#pragma unroll
    for (int sx = 0; sx < 8; ++sx) Ac[sx] = *(const bf16x8*)(ANg + (size_t)it * 16384 + (32 * b + r) * 128 + 16 * sx + 8 * h);
#pragma unroll
    for (int g = 0; g < 4; ++g) {
      const float4 t = *(const float4*)(BNg + (size_t)it * 16384 + (((b * 4 + dvs) * 4 + g) * 64 + lane) * 4);
      Bc[4 * g] = t.x; Bc[4 * g + 1] = t.y; Bc[4 * g + 2] = t.z; Bc[4 * g + 3] = t.w;
    }
  }
  f32x16 acc = zero16();
  for (int n = 0; n < NCH; ++n) {
    const int cur = n & 1;
    bf16x8 An[8]; f32x16 Bn;
    {
      const int it = (n + 1 < NCH ? n + 1 : n) * 4 + hd;
#pragma unroll
      for (int sx = 0; sx < 8; ++sx) An[sx] = *(const bf16x8*)(ANg + (size_t)it * 16384 + (32 * b + r) * 128 + 16 * sx + 8 * h);
#pragma unroll
      for (int g = 0; g < 4; ++g) {
        const float4 t = *(const float4*)(BNg + (size_t)it * 16384 + (((b * 4 + dvs) * 4 + g) * 64 + lane) * 4);
        Bn[4 * g] = t.x; Bn[4 * g + 1] = t.y; Bn[4 * g + 2] = t.z; Bn[4 * g + 3] = t.w;
      }
    }
    __syncthreads();
    const ushort_t* Sc = ST + cur * (32 * 136);
    f32x16 a0 = Bc, a1 = zero16();
#pragma unroll
    for (int sx = 0; sx < 8; sx += 2) {
      a0 = MFMA(Ac[sx], *(const bf16x8*)(Sc + r * 136 + 16 * sx + 8 * h), a0);
      a1 = MFMA(Ac[sx + 1], *(const bf16x8*)(Sc + r * 136 + 16 * (sx + 1) + 8 * h), a1);
    }
#pragma unroll
    for (int i = 0; i < 16; ++i) acc[i] = a0[i] + a1[i];
    const u32x4 p0 = __builtin_bit_cast(u32x4, pack8<0>(acc));
    const u32x4 p1 = __builtin_bit_cast(u32x4, pack8<1>(acc));
    ushort_t* Sn = ST + (cur ^ 1) * (32 * 136) + r * 136 + 32 * b + 4 * h;
    *(uint2*)(Sn) = make_uint2(p0[0], p0[1]);
    *(uint2*)(Sn + 8) = make_uint2(p0[2], p0[3]);
    *(uint2*)(Sn + 16) = make_uint2(p1[0], p1[1]);
    *(uint2*)(Sn + 24) = make_uint2(p1[2], p1[3]);
    if (n + 1 < NCH) {
      SPK[((((size_t)((n + 1) * 4 + hd) * 4 + dvs) * 4 + b) * 2 + 0) * 64 + lane] = p0;
      SPK[((((size_t)((n + 1) * 4 + hd) * 4 + dvs) * 4 + b) * 2 + 1) * 64 + lane] = p1;
    }
#pragma unroll
    for (int sx = 0; sx < 8; ++sx) Ac[sx] = An[sx];
    Bc = Bn;
  }
#pragma unroll
  for (int i = 0; i < 16; ++i)
    P.out[OUT_PGDN + (((size_t)l * 4 + hd) * 128 + 32 * b + crow(i, h)) * 128 + 32 * dvs + r] = acc[i];
}

DI void gdn_out(const Params& P, int l, int item, char* smem) {
  const float* UTg = (const float*)(P.ws + O_UT);
  const ushort_t* WNg = (const ushort_t*)(P.ws + O_WN); const ushort_t* QGg = (const ushort_t*)(P.ws + O_QG);
  const ushort_t* QKMg = (const ushort_t*)(P.ws + O_QKM);
  const u32x4* SPK = (const u32x4*)(P.ws + O_SPK);
  const ushort_t* PROJ = (const ushort_t*)(P.ws + O_PROJ);
  ushort_t* MIX = (ushort_t*)(P.ws + O_MIX);
  ushort_t* WNs = (ushort_t*)smem;
  ushort_t* QGs = WNs + 64 * 136;
  ushort_t* QKs = QGs + 64 * 136;
  float* Os = (float*)smem;
  const int tid = get_tid(), lane = tid & 63, wave = tid >> 6, r = lane & 31, h = lane >> 5;
  const int n = item >> 2, hd = item & 3, dv0 = 32 * wave;
  __syncthreads();
  {
    const ushort_t* wsrc = WNg + (size_t)item * 8192; const ushort_t* qsrc = QGg + (size_t)item * 8192;
    const ushort_t* msrc = QKMg + (size_t)item * 4096;
#pragma unroll
    for (int i = 0; i < 4; ++i) {
      const int c = tid + 256 * i;
      *(u32x4*)(WNs + (c >> 4) * 136 + (c & 15) * 8) = *(const u32x4*)(wsrc + c * 8);
      *(u32x4*)(QGs + (c >> 4) * 136 + (c & 15) * 8) = *(const u32x4*)(qsrc + c * 8);
    }
#pragma unroll
    for (int i = 0; i < 2; ++i) {
      const int c = tid + 256 * i;
      *(u32x4*)(QKs + (c >> 3) * 72 + (c & 7) * 8) = *(const u32x4*)(msrc + c * 8);
    }
  }
  f32x16 vn[2];
#pragma unroll
  for (int cb = 0; cb < 2; ++cb)
#pragma unroll
    for (int g = 0; g < 4; ++g) {
      const float4 t = *(const float4*)(UTg + (size_t)item * 8192 + (dv0 + r) * 64 + 32 * cb + 8 * g + 4 * h);
      vn[cb][4 * g] = t.x; vn[cb][4 * g + 1] = t.y; vn[cb][4 * g + 2] = t.z; vn[cb][4 * g + 3] = t.w;
    }
  bf16x8 Sp[4][2];
#pragma unroll
  for (int b = 0; b < 4; ++b)
#pragma unroll
    for (int sx = 0; sx < 2; ++sx) Sp[b][sx] = __builtin_bit_cast(bf16x8, SPK[((((size_t)item * 4 + wave) * 4 + b) * 2 + sx) * 64 + lane]);
  __syncthreads();
#pragma unroll
  for (int cb = 0; cb < 2; ++cb)
#pragma unroll
    for (int b = 0; b < 4; ++b)
#pragma unroll
      for (int sx = 0; sx < 2; ++sx) vn[cb] = MFMA(fragP(WNs + (32 * cb + r) * 136 + 32 * b + 16 * sx, h), Sp[b][sx], vn[cb]);
  bf16x8 Vp[2][2];
  Vp[0][0] = pack8<0>(vn[0]); Vp[0][1] = pack8<1>(vn[0]); Vp[1][0] = pack8<0>(vn[1]); Vp[1][1] = pack8<1>(vn[1]);
  f32x16 o[2];
#pragma unroll
  for (int cb = 0; cb < 2; ++cb) {
    o[cb] = zero16();
#pragma unroll
    for (int b = 0; b < 4; ++b)
#pragma unroll
      for (int sx = 0; sx < 2; ++sx) o[cb] = MFMA(fragP(QGs + (32 * cb + r) * 136 + 32 * b + 16 * sx, h), Sp[b][sx], o[cb]);
#pragma unroll
    for (int cb2 = 0; cb2 <= cb; ++cb2)
#pragma unroll
      for (int sx = 0; sx < 2; ++sx) o[cb] = MFMA(fragP(QKs + (32 * cb + r) * 72 + 32 * cb2 + 16 * sx, h), Vp[cb2][sx], o[cb]);
  }
  __syncthreads();
#pragma unroll
  for (int cb = 0; cb < 2; ++cb)
#pragma unroll
    for (int i = 0; i < 16; ++i) Os[(32 * cb + crow(i, h)) * 132 + dv0 + r] = o[cb][i];
  __syncthreads();
  const float gw0 = P.gdn_norm[l * 128 + lane], gw1 = P.gdn_norm[l * 128 + 64 + lane];
#pragma unroll 4
  for (int rr = 0; rr < 16; ++rr) {
    const int c = 16 * wave + rr, row = 64 * n + c;
    const float o0 = Os[c * 132 + lane], o1 = Os[c * 132 + 64 + lane];
    const float z0 = bf2f(PROJ[(size_t)row * INP + OFF_Z + hd * 128 + lane]), z1 = bf2f(PROJ[(size_t)row * INP + OFF_Z + hd * 128 + 64 + lane]);
    const float ss = wave_sum(o0 * o0 + o1 * o1);
    const float rstd = rsqrtf(ss * (1.f / 128.f) + EPS);
    MIX[(size_t)row * 1024 + 512 + hd * 128 + lane] = f2bf(o0 * rstd * gw0 * siluf(z0));
    MIX[(size_t)row * 1024 + 512 + hd * 128 + 64 + lane] = f2bf(o1 * rstd * gw1 * siluf(z1));
  }
}

template <int NDB>
DI void softmax_pv(f32x16 (&st)[2], f32x16 (&o)[NDB], float& m, float& l, const ushort_t* Vs, int vpitch, int vcol0, int lane) {
  const int h = lane >> 5, i16 = lane & 15, q = i16 >> 2, p = i16 & 3, blk = (lane >> 4) & 1;
  float mt = st[0][0];
#pragma unroll
  for (int kb = 0; kb < 2; ++kb)
#pragma unroll
    for (int i = 0; i < 16; ++i) mt = fmaxf(mt, st[kb][i]);
  mt = swap_max(mt);
  const float mn = fmaxf(m, mt);
  const float alpha = __builtin_amdgcn_exp2f(m - mn);
  m = mn;
  float ls = 0.f;
#pragma unroll
  for (int kb = 0; kb < 2; ++kb)
#pragma unroll
    for (int i = 0; i < 16; ++i) { const float pv = __builtin_amdgcn_exp2f(st[kb][i] - mn); st[kb][i] = pv; ls += pv; }
  l = l * alpha + ls;
#pragma unroll
  for (int db = 0; db < NDB; ++db)
#pragma unroll
    for (int i = 0; i < 16; ++i) o[db][i] *= alpha;
  const ushort_t* vb = Vs + (4 * h + q) * vpitch + vcol0 + 16 * blk + 4 * p;
  __builtin_amdgcn_s_setprio(1);
#pragma unroll
  for (int kb = 0; kb < 2; ++kb) {
    const bf16x8 p0 = pack8<0>(st[kb]);
    const bf16x8 p1 = pack8<1>(st[kb]);
#pragma unroll
    for (int db = 0; db < NDB; ++db) {
      const ushort_t* v0 = vb + (32 * kb) * vpitch + 32 * db;
      o[db] = MFMA(cat8(vtr(v0), vtr(v0 + 8 * vpitch)), p0, o[db]);
      o[db] = MFMA(cat8(vtr(v0 + 16 * vpitch), vtr(v0 + 24 * vpitch)), p1, o[db]);
    }
  }
  __builtin_amdgcn_s_setprio(0);
}

DI void attn_prompt(const Params& P, int qt, int head, char* smem) {
  const ushort_t* QF = (const ushort_t*)(P.ws + O_QF); const ushort_t* KF = (const ushort_t*)(P.ws + O_KF);
  const ushort_t* VV = (const ushort_t*)(P.ws + O_VV); ushort_t* MIX = (ushort_t*)(P.ws + O_MIX);
  constexpr int KP = 104, VP = 72;
  ushort_t* Kb = (ushort_t*)smem;
  ushort_t* Vb = Kb + 2 * 64 * KP;
  const int tid = get_tid(), lane = tid & 63, wave = tid >> 6, r = lane & 31, h = lane >> 5;
  const int qrow = 128 * qt + 32 * wave + r;
  const int cq = 2 * qt + (wave >> 1);
  const int ntile = 2 * qt + 2;
  bf16x8 qf[6];
#pragma unroll
  for (int s = 0; s < 6; ++s) qf[s] = *(const bf16x8*)(QF + (size_t)qrow * 768 + head * 96 + 16 * s + 8 * h);
  f32x16 o[2]; o[0] = zero16(); o[1] = zero16();
  float m = -1e30f, l = 0.f;
  u32x4 rk0, rk1, rk2, rv0, rv1;
  u32x4 sk0, sk1, sk2, sv0, sv1;
  const int kr0 = tid / 12, kc0 = tid % 12, kr1 = (tid + 256) / 12, kc1 = (tid + 256) % 12, kr2 = (tid + 512) / 12, kc2 = (tid + 512) % 12;
  const int vr0 = tid >> 3, vc0 = tid & 7, vr1 = (tid + 256) >> 3;
  const ushort_t* kg0 = KF + (size_t)kr0 * 768 + head * 96 + kc0 * 8;
  const ushort_t* kg1 = KF + (size_t)kr1 * 768 + head * 96 + kc1 * 8;
  const ushort_t* kg2 = KF + (size_t)kr2 * 768 + head * 96 + kc2 * 8;
  const ushort_t* vg0 = VV + (size_t)vr0 * 512 + head * 64 + vc0 * 8;
  const ushort_t* vg1 = VV + (size_t)vr1 * 512 + head * 64 + vc0 * 8;
#define ATT_GLOAD0(kt) { const size_t ko = (size_t)(kt) * 64 * 768, vo = (size_t)(kt) * 64 * 512; \
    rk0 = *(const u32x4*)(kg0 + ko); rk1 = *(const u32x4*)(kg1 + ko); rk2 = *(const u32x4*)(kg2 + ko); rv0 = *(const u32x4*)(vg0 + vo); rv1 = *(const u32x4*)(vg1 + vo); }
#define ATT_GLOAD1(kt) { const size_t ko = (size_t)(kt) * 64 * 768, vo = (size_t)(kt) * 64 * 512; \
    sk0 = *(const u32x4*)(kg0 + ko); sk1 = *(const u32x4*)(kg1 + ko); sk2 = *(const u32x4*)(kg2 + ko); sv0 = *(const u32x4*)(vg0 + vo); sv1 = *(const u32x4*)(vg1 + vo); }
#define ATT_LSTORE0(buf) { ushort_t* kd = Kb + (buf) * 64 * KP; ushort_t* vd = Vb + (buf) * 64 * VP; \
    *(u32x4*)(kd + kr0 * KP + kc0 * 8) = rk0; *(u32x4*)(kd + kr1 * KP + kc1 * 8) = rk1; *(u32x4*)(kd + kr2 * KP + kc2 * 8) = rk2; \
    *(u32x4*)(vd + vr0 * VP + vc0 * 8) = rv0; *(u32x4*)(vd + vr1 * VP + vc0 * 8) = rv1; }
#define ATT_LSTORE1(buf) { ushort_t* kd = Kb + (buf) * 64 * KP; ushort_t* vd = Vb + (buf) * 64 * VP; \
    *(u32x4*)(kd + kr0 * KP + kc0 * 8) = sk0; *(u32x4*)(kd + kr1 * KP + kc1 * 8) = sk1; *(u32x4*)(kd + kr2 * KP + kc2 * 8) = sk2; \
    *(u32x4*)(vd + vr0 * VP + vc0 * 8) = sv0; *(u32x4*)(vd + vr1 * VP + vc0 * 8) = sv1; }
#define ATT_COMPUTE(kt, buf) if ((kt) <= cq) { \
      const ushort_t* Ks = Kb + (buf) * 64 * KP; \
      f32x16 st[2]; st[0] = zero16(); st[1] = zero16(); \
      __builtin_amdgcn_s_setprio(1); \
      _Pragma("unroll") for (int s = 0; s < 6; ++s) { \
        _Pragma("unroll") for (int kb = 0; kb < 2; ++kb) st[kb] = MFMA(*(const bf16x8*)(Ks + (32 * kb + r) * KP + 16 * s + 8 * h), qf[s], st[kb]); } \
      __builtin_amdgcn_s_setprio(0); \
      if ((kt) == 0) { \
        _Pragma("unroll") for (int kb = 0; kb < 2; ++kb) \
          _Pragma("unroll") for (int i = 0; i < 16; ++i) if (32 * kb + crow(i, h) < POFF) st[kb][i] = -1e30f; } \
      softmax_pv<2>(st, o, m, l, Vb + (buf) * 64 * VP, VP, 0, lane); }
  __syncthreads();
  ATT_GLOAD0(0);
  ATT_GLOAD1(1);
  ATT_LSTORE0(0);
  const int lastt = ntile - 1;
  ATT_GLOAD0(min(2, lastt));
  __syncthreads();
  for (int kt = 0; kt < ntile; kt += 2) {
    ATT_COMPUTE(kt, 0);
    ATT_LSTORE1(1);
    ATT_GLOAD1(min(kt + 3, lastt));
    __syncthreads();
    ATT_COMPUTE(kt + 1, 1);
    ATT_LSTORE0(0);
    ATT_GLOAD0(min(kt + 4, lastt));
    __syncthreads();
  }
#undef ATT_GLOAD0
#undef ATT_GLOAD1
#undef ATT_LSTORE0
#undef ATT_LSTORE1
#undef ATT_COMPUTE
  const float inv = 1.f / swap_sum(l);
#pragma unroll
  for (int db = 0; db < 2; ++db)
#pragma unroll
    for (int g = 0; g < 4; ++g)
      *(uint2*)(MIX + (size_t)qrow * 1024 + head * 64 + 32 * db + 8 * g + 4 * h) =
          make_uint2(pk2(o[db][4 * g] * inv, o[db][4 * g + 1] * inv), pk2(o[db][4 * g + 2] * inv, o[db][4 * g + 3] * inv));
}

DI void attn_sample(const Params& P, int l, int b, int sp, int hg, char* smem) {
  const ushort_t* QF = (const ushort_t*)(P.ws + O_QF); const ushort_t* QL = (const ushort_t*)(P.ws + O_QL);
  const ushort_t* CKV = (const ushort_t*)(P.ws + O_CKV); const ushort_t* KPE = (const ushort_t*)(P.ws + O_KPE);
  float* PO = (float*)(P.ws + O_PO); float* PML = (float*)(P.ws + O_PML);
  constexpr int KP = 296;
  ushort_t* Qs = (ushort_t*)smem;
  ushort_t* Kt = Qs + 64 * KP;
  const int tid = get_tid(), lane = tid & 63, wave = tid >> 6, r = lane & 31, h = lane >> 5;
  const int qb = wave & 1, dvh = wave >> 1;
  __syncthreads();
#pragma unroll
  for (int i = 0; i < 9; ++i) {
    const int c = tid + 256 * i, q = c / 36, cc = c % 36;
    const int hh = q >> 4, tok = q & 15, head = 4 * hg + hh, srow = 16 * b + tok;
    uint4 v;
    if (cc < 32) v = *(const uint4*)(QL + (size_t)srow * 2048 + head * 256 + cc * 8);
    else v = *(const uint4*)(QF + (size_t)(SOFF + srow) * 768 + head * 96 + 64 + (cc - 32) * 8);
    *(uint4*)(Qs + q * KP + cc * 8) = v;
  }
  f32x16 o[4]; o[0] = zero16(); o[1] = zero16(); o[2] = zero16(); o[3] = zero16();
  float m = -1e30f, lsum = 0.f;
  const int nt = (sp == 7) ? 9 : 8;
  const float* clat = P.cache_lat + (((size_t)l * 32 + b) * PAST + (size_t)sp * 512) * 256;
  const float* cpe = P.cache_pe + (((size_t)l * 32 + b) * PAST + (size_t)sp * 512) * 32;
  for (int ti = 0; ti < nt; ++ti) {
    __syncthreads();
    if (ti < 8) {
      const float* lat = clat + (size_t)ti * 64 * 256;
#pragma unroll
      for (int bt = 0; bt < 2; ++bt) {
        float4 t[8];
#pragma unroll
        for (int i = 0; i < 8; ++i) t[i] = *(const float4*)(lat + (size_t)(tid + 256 * (8 * bt + i)) * 4);
#pragma unroll
        for (int i = 0; i < 8; ++i) {
          const int c = tid + 256 * (8 * bt + i), row = c >> 6, c4 = (c & 63) * 4;
          *(uint2*)(Kt + row * KP + c4) = make_uint2(pk2(t[i].x, t[i].y), pk2(t[i].z, t[i].w));
        }
      }
      const float* pe = cpe + (size_t)ti * 64 * 32;
#pragma unroll
      for (int i = 0; i < 2; ++i) {
        const int c = tid + 256 * i, row = c >> 3, c4 = (c & 7) * 4;
        const float4 t = *(const float4*)(pe + (size_t)c * 4);
        *(uint2*)(Kt + row * KP + 256 + c4) = make_uint2(pk2(t.x, t.y), pk2(t.z, t.w));
      }
    } else {
#pragma unroll
      for (int i = 0; i < 9; ++i) {
        const int c = tid + 256 * i, row = c / 36, cc = c % 36;
        uint4 v = make_uint4(0u, 0u, 0u, 0u);
        if (row < 16) {
          if (cc < 32) v = *(const uint4*)(CKV + (size_t)(SOFF + 16 * b + row) * 256 + cc * 8);
          else v = *(const uint4*)(KPE + (size_t)(SOFF + 16 * b + row) * 32 + (cc - 32) * 8);
        }
        *(uint4*)(Kt + row * KP + cc * 8) = v;
      }
    }
    __syncthreads();
    f32x16 st[2]; st[0] = zero16(); st[1] = zero16();
#pragma unroll
    for (int s = 0; s < 18; ++s) {
      const bf16x8 qv = *(const bf16x8*)(Qs + (32 * qb + r) * KP + 16 * s + 8 * h);
#pragma unroll
      for (int kb = 0; kb < 2; ++kb) st[kb] = MFMA(*(const bf16x8*)(Kt + (32 * kb + r) * KP + 16 * s + 8 * h), qv, st[kb]);
    }
    if (ti == 8) {
#pragma unroll
      for (int kb = 0; kb < 2; ++kb)
#pragma unroll
        for (int i = 0; i < 16; ++i) if (32 * kb + crow(i, h) >= 16) st[kb][i] = -1e30f;
    }
    softmax_pv<4>(st, o, m, lsum, Kt, KP, 128 * dvh, lane);
  }
  const float lt = swap_sum(lsum);
  const int gq = 64 * hg + 32 * qb + r;
  const size_t pbase = ((size_t)(b * 8 + sp) * 128 + gq);
  if (dvh == 0 && h == 0) { PML[pbase * 2] = m; PML[pbase * 2 + 1] = lt; }
#pragma unroll
  for (int db = 0; db < 4; ++db)
#pragma unroll
    for (int g = 0; g < 4; ++g)
      *(float4*)(PO + pbase * 256 + 128 * dvh + 32 * db + 8 * g + 4 * h) = make_float4(o[db][4 * g], o[db][4 * g + 1], o[db][4 * g + 2], o[db][4 * g + 3]);
}


DI bool tile_swz(int t, int MT, int NT, int& mt, int& nt) {
  const int G = gridDim.x, b = blockIdx.x;
  int u = t;
  if ((G & 7) == 0) u = (t / G) * G + (b & 7) * (G >> 3) + (b >> 3);
  if (u >= MT * NT) return false;
  const int full = (NT >> 3) * MT * 8;
  if (u < full) { const int g = u / (MT * 8), rem = u % (MT * 8); mt = rem >> 3; nt = g * 8 + (rem & 7); }
  else { const int rem = u - full, w = NT & 7; mt = rem / w; nt = (NT >> 3) * 8 + rem % w; }
  return true;
}
DI int round_up_grid(int n) { const int G = gridDim.x; return ((n + G - 1) / G) * G; }

DI void phase_g1(const Params& P, int l, char* smem) {
  const ushort_t* Wl = (const ushort_t*)(P.ws + O_W) + (size_t)l * E_WL;
  for (int t = blockIdx.x; t < round_up_grid(133 * 11); t += gridDim.x) {
    int mt, nt; if (!tile_swz(t, 133, 11, mt, nt)) continue;
    gemm_tile_w((const ushort_t*)(P.ws + O_XN), 1024, Wl + E_WT_IN, 1024, 1024, mt * 128, nt * 256, smem, EpiBF16{(ushort_t*)(P.ws + O_PROJ), INP, 1.f});
  }
}

DI void phase_mid(const Params& P, int l, char* smem) {
  const ushort_t* Wl = (const ushort_t*)(P.ws + O_W) + (size_t)l * E_WL;
  const ushort_t* CQN = (const ushort_t*)(P.ws + O_CQN);
  constexpr int N_G2 = 133 * 6, N_G2S = 4 * 16, N_G3 = 129 * 8, N_PREP = NITEM, N_GS = 128;
  constexpr int TOT = N_G2 + N_G2S + N_G3 + N_PREP + N_GS;
  for (int t0 = blockIdx.x; t0 < TOT; t0 += gridDim.x) {
    int t = t0;
    if (t < N_PREP) { gdn_prep(P, t, smem); continue; }
    t -= N_PREP;
    if (t < N_GS) { gdn_sample(P, l, t, smem); continue; }
    t -= N_GS;
    if (t < N_G3) { gemm_tile((const ushort_t*)(P.ws + O_CKV), 256, Wl + E_WT_UKV, 256, 256, (t / 8) * 128, (t % 8) * 128, smem, EpiKV{(ushort_t*)(P.ws + O_KF), (ushort_t*)(P.ws + O_VV)}); continue; }
    t -= N_G3;
    if (t < N_G2) { gemm_tile(CQN, 384, Wl + E_WT_UQ, 384, 384, (t / 6) * 128, (t % 6) * 128, smem, EpiQ{(ushort_t*)(P.ws + O_QF)}); continue; }
    t -= N_G2;
    gemm_tile(CQN, 384, Wl + E_WABS, 384, 384, SOFF + (t / 16) * 128, (t % 16) * 128, smem, EpiBF16{(ushort_t*)(P.ws + O_QL) - (size_t)SOFF * 2048, 2048, QSCALE});
  }
}

DI void phase_mix(const Params& P, int l, char* smem, int flags) {
  int* ctr = (int*)(P.ws + O_CTR) + l * 16;
  volatile int* slot = (volatile int*)(smem + 75776);
  const int myq = (int)(xcc_id_early() & 7u);
  if (threadIdx.x == 0) slot[1] = 0;
  while (true) {
    __syncthreads();
    if (threadIdx.x == 0) {
      int stg = slot[1], code = -1;
      while (stg < 10) {
        if (stg == 0) { const int t = atomicAdd(&ctr[0], 1); if (t < 16) { code = t; break; } stg = 1; }
        else if (stg == 2) { const int t = atomicAdd(&ctr[9], 1); if (t < 512) { code = 16 + 1032 + t; break; } stg = 3; }
        else { const int q = (stg == 1) ? myq : ((myq + stg - 2) & 7); const int t = atomicAdd(&ctr[1 + q], 1); if (t < 129) { code = 16 + (128 - t) * 8 + q; break; } ++stg; }
      }
      slot[1] = stg; slot[0] = code;
    }
    __syncthreads();
    int t = slot[0];
    if (t < 0) break;
    if (t < 16) { if (flags == 0 || flags == 1) gdn_scan(P, l, t, smem); continue; }
    t -= 16;
    if (t < 1032) { if (flags == 0 || flags == 2) attn_prompt(P, t >> 3, t & 7, smem); continue; }
    t -= 1032;
    if (flags == 0 || flags == 3) attn_sample(P, l, t >> 4, (t >> 1) & 7, t & 1, smem);
  }
}

DI void phase_gate(const Params& P, int l, char* smem) {
  const float* OG = (const float*)(P.ws + O_OG); const ushort_t* PROJ = (const ushort_t*)(P.ws + O_PROJ);
  ushort_t* MIX = (ushort_t*)(P.ws + O_MIX); ushort_t* MIXS = (ushort_t*)(P.ws + O_MIXS);
  const float* PO = (const float*)(P.ws + O_PO); const float* PML = (const float*)(P.ws + O_PML);
  const int tid = get_tid(), lane = tid & 63, gw = blockIdx.x * 4 + (tid >> 6), nw = gridDim.x * 4;
  for (int t = blockIdx.x; t < NITEM; t += gridDim.x) gdn_out(P, l, t, smem);
  for (int row = SOFF + gw; row < MTOT; row += nw) {
    const bool valid = row_valid(row);
#pragma unroll
    for (int hd = 0; hd < 4; ++hd) {
      float o0 = 0.f, o1 = 0.f, z0 = 0.f, z1 = 0.f;
      if (valid) {
        o0 = OG[(size_t)row * 512 + hd * 128 + lane]; o1 = OG[(size_t)row * 512 + hd * 128 + 64 + lane];
        z0 = bf2f(PROJ[(size_t)row * INP + OFF_Z + hd * 128 + lane]); z1 = bf2f(PROJ[(size_t)row * INP + OFF_Z + hd * 128 + 64 + lane]);
      }
      const float ss = wave_sum(o0 * o0 + o1 * o1);
      const float rstd = rsqrtf(ss * (1.f / 128.f) + EPS);
      const float v0 = o0 * rstd * P.gdn_norm[l * 128 + lane] * siluf(z0);
      const float v1 = o1 * rstd * P.gdn_norm[l * 128 + 64 + lane] * siluf(z1);
      if (row < SOFF) { MIX[(size_t)row * 1024 + 512 + hd * 128 + lane] = f2bf(v0); MIX[(size_t)row * 1024 + 512 + hd * 128 + 64 + lane] = f2bf(v1); }
      else { MIXS[(size_t)(row - SOFF) * 2560 + 2048 + hd * 128 + lane] = f2bf(v0); MIXS[(size_t)(row - SOFF) * 2560 + 2048 + hd * 128 + 64 + lane] = f2bf(v1); }
    }
  }
  for (int it = gw; it < 32 * 128; it += nw) {
    const int b = it >> 7, gq = it & 127, head = gq >> 4, tok = gq & 15;
    float ms[8], mx = -1e30f;
#pragma unroll
    for (int sp = 0; sp < 8; ++sp) { ms[sp] = PML[((size_t)(b * 8 + sp) * 128 + gq) * 2]; mx = fmaxf(mx, ms[sp]); }
    float L = 0.f; float4 acc = make_float4(0.f, 0.f, 0.f, 0.f);
#pragma unroll
    for (int sp = 0; sp < 8; ++sp) {
      const float w = __builtin_amdgcn_exp2f(ms[sp] - mx);
      L += w * PML[((size_t)(b * 8 + sp) * 128 + gq) * 2 + 1];
      const float4 t = *(const float4*)(PO + ((size_t)(b * 8 + sp) * 128 + gq) * 256 + lane * 4);
      acc.x += w * t.x; acc.y += w * t.y; acc.z += w * t.z; acc.w += w * t.w;
    }
    const float inv = 1.f / L;
    *(uint2*)(MIXS + (size_t)(16 * b + tok) * 2560 + head * 256 + lane * 4) = make_uint2(pk2(acc.x * inv, acc.y * inv), pk2(acc.z * inv, acc.w * inv));
  }
}

DI void phase_g6(const Params& P, int l, char* smem) {
  const ushort_t* Wl = (const ushort_t*)(P.ws + O_W) + (size_t)l * E_WL;
  ushort_t* OMIX = (ushort_t*)(P.ws + O_OMIX);
  for (int t = blockIdx.x; t < round_up_grid(133 * 16); t += gridDim.x) {
    int mt, n2; if (!tile_swz(t, 133, 16, mt, n2)) continue;
    const int nt = n2 >> 1, ks = n2 & 1;
    ushort_t* dst = OMIX + (size_t)ks * MTOT * 1024;
    if (mt < 129) gemm_tile((const ushort_t*)(P.ws + O_MIX) + ks * 512, 1024, Wl + E_WT_O + ks * 512, 1024, 512, mt * 128, nt * 128, smem, EpiBF16{dst, 1024, 1.f});
    else gemm_tile((const ushort_t*)(P.ws + O_MIXS) - (size_t)SOFF * 2560 + ks * 1280, 2560, Wl + E_WT_OS + ks * 1280, 2560, 1280, mt * 128, nt * 128, smem, EpiBF16{dst, 1024, 1.f});
  }
}

DI void phase_resid(const Params& P, const float* w1, const float* w2, bool final_out, bool first) {
  const ushort_t* OMIX = (const ushort_t*)(P.ws + O_OMIX);
  const float* X = (const float*)(P.ws + (first ? O_X : O_X2)); float* XO = (float*)(P.ws + (first ? O_X2 : O_X)); ushort_t* XN = (ushort_t*)(P.ws + O_XN);
  const int tid = get_tid(), lane = tid & 63, gw = blockIdx.x * 4 + (tid >> 6), nw = gridDim.x * 4;
  for (int row = gw; row < MTOT; row += nw) {
    const bool valid = row_valid(row);
    float v[16], ss = 0.f;
#pragma unroll
    for (int j = 0; j < 4; ++j) {
      const uint2 t = *(const uint2*)(OMIX + (size_t)row * 1024 + 4 * lane + 256 * j);
      const uint2 t2 = *(const uint2*)(OMIX + (size_t)MTOT * 1024 + (size_t)row * 1024 + 4 * lane + 256 * j);
      v[4 * j] = __uint_as_float(t.x << 16) + __uint_as_float(t2.x << 16); v[4 * j + 1] = __uint_as_float(t.x & 0xffff0000u) + __uint_as_float(t2.x & 0xffff0000u);
      v[4 * j + 2] = __uint_as_float(t.y << 16) + __uint_as_float(t2.y << 16); v[4 * j + 3] = __uint_as_float(t.y & 0xffff0000u) + __uint_as_float(t2.y & 0xffff0000u);
    }
#pragma unroll
    for (int i = 0; i < 16; ++i) { v[i] = valid ? v[i] : 0.f; ss += v[i] * v[i]; }
    ss = wave_sum(ss);
    const float rstd = rsqrtf(ss * (1.f / 1024.f) + EPS);
#pragma unroll
    for (int j = 0; j < 4; ++j) {
      const int c = 4 * lane + 256 * j;
      const float4 xv = *(const float4*)(X + (size_t)row * 1024 + c);
      const float4 wv = *(const float4*)(w1 + c);
      v[4 * j] = xv.x + v[4 * j] * rstd * wv.x; v[4 * j + 1] = xv.y + v[4 * j + 1] * rstd * wv.y;
      v[4 * j + 2] = xv.z + v[4 * j + 2] * rstd * wv.z; v[4 * j + 3] = xv.w + v[4 * j + 3] * rstd * wv.w;
    }
    if (final_out) {
      if (valid) {
        float* dst = nullptr;
        if (row >= SOFF) dst = P.out + OUT_YS + (size_t)(row - SOFF) * 1024;
        else if (row >= POFF + 16) dst = P.out + OUT_YP + (size_t)(row - POFF - 16) * 1024;
        if (dst) {
#pragma unroll
          for (int j = 0; j < 4; ++j) *(float4*)(dst + 4 * lane + 256 * j) = make_float4(v[4 * j], v[4 * j + 1], v[4 * j + 2], v[4 * j + 3]);
        }
      }
    } else {
      norm_store_row(v, XO + (size_t)row * 1024, XN + (size_t)row * 1024, w2, lane, valid);
    }
  }
}

DI void phase_g7(const Params& P, int l, char* smem) {
  const ushort_t* Wl = (const ushort_t*)(P.ws + O_W) + (size_t)l * E_WL;
  for (int t = blockIdx.x; t < round_up_grid(133 * 22); t += gridDim.x) {
    int mt, nt; if (!tile_swz(t, 133, 22, mt, nt)) continue;
    gemm_tile_w((const ushort_t*)(P.ws + O_XN), 1024, Wl + E_WT_GU, 1024, 1024, mt * 128, nt * 256, smem, EpiSwiGLU{(ushort_t*)(P.ws + O_ACT)});
  }
}
DI void phase_g8(const Params& P, int l, char* smem) {
  const ushort_t* Wl = (const ushort_t*)(P.ws + O_W) + (size_t)l * E_WL;
  for (int t = blockIdx.x; t < round_up_grid(133 * 16); t += gridDim.x) {
    int mt, n2; if (!tile_swz(t, 133, 16, mt, n2)) continue;
    const int nt = n2 >> 1, ks = n2 & 1;
    gemm_tile((const ushort_t*)(P.ws + O_ACT) + ks * 1408, DFF, Wl + E_WT_DOWN + ks * 1408, DFF, 1408, mt * 128, nt * 128, smem,
              EpiBF16{(ushort_t*)(P.ws + O_OMIX) + (size_t)ks * MTOT * 1024, 1024, 1.f});
  }
}

#define XB_TMO      128
#define XB_XCNT(j)  (256  + 64 * (j))
#define XB_XSUB(j)  (1280 + 64 * (j))
#define XB_XGEN(j)  (2304 + 64 * (j))
#define XB_TOP      3328
#define XB_TOPGEN   3392
#define XCD_BAR_WORDS 3456
#define XB_SPIN_CAP (1u << 22)
#define LAS __attribute__((address_space(3)))
DI unsigned xb_ld(unsigned* p) { return __hip_atomic_load(p, __ATOMIC_RELAXED, __HIP_MEMORY_SCOPE_AGENT); }
DI unsigned xb_add(unsigned* p, unsigned v) { return __hip_atomic_fetch_add(p, v, __ATOMIC_RELAXED, __HIP_MEMORY_SCOPE_AGENT); }
DI unsigned xb_xcc_id() { return (unsigned)__builtin_amdgcn_s_getreg((3 << 11) | 20) & 0xFu; }
#define XB_SPIN(cond, bar) do { unsigned _sp = 0; while (cond) { __builtin_amdgcn_s_sleep(1); \
    if ((++_sp & 255u) == 0u) { if (xb_ld(&(bar)[XB_TMO])) break; if (_sp > XB_SPIN_CAP) { atomicAdd(&(bar)[XB_TMO], 1u); break; } } } } while (0)
struct XcdBarrier { unsigned* bar; unsigned x; volatile LAS unsigned* st; };
DI XcdBarrier xcd_barrier_post(unsigned* bar, volatile LAS unsigned* st) {
  XcdBarrier b; b.bar = bar; b.x = xb_xcc_id(); b.st = st;
  if (threadIdx.x == 0) (void)xb_add(&bar[XB_XCNT(b.x)], 1u);
  return b;
}
DI void xcd_barrier_complete(unsigned* bar, unsigned x, unsigned& nloc, unsigned& nx) {
  const unsigned G = gridDim.x * gridDim.y * gridDim.z;
  unsigned sum, cnt, mine, sp = 0u;
  for (;;) {
    sum = 0u; cnt = 0u; mine = 0u;
#pragma unroll
    for (unsigned j = 0; j < 16; ++j) { const unsigned c = xb_ld(&bar[XB_XCNT(j)]); sum += c; cnt += (c > 0u) ? 1u : 0u; mine = (j == x) ? c : mine; }
    if (sum == G) break;
    __builtin_amdgcn_s_sleep(1);
    if ((++sp & 255u) == 0u) { if (xb_ld(&bar[XB_TMO])) break; if (sp > XB_SPIN_CAP) { atomicAdd(&bar[XB_TMO], 1u); break; } }
  }
  nloc = mine > 0u ? mine : 1u; nx = cnt > 0u ? cnt : 1u;
}
DI void xcd_barrier(const XcdBarrier& b) {
  asm volatile("s_waitcnt vmcnt(0)" ::: "memory");
  __syncthreads();
  if (threadIdx.x == 0) {
    unsigned* bar = b.bar;
    __builtin_amdgcn_s_waitcnt(0);
    unsigned nloc = b.st[0], nx = b.st[1];
    if (nloc == 0u) { xcd_barrier_complete(bar, b.x, nloc, nx); b.st[0] = nloc; b.st[1] = nx; }
    const unsigned old = xb_add(&bar[XB_XSUB(b.x)], 1u);
    const unsigned gen = old / nloc;
    if (old + 1u == (gen + 1u) * nloc) {
      __builtin_amdgcn_fence(__ATOMIC_RELEASE, "agent");
      asm volatile("s_waitcnt vmcnt(0)" ::: "memory");
      const unsigned og = xb_add(&bar[XB_TOP], 1u);
      const unsigned tg = og / nx;
      if (og + 1u == (tg + 1u) * nx) xb_add(&bar[XB_TOPGEN], 1u);
      else XB_SPIN(xb_ld(&bar[XB_TOPGEN]) == tg, bar);
      __builtin_amdgcn_fence(__ATOMIC_ACQUIRE, "agent");
      xb_add(&bar[XB_XGEN(b.x)], 1u);
      asm volatile("s_waitcnt vmcnt(0)" ::: "memory");
    } else {
      XB_SPIN(xb_ld(&bar[XB_XGEN(b.x)]) == gen, bar);
      __builtin_amdgcn_fence(__ATOMIC_ACQUIRE, "agent");
      asm volatile("s_waitcnt vmcnt(0)" ::: "memory");
    }
  }
  __syncthreads();
}

constexpr int NPHASE = 2 + 10 * DEPTH;

DI void run_phase(const Params& P, int ph, char* smem, int flags) {
  if (ph == 0) { phase_prep0(P, smem); return; }
  if (ph == 1) { phase_prep1(P, smem); return; }
  const int l = (ph - 2) / 10, sub = (ph - 2) % 10;
  switch (sub) {
    case 0: phase_g1(P, l, smem); break;
    case 1: phase_rowpass(P, l); break;
    case 2: phase_mid(P, l, smem); break;
    case 3: phase_mix(P, l, smem, flags); break;
    case 4: phase_gate(P, l, smem); break;
    case 5: phase_g6(P, l, smem); break;
    case 6: phase_resid(P, P.post_mix + l * 1024, P.pre_ffn + l * 1024, false, true); break;
    case 7: phase_g7(P, l, smem); break;
    case 8: phase_g8(P, l, smem); break;
    default: phase_resid(P, P.post_ffn + l * 1024, P.pre_mix + (l < 3 ? l + 1 : 0) * 1024, l == 3, false); break;
  }
}

template <bool COOP>
__global__ void __launch_bounds__(256, 2) mega_kernel(Params P, int ph0, int ph1, int flags) {
  __shared__ __attribute__((aligned(16))) char smem[SMEM_BYTES];
  if (COOP) {
    __shared__ uint4 xb_words;
    if (threadIdx.x == 0) xb_words = make_uint4(0u, 0u, 0u, 0u);
    __syncthreads();
    XcdBarrier xb = xcd_barrier_post((unsigned*)(P.ws + O_BAR), (volatile LAS unsigned*)&xb_words);
    for (int ph = ph0; ph < ph1; ++ph) {
      run_phase(P, ph, smem, flags);
      if (ph + 1 < ph1) {
        if (flags == 0x7fffffff) cg::this_grid().sync();
        xcd_barrier(xb);
      }
    }
  } else {
    for (int ph = ph0; ph < ph1; ++ph) run_phase(P, ph, smem, flags);
  }
}

extern "C" void kernel_launch(void* const* d_in, const int* in_sizes, int n_in, void* d_out, int out_size, void* d_ws,
                              size_t ws_size, hipStream_t stream) {
  Params P{};
  const float** pp = (const float**)&P;
  for (int i = 0; i < 25; ++i) pp[i] = (const float*)d_in[i];
  P.out = (float*)d_out;
  P.ws = (char*)d_ws;
  if (ws_size < O_END) { fprintf(stderr, "workspace too small: %zu < %zu\n", ws_size, (size_t)O_END); return; }
#if ONE_LAUNCH
  static int grid_blocks = 0;
  if (!grid_blocks) {
    int dev = 0, cus = 0, per_cu = 0;
    hipGetDevice(&dev);
    hipDeviceGetAttribute(&cus, hipDeviceAttributeMultiprocessorCount, dev);
    hipOccupancyMaxActiveBlocksPerMultiprocessor(&per_cu, mega_kernel<true>, 256, 0);
    if (per_cu > 2) per_cu = 2;
    grid_blocks = cus * per_cu;
  }
  hipMemsetAsync((char*)d_ws + O_BAR, 0, XCD_BAR_WORDS * 4, stream);
  int ph0 = 0, ph1 = NPHASE, flags = 0;
  void* args[] = {&P, &ph0, &ph1, &flags};
  hipError_t e = hipLaunchCooperativeKernel((void*)mega_kernel<true>, dim3(grid_blocks), dim3(256), args, 0, stream);
  if (e != hipSuccess) fprintf(stderr, "cooperative launch failed: %s (grid %d)\n", hipGetErrorString(e), grid_blocks);
#else
  for (int ph = 0; ph < NPHASE; ++ph) {
    mega_kernel<false><<<512, 256, 0, stream>>>(P, ph, ph + 1, 0);
    if ((ph >= 2 && ((PROBE_MASK >> ((ph - 2) % 10)) & 1)) || (ph < 2 && ((PROBE_MASK >> (10 + ph)) & 1))) {
      if (ph >= 2 && (ph - 2) % 10 == 3) hipMemsetAsync((char*)d_ws + O_CTR, 0, 256, stream);
      mega_kernel<false><<<512, 256, 0, stream>>>(P, ph, ph + 1, PROBE_FLAGS);
    }
  }
#endif
}
```

```cpp
#include <hip/hip_runtime.h>
#include <hip/hip_cooperative_groups.h>
#include <cstdio>
namespace cg = cooperative_groups;

#ifndef ONE_LAUNCH
#define ONE_LAUNCH 1
#endif
#ifndef PROBE_MASK
#define PROBE_MASK 0
#endif
#ifndef PROBE_FLAGS
#define PROBE_FLAGS 0
#endif

#define DI __device__ __forceinline__
typedef unsigned short ushort_t;
typedef short bf16x8 __attribute__((ext_vector_type(8)));
typedef short s16x4 __attribute__((ext_vector_type(4)));
typedef float f32x16 __attribute__((ext_vector_type(16)));
typedef float f32x2v __attribute__((ext_vector_type(2)));
typedef __bf16 bf16x2v __attribute__((ext_vector_type(2)));
typedef unsigned u32x4 __attribute__((ext_vector_type(4)));
#define MFMA(a, b, c) __builtin_amdgcn_mfma_f32_32x32x16_bf16((a), (b), (c), 0, 0, 0)

constexpr int DM = 1024, LTOK = 16400, DEPTH = 4, DECB = 32, DECT = 16, PAST = 4096;
constexpr int POFF = 48, PEND = 16448, SOFF = 16512, MTOT = 17024;
constexpr int NCH = 257, NITEM = NCH * 4;
constexpr int INP = 2816, DFF = 2816;
constexpr int OFF_KV = 384, OFF_PE = 640, OFF_QKV = 672, OFF_Z = 2208, OFF_B = 2720, OFF_A = 2724, INW = 2728;
constexpr float EPS = 1e-6f;
constexpr float QSCALE = 0.10206207261596577f * 1.4426950408889634f;
constexpr int SMEM_BYTES = 75776 + 16;

constexpr size_t OUT_YP = 0;
constexpr size_t OUT_YS = OUT_YP + (size_t)16384 * 1024;
constexpr size_t OUT_PLAT = OUT_YS + (size_t)512 * 1024;
constexpr size_t OUT_PPE = OUT_PLAT + (size_t)4 * LTOK * 256;
constexpr size_t OUT_PGDN = OUT_PPE + (size_t)4 * LTOK * 32;
constexpr size_t OUT_PCONV = OUT_PGDN + (size_t)4 * 4 * 128 * 128;
constexpr size_t OUT_SLAT = OUT_PCONV + (size_t)4 * 3 * 1536;
constexpr size_t OUT_SPE = OUT_SLAT + (size_t)4 * 32 * 16 * 256;
constexpr size_t OUT_SGDN = OUT_SPE + (size_t)4 * 32 * 16 * 32;
constexpr size_t OUT_SCONV = OUT_SGDN + (size_t)4 * 32 * 4 * 128 * 128;

constexpr size_t al256(size_t x) { return (x + 255) & ~(size_t)255; }
constexpr size_t E_WT_IN = 0;
constexpr size_t E_WT_UQ = E_WT_IN + (size_t)2816 * 1024;
constexpr size_t E_WUQ_BF = E_WT_UQ + (size_t)768 * 384;
constexpr size_t E_WT_UKV = E_WUQ_BF + (size_t)384 * 768;
constexpr size_t E_WUK_BF = E_WT_UKV + (size_t)1024 * 256;
constexpr size_t E_WUV_BF = E_WUK_BF + (size_t)256 * 512;
constexpr size_t E_WABS = E_WUV_BF + (size_t)256 * 512;
constexpr size_t E_WT_O = E_WABS + (size_t)2048 * 384;
constexpr size_t E_WT_OS = E_WT_O + (size_t)1024 * 1024;
constexpr size_t E_WT_GU = E_WT_OS + (size_t)1024 * 2560;
constexpr size_t E_WT_DOWN = E_WT_GU + (size_t)5632 * 1024;
constexpr size_t E_WL = E_WT_DOWN + (size_t)1024 * 2816;

constexpr size_t O_CTR = 0;
constexpr size_t O_BAR = 1024;
constexpr size_t O_W = 16384;
constexpr size_t O_X = al256(O_W + 4 * E_WL * 2);
constexpr size_t O_XN = al256(O_X + (size_t)MTOT * 1024 * 4);
constexpr size_t O_PROJ = al256(O_XN + (size_t)MTOT * 1024 * 2);
constexpr size_t O_CQN = al256(O_PROJ + (size_t)MTOT * INP * 4);
constexpr size_t O_CKV = al256(O_CQN + (size_t)MTOT * 384 * 2);
constexpr size_t O_KPE = al256(O_CKV + (size_t)MTOT * 256 * 2);
constexpr size_t O_QF = al256(O_KPE + (size_t)MTOT * 32 * 2);
constexpr size_t O_QL = al256(O_QF + (size_t)MTOT * 768 * 2);
constexpr size_t O_KF = al256(O_QL + (size_t)512 * 2048 * 2);
constexpr size_t O_VV = al256(O_KF + (size_t)SOFF * 768 * 2);
constexpr size_t O_GQ = al256(O_VV + (size_t)SOFF * 512 * 2);
constexpr size_t O_GK = al256(O_GQ + (size_t)MTOT * 512 * 4);
constexpr size_t O_GV = al256(O_GK + (size_t)MTOT * 512 * 4);
constexpr size_t O_GB = al256(O_GV + (size_t)MTOT * 512 * 4);
constexpr size_t O_GG = al256(O_GB + (size_t)MTOT * 4 * 4);
constexpr size_t O_UT = al256(O_GG + (size_t)MTOT * 4 * 4);
constexpr size_t O_WN = al256(O_UT + (size_t)NITEM * 8192 * 4);
constexpr size_t O_QG = al256(O_WN + (size_t)NITEM * 8192 * 2);
constexpr size_t O_KDT = al256(O_QG + (size_t)NITEM * 8192 * 2);
constexpr size_t O_QKM = al256(O_KDT + (size_t)NITEM * 8192 * 2);
constexpr size_t O_GL = al256(O_QKM + (size_t)NITEM * 4096 * 2);
constexpr size_t O_OG = al256(O_GL + (size_t)NITEM * 4);
constexpr size_t O_MIX = al256(O_OG + (size_t)MTOT * 512 * 4);
constexpr size_t O_MIXS = al256(O_MIX + (size_t)MTOT * 1024 * 2);
constexpr size_t O_PO = al256(O_MIXS + (size_t)512 * 2560 * 2);
constexpr size_t O_PML = al256(O_PO + (size_t)32 * 8 * 128 * 256 * 4);
constexpr size_t O_OMIX = al256(O_PML + (size_t)32 * 8 * 128 * 2 * 4);
constexpr size_t O_ACT = al256(O_OMIX + (size_t)MTOT * 1024 * 4);
constexpr size_t O_X2 = al256(O_ACT + (size_t)MTOT * DFF * 2);
constexpr size_t O_AN = al256(O_X2 + (size_t)MTOT * 1024 * 4);
constexpr size_t O_BN = al256(O_AN + (size_t)NITEM * 16384 * 2);
constexpr size_t O_SPK = al256(O_BN + (size_t)NITEM * 16384 * 4);
constexpr size_t O_END = al256(O_SPK + (size_t)NITEM * 32768);

struct Params {
  const float *x_prompt, *x_sample, *cache_lat, *cache_pe, *state_gdn, *state_conv, *meta, *pre_mix, *w_in, *q_norm,
      *kv_norm, *w_uq, *w_uk, *w_uv, *conv_w, *a_log, *dt_bias, *gdn_norm, *w_o, *post_mix, *pre_ffn, *w_gate, *w_up,
      *w_down, *post_ffn;
  float* out;
  char* ws;
};

DI unsigned pk2(float a, float b) { f32x2v f = {a, b}; bf16x2v r = __builtin_convertvector(f, bf16x2v); return __builtin_bit_cast(unsigned, r); }
DI ushort_t f2bf(float x) { return (ushort_t)(pk2(x, 0.f) & 0xffffu); }
DI float bf2f(ushort_t u) { return __uint_as_float(((unsigned)u) << 16); }
DI int crow(int reg, int h) { return (reg & 3) + 8 * (reg >> 2) + 4 * h; }
DI f32x16 zero16() { f32x16 z;
#pragma unroll
  for (int i = 0; i < 16; ++i) z[i] = 0.f; return z; }
template <int S> DI bf16x8 pack8(const f32x16& x) {
  u32x4 p;
  p[0] = pk2(x[8 * S + 0], x[8 * S + 1]); p[1] = pk2(x[8 * S + 2], x[8 * S + 3]);
  p[2] = pk2(x[8 * S + 4], x[8 * S + 5]); p[3] = pk2(x[8 * S + 6], x[8 * S + 7]);
  return __builtin_bit_cast(bf16x8, p);
}
DI float wave_sum(float v) {
#pragma unroll
  for (int d = 32; d >= 1; d >>= 1) v += __shfl_xor(v, d, 64);
  return v;
}
DI float swap_max(float m) { auto rr = __builtin_amdgcn_permlane32_swap(__float_as_uint(m), __float_as_uint(m), false, false); return fmaxf(__uint_as_float(rr[0]), __uint_as_float(rr[1])); }
DI float swap_sum(float m) { auto rr = __builtin_amdgcn_permlane32_swap(__float_as_uint(m), __float_as_uint(m), false, false); return __uint_as_float(rr[0]) + __uint_as_float(rr[1]); }
typedef short v4i16_t __attribute__((ext_vector_type(4)));
DI s16x4 vtr(const ushort_t* p) { return __builtin_bit_cast(s16x4, __builtin_amdgcn_ds_read_tr16_b64_v4i16((__attribute__((address_space(3))) v4i16_t*)p)); }
DI bf16x8 cat8(s16x4 lo, s16x4 hi) { return __builtin_shufflevector(lo, hi, 0, 1, 2, 3, 4, 5, 6, 7); }
DI bf16x8 fragP(const ushort_t* base, int h) { s16x4 lo = *(const s16x4*)(base + 4 * h); s16x4 hi = *(const s16x4*)(base + 8 + 4 * h); return cat8(lo, hi); }
DI unsigned xcc_id_early() { return (unsigned)__builtin_amdgcn_s_getreg((3 << 11) | 20) & 0xFu; }
DI int get_tid() { int t = threadIdx.x; asm volatile("" : "+v"(t)); return t; }
DI float siluf(float x) { return x * __builtin_amdgcn_rcpf(1.f + __expf(-x)); }
DI float row_pos(int row) { return row < SOFF ? (float)(row - POFF) : (float)(16 + PAST + ((row - SOFF) & 15)); }
DI bool row_valid(int row) { return row >= SOFF || (row >= POFF && row < PEND); }
DI float rope_inv(int j) { return exp2f(-(float)j * (13.287712379549449f / 16.f)); }

constexpr int GP = 72;
template <class Epi>
DI void gemm_tile(const ushort_t* __restrict__ A, int lda, const ushort_t* __restrict__ Wt, int ldb, int K, int m0, int n0,
                  char* smem, Epi epi) {
  ushort_t* L0 = (ushort_t*)smem;
  ushort_t* L1 = L0 + 256 * GP;
  const int tid = get_tid(), lane = tid & 63, wave = tid >> 6, r = lane & 31, h = lane >> 5;
  const int wm = wave >> 1, wn = wave & 1;
  const int lrow = tid >> 3, lcol = (tid & 7) * 8;
  const ushort_t* Ag = A + (size_t)(m0 + lrow) * lda + lcol;
  const ushort_t* Bg = Wt + (size_t)(n0 + lrow) * ldb + lcol;
  const size_t a32 = (size_t)32 * lda, b32 = (size_t)32 * ldb;
  u32x4 pa0, pa1, pa2, pa3, pb0, pb1, pb2, pb3;
  u32x4 qa0, qa1, qa2, qa3, qb0, qb1, qb2, qb3;
#define G_LOAD0(kk) { pa0 = *(const u32x4*)(Ag + (kk)); pa1 = *(const u32x4*)(Ag + a32 + (kk)); pa2 = *(const u32x4*)(Ag + 2 * a32 + (kk)); pa3 = *(const u32x4*)(Ag + 3 * a32 + (kk)); \
                      pb0 = *(const u32x4*)(Bg + (kk)); pb1 = *(const u32x4*)(Bg + b32 + (kk)); pb2 = *(const u32x4*)(Bg + 2 * b32 + (kk)); pb3 = *(const u32x4*)(Bg + 3 * b32 + (kk)); }
#define G_LOAD1(kk) { qa0 = *(const u32x4*)(Ag + (kk)); qa1 = *(const u32x4*)(Ag + a32 + (kk)); qa2 = *(const u32x4*)(Ag + 2 * a32 + (kk)); qa3 = *(const u32x4*)(Ag + 3 * a32 + (kk)); \
                      qb0 = *(const u32x4*)(Bg + (kk)); qb1 = *(const u32x4*)(Bg + b32 + (kk)); qb2 = *(const u32x4*)(Bg + 2 * b32 + (kk)); qb3 = *(const u32x4*)(Bg + 3 * b32 + (kk)); }
#define L_STORE0(L) { ushort_t* la = (L) + lrow * GP + lcol; ushort_t* lb = la + 128 * GP; \
                      *(u32x4*)(la) = pa0; *(u32x4*)(la + 32 * GP) = pa1; *(u32x4*)(la + 64 * GP) = pa2; *(u32x4*)(la + 96 * GP) = pa3; \
                      *(u32x4*)(lb) = pb0; *(u32x4*)(lb + 32 * GP) = pb1; *(u32x4*)(lb + 64 * GP) = pb2; *(u32x4*)(lb + 96 * GP) = pb3; }
#define L_STORE1(L) { ushort_t* la = (L) + lrow * GP + lcol; ushort_t* lb = la + 128 * GP; \
                      *(u32x4*)(la) = qa0; *(u32x4*)(la + 32 * GP) = qa1; *(u32x4*)(la + 64 * GP) = qa2; *(u32x4*)(la + 96 * GP) = qa3; \
                      *(u32x4*)(lb) = qb0; *(u32x4*)(lb + 32 * GP) = qb1; *(u32x4*)(lb + 64 * GP) = qb2; *(u32x4*)(lb + 96 * GP) = qb3; }
#define G_COMPUTE(L) { const ushort_t* As = (L); const ushort_t* Bs = (L) + 128 * GP; \
    _Pragma("unroll") for (int ks = 0; ks < 4; ++ks) { \
      const bf16x8 af0 = *(const bf16x8*)(As + (64 * wm + r) * GP + ks * 16 + h * 8); \
      const bf16x8 af1 = *(const bf16x8*)(As + (64 * wm + 32 + r) * GP + ks * 16 + h * 8); \
      const bf16x8 bf0 = *(const bf16x8*)(Bs + (64 * wn + r) * GP + ks * 16 + h * 8); \
      const bf16x8 bf1 = *(const bf16x8*)(Bs + (64 * wn + 32 + r) * GP + ks * 16 + h * 8); \
      acc00 = MFMA(bf0, af0, acc00); acc01 = MFMA(bf1, af0, acc01); acc10 = MFMA(bf0, af1, acc10); acc11 = MFMA(bf1, af1, acc11); } }
  f32x16 acc00 = zero16(), acc01 = zero16(), acc10 = zero16(), acc11 = zero16();
  __syncthreads();
  if (K == 64) {
    G_LOAD0(0);
    L_STORE0(L0);
    __syncthreads();
    G_COMPUTE(L0);
    __syncthreads();
  } else {
    const int klast = K - 64;
    G_LOAD0(0);
    G_LOAD1(64);
    L_STORE0(L0);
    G_LOAD0(min(128, klast));
    __syncthreads();
    for (int k0 = 0; k0 < K; k0 += 128) {
      G_COMPUTE(L0);
      L_STORE1(L1);
      G_LOAD1(min(k0 + 192, klast));
      __syncthreads();
      G_COMPUTE(L1);
      L_STORE0(L0);
      G_LOAD0(min(k0 + 256, klast));
      __syncthreads();
    }
  }
#undef G_LOAD0
#undef G_LOAD1
#undef L_STORE0
#undef L_STORE1
#undef G_COMPUTE
  epi(m0 + 64 * wm + r, n0 + 64 * wn, acc00, acc01, h);
  epi(m0 + 64 * wm + 32 + r, n0 + 64 * wn, acc10, acc11, h);
}

template <class Epi>
DI void gemm_tile_w(const ushort_t* __restrict__ A, int lda, const ushort_t* __restrict__ Wt, int ldb, int K, int m0, int n0,
                    char* smem, Epi epi) {
  ushort_t* As = (ushort_t*)smem;
  ushort_t* Bs = As + 128 * GP;
  const int tid = get_tid(), lane = tid & 63, wave = tid >> 6, r = lane & 31, h = lane >> 5;
  const int wm = wave >> 1, wn = wave & 1;
  const int lrow = tid >> 3, lcol = (tid & 7) * 8;
  const ushort_t* Ag = A + (size_t)(m0 + lrow) * lda + lcol;
  const ushort_t* Bg = Wt + (size_t)(n0 + lrow) * ldb + lcol;
  const size_t a32 = (size_t)32 * lda, b32 = (size_t)32 * ldb;
  u32x4 ra[4], rb[8];
#pragma unroll
  for (int i = 0; i < 4; ++i) ra[i] = *(const u32x4*)(Ag + i * a32);
#pragma unroll
  for (int i = 0; i < 8; ++i) rb[i] = *(const u32x4*)(Bg + i * b32);
  f32x16 acc[2][4];
#pragma unroll
  for (int mi = 0; mi < 2; ++mi)
#pragma unroll
    for (int ni = 0; ni < 4; ++ni) acc[mi][ni] = zero16();
  for (int k0 = 0; k0 < K; k0 += 64) {
    __syncthreads();
#pragma unroll
    for (int i = 0; i < 4; ++i) *(u32x4*)(As + (lrow + 32 * i) * GP + lcol) = ra[i];
#pragma unroll
    for (int i = 0; i < 8; ++i) *(u32x4*)(Bs + (lrow + 32 * i) * GP + lcol) = rb[i];
    __syncthreads();
    if (k0 + 64 < K) {
#pragma unroll
      for (int i = 0; i < 4; ++i) ra[i] = *(const u32x4*)(Ag + i * a32 + k0 + 64);
#pragma unroll
      for (int i = 0; i < 8; ++i) rb[i] = *(const u32x4*)(Bg + i * b32 + k0 + 64);
    }
#pragma unroll
    for (int ks = 0; ks < 4; ++ks) {
      bf16x8 af[2], bfv[4];
#pragma unroll
      for (int mi = 0; mi < 2; ++mi) af[mi] = *(const bf16x8*)(As + (64 * wm + 32 * mi + r) * GP + ks * 16 + h * 8);
#pragma unroll
      for (int ni = 0; ni < 4; ++ni) bfv[ni] = *(const bf16x8*)(Bs + (128 * wn + 32 * ni + r) * GP + ks * 16 + h * 8);
#pragma unroll
      for (int mi = 0; mi < 2; ++mi)
#pragma unroll
        for (int ni = 0; ni < 4; ++ni) acc[mi][ni] = MFMA(bfv[ni], af[mi], acc[mi][ni]);
    }
  }
#pragma unroll
  for (int mi = 0; mi < 2; ++mi) {
    epi(m0 + 64 * wm + 32 * mi + r, n0 + 128 * wn, acc[mi][0], acc[mi][1], h);
    epi(m0 + 64 * wm + 32 * mi + r, n0 + 128 * wn + 64, acc[mi][2], acc[mi][3], h);
  }
}

struct EpiF32 {
  float* C; int ldc;
  DI void operator()(int m, int nb, const f32x16& a0, const f32x16& a1, int h) const {
#pragma unroll
    for (int g = 0; g < 4; ++g) {
      *(float4*)(C + (size_t)m * ldc + nb + 8 * g + 4 * h) = make_float4(a0[4 * g], a0[4 * g + 1], a0[4 * g + 2], a0[4 * g + 3]);
      *(float4*)(C + (size_t)m * ldc + nb + 32 + 8 * g + 4 * h) = make_float4(a1[4 * g], a1[4 * g + 1], a1[4 * g + 2], a1[4 * g + 3]);
    }
  }
};
struct EpiBF16 {
  ushort_t* C; int ldc; float scale;
  DI void operator()(int m, int nb, const f32x16& a0, const f32x16& a1, int h) const {
#pragma unroll
    for (int g = 0; g < 4; ++g) {
      *(uint2*)(C + (size_t)m * ldc + nb + 8 * g + 4 * h) = make_uint2(pk2(a0[4 * g] * scale, a0[4 * g + 1] * scale), pk2(a0[4 * g + 2] * scale, a0[4 * g + 3] * scale));
      *(uint2*)(C + (size_t)m * ldc + nb + 32 + 8 * g + 4 * h) = make_uint2(pk2(a1[4 * g] * scale, a1[4 * g + 1] * scale), pk2(a1[4 * g + 2] * scale, a1[4 * g + 3] * scale));
    }
  }
};
struct EpiQ {
  ushort_t* QF;
  DI void one(int m, int nb, f32x16 a, int h) const {
    if ((nb % 96) == 64) {
      const float pos = row_pos(m);
#pragma unroll
      for (int i = 0; i < 8; ++i) {
        const int j = crow(i, h);
        float sn, cs; sincosf(pos * rope_inv(j), &sn, &cs);
        const float x1 = a[i], x2 = a[i + 8];
        a[i] = x1 * cs - x2 * sn; a[i + 8] = x1 * sn + x2 * cs;
      }
    }
#pragma unroll
    for (int g = 0; g < 4; ++g)
      *(uint2*)(QF + (size_t)m * 768 + nb + 8 * g + 4 * h) = make_uint2(pk2(a[4 * g] * QSCALE, a[4 * g + 1] * QSCALE), pk2(a[4 * g + 2] * QSCALE, a[4 * g + 3] * QSCALE));
  }
  DI void operator()(int m, int nb, const f32x16& a0, const f32x16& a1, int h) const { one(m, nb, a0, h); one(m, nb + 32, a1, h); }
};
struct EpiKV {
  ushort_t* KF; ushort_t* VV;
  DI void one(int m, int nb, const f32x16& a, int h) const {
#pragma unroll
    for (int g = 0; g < 4; ++g) {
      const int n = nb + 8 * g + 4 * h;
      uint2 v = make_uint2(pk2(a[4 * g], a[4 * g + 1]), pk2(a[4 * g + 2], a[4 * g + 3]));
      if (n < 512) *(uint2*)(KF + (size_t)m * 768 + (n >> 6) * 96 + (n & 63)) = v;
      else *(uint2*)(VV + (size_t)m * 512 + (n - 512)) = v;
    }
  }
  DI void operator()(int m, int nb, const f32x16& a0, const f32x16& a1, int h) const { one(m, nb, a0, h); one(m, nb + 32, a1, h); }
};
struct EpiSwiGLU {
  ushort_t* ACT;
  DI void operator()(int m, int nb, const f32x16& a0, const f32x16& a1, int h) const {
    const int cb = nb >> 1;
#pragma unroll
    for (int g = 0; g < 4; ++g) {
      float v0 = siluf(a0[4 * g]) * a1[4 * g], v1 = siluf(a0[4 * g + 1]) * a1[4 * g + 1];
      float v2 = siluf(a0[4 * g + 2]) * a1[4 * g + 2], v3 = siluf(a0[4 * g + 3]) * a1[4 * g + 3];
      *(uint2*)(ACT + (size_t)m * DFF + cb + 8 * g + 4 * h) = make_uint2(pk2(v0, v1), pk2(v2, v3));
    }
  }
};

DI void tconv_tile(const float* __restrict__ src, int K, int N, ushort_t* dst, int ldd, int mode, ushort_t* dst2, int kt, int nt, char* smem) {
  float* tile = (float*)smem;
  const int tid = get_tid();
  const int k0 = kt * 64, n0 = nt * 64;
  __syncthreads();
#pragma unroll
  for (int it = 0; it < 16; ++it) {
    int k = it * 4 + (tid >> 6), n = tid & 63;
    float v = (n0 + n < N) ? src[(size_t)(k0 + k) * N + n0 + n] : 0.f;
    tile[k * 65 + n] = v;
  }
  __syncthreads();
#pragma unroll
  for (int it = 0; it < 16; ++it) {
    int n = it * 4 + (tid >> 6), k = tid & 63;
    int gn = n0 + n;
    int row = gn;
    if (mode == 1) row = (gn >> 5) * 64 + (gn & 31);
    else if (mode == 2) row = (gn >> 5) * 64 + 32 + (gn & 31);
    ushort_t v = f2bf(tile[k * 65 + n]);
    dst[(size_t)row * ldd + k0 + k] = v;
    if (mode == 3 && k0 >= 512) dst2[(size_t)gn * 2560 + 2048 + (k0 - 512) + k] = v;
  }
}

DI void norm_store_row(const float (&v)[16], float* Xrow, ushort_t* XNrow, const float* w, int lane, bool valid) {
  float ss = 0.f;
#pragma unroll
  for (int i = 0; i < 16; ++i) ss += v[i] * v[i];
  ss = wave_sum(ss);
  const float rstd = rsqrtf(ss * (1.f / 1024.f) + EPS);
#pragma unroll
  for (int j = 0; j < 4; ++j) {
    const int c = 4 * lane + 256 * j;
    float4 wv = *(const float4*)(w + c);
    float o0 = valid ? v[4 * j] : 0.f, o1 = valid ? v[4 * j + 1] : 0.f, o2 = valid ? v[4 * j + 2] : 0.f, o3 = valid ? v[4 * j + 3] : 0.f;
    if (Xrow) *(float4*)(Xrow + c) = make_float4(o0, o1, o2, o3);
    *(uint2*)(XNrow + c) = make_uint2(pk2(o0 * rstd * wv.x, o1 * rstd * wv.y), pk2(o2 * rstd * wv.z, o3 * rstd * wv.w));
  }
}

DI void phase_prep0(const Params& P, char* smem) {
  ushort_t* W = (ushort_t*)(P.ws + O_W);
  const int tid = get_tid();
  if (blockIdx.x == 0 && tid < 64) ((int*)(P.ws + O_CTR))[tid] = 0;
  constexpr int T_IN = 704, T_UQ = 72, T_UK = 32, T_UV = 32, T_O = 256, T_G = 704, T_U = 704, T_D = 704;
  constexpr int TL = T_IN + T_UQ + T_UK + T_UV + T_O + T_G + T_U + T_D;
  for (int t = blockIdx.x; t < TL * 4; t += gridDim.x) {
    const int l = t / TL; int rm = t % TL;
    ushort_t* Wl = W + (size_t)l * E_WL;
    if (rm < T_IN) { tconv_tile(P.w_in + (size_t)l * 1024 * INW, 1024, INW, Wl + E_WT_IN, 1024, 0, nullptr, rm / 44, rm % 44, smem); continue; }
    rm -= T_IN;
    if (rm < T_UQ) { tconv_tile(P.w_uq + (size_t)l * 384 * 768, 384, 768, Wl + E_WT_UQ, 384, 0, nullptr, rm / 12, rm % 12, smem); continue; }
    rm -= T_UQ;
    if (rm < T_UK) { tconv_tile(P.w_uk + (size_t)l * 256 * 512, 256, 512, Wl + E_WT_UKV, 256, 0, nullptr, rm / 8, rm % 8, smem); continue; }
    rm -= T_UK;
    if (rm < T_UV) { tconv_tile(P.w_uv + (size_t)l * 256 * 512, 256, 512, Wl + E_WT_UKV + (size_t)512 * 256, 256, 0, nullptr, rm / 8, rm % 8, smem); continue; }
    rm -= T_UV;
    if (rm < T_O) { tconv_tile(P.w_o + (size_t)l * 1024 * 1024, 1024, 1024, Wl + E_WT_O, 1024, 3, Wl + E_WT_OS, rm / 16, rm % 16, smem); continue; }
    rm -= T_O;
    if (rm < T_G) { tconv_tile(P.w_gate + (size_t)l * 1024 * DFF, 1024, DFF, Wl + E_WT_GU, 1024, 1, nullptr, rm / 44, rm % 44, smem); continue; }
    rm -= T_G;
    if (rm < T_U) { tconv_tile(P.w_up + (size_t)l * 1024 * DFF, 1024, DFF, Wl + E_WT_GU, 1024, 2, nullptr, rm / 44, rm % 44, smem); continue; }
    rm -= T_U;
    tconv_tile(P.w_down + (size_t)l * DFF * 1024, DFF, 1024, Wl + E_WT_DOWN, DFF, 0, nullptr, rm / 16, rm % 16, smem);
  }
  const int gt = blockIdx.x * 256 + tid, gs = gridDim.x * 256;
  for (int l = 0; l < 4; ++l) {
    ushort_t* Wl = W + (size_t)l * E_WL;
    for (int i = gt; i < 384 * 768; i += gs) Wl[E_WUQ_BF + i] = f2bf(P.w_uq[(size_t)l * 384 * 768 + i]);
    for (int i = gt; i < 256 * 512; i += gs) { Wl[E_WUK_BF + i] = f2bf(P.w_uk[(size_t)l * 256 * 512 + i]); Wl[E_WUV_BF + i] = f2bf(P.w_uv[(size_t)l * 256 * 512 + i]); }
  }
  float* X = (float*)(P.ws + O_X);
  ushort_t* XN = (ushort_t*)(P.ws + O_XN);
  const int lane = tid & 63, gw = blockIdx.x * 4 + (tid >> 6), nw = gridDim.x * 4;
  for (int row = gw; row < MTOT; row += nw) {
    const bool valid = row_valid(row);
    const float* src = nullptr;
    if (valid) {
      if (row >= SOFF) src = P.x_sample + (size_t)(row - SOFF) * 1024;
      else if (row < POFF + 16) src = P.meta + (size_t)(row - POFF) * 1024;
      else src = P.x_prompt + (size_t)(row - POFF - 16) * 1024;
    }
    float v[16];
#pragma unroll
    for (int j = 0; j < 4; ++j) {
      float4 t = valid ? *(const float4*)(src + 4 * lane + 256 * j) : make_float4(0.f, 0.f, 0.f, 0.f);
      v[4 * j] = t.x; v[4 * j + 1] = t.y; v[4 * j + 2] = t.z; v[4 * j + 3] = t.w;
    }
    norm_store_row(v, X + (size_t)row * 1024, XN + (size_t)row * 1024, P.pre_mix, lane, valid);
  }
}

DI void phase_prep1(const Params& P, char* smem) {
  ushort_t* W = (ushort_t*)(P.ws + O_W);
  for (int t = blockIdx.x; t < 4 * 176; t += gridDim.x) {
    const int l = t / 176; int rm = t % 176;
    ushort_t* Wl = W + (size_t)l * E_WL;
    if (rm < 48) {
      const int hd = rm / 6, mt = (rm % 6) / 3, nt = rm % 3;
      gemm_tile(Wl + E_WUK_BF + hd * 64, 512, Wl + E_WUQ_BF + hd * 96, 768, 64, mt * 128, nt * 128, smem,
                EpiBF16{Wl + E_WABS + (size_t)hd * 256 * 384, 384, 1.f});
    } else {
      rm -= 48;
      const int hd = rm / 16, mt = (rm % 16) / 2, nt = rm % 2;
      gemm_tile(Wl + E_WT_O + hd * 64, 1024, Wl + E_WUV_BF + hd * 64, 512, 64, mt * 128, nt * 128, smem,
                EpiBF16{Wl + E_WT_OS + hd * 256, 2560, 1.f});
    }
  }
}

DI void phase_rowpass(const Params& P, int l) {
  const ushort_t* PROJ = (const ushort_t*)(P.ws + O_PROJ);
  ushort_t* CQN = (ushort_t*)(P.ws + O_CQN); ushort_t* CKV = (ushort_t*)(P.ws + O_CKV); ushort_t* KPE = (ushort_t*)(P.ws + O_KPE);
  ushort_t* KF = (ushort_t*)(P.ws + O_KF);
  float* GQ = (float*)(P.ws + O_GQ); float* GK = (float*)(P.ws + O_GK); float* GV = (float*)(P.ws + O_GV);
  float* GB = (float*)(P.ws + O_GB); float* GG = (float*)(P.ws + O_GG);
  const int tid = get_tid(), lane = tid & 63, gw = blockIdx.x * 4 + (tid >> 6), nw = gridDim.x * 4;
  const float* cw = P.conv_w + (size_t)l * 4 * 1536;
  for (int row = gw; row < MTOT; row += nw) {
    const ushort_t* pr = PROJ + (size_t)row * INP;
    const bool isP = row < SOFF, valid = row_valid(row);
    const int tok = row - POFF, sb = (row - SOFF) >> 4, st = (row - SOFF) & 15;
    const float pos = row_pos(row);
    {
      float v[6], ss = 0.f;
#pragma unroll
      for (int j = 0; j < 6; ++j) { v[j] = bf2f(pr[lane + 64 * j]); ss += v[j] * v[j]; }
      ss = wave_sum(ss);
      const float rstd = rsqrtf(ss * (1.f / 384.f) + EPS);
#pragma unroll
      for (int j = 0; j < 6; ++j) CQN[(size_t)row * 384 + lane + 64 * j] = f2bf(v[j] * rstd * P.q_norm[l * 384 + lane + 64 * j]);
    }
    {
      float v[4], ss = 0.f;
#pragma unroll
      for (int j = 0; j < 4; ++j) { v[j] = bf2f(pr[OFF_KV + lane + 64 * j]); ss += v[j] * v[j]; }
      ss = wave_sum(ss);
      const float rstd = rsqrtf(ss * (1.f / 256.f) + EPS);
      float* olat = nullptr;
      if (valid) olat = isP ? P.out + OUT_PLAT + ((size_t)l * LTOK + tok) * 256 : P.out + OUT_SLAT + (((size_t)l * 32 + sb) * 16 + st) * 256;
#pragma unroll
      for (int j = 0; j < 4; ++j) {
        const float o = v[j] * rstd * P.kv_norm[l * 256 + lane + 64 * j];
        CKV[(size_t)row * 256 + lane + 64 * j] = f2bf(o);
        if (valid) olat[lane + 64 * j] = o;
      }
    }
    {
      const float x = bf2f(pr[OFF_PE + (lane & 31)]);
      const float pt = __shfl_xor(x, 16, 64);
      float sn, cs; sincosf(pos * rope_inv(lane & 15), &sn, &cs);
      const float o = ((lane & 31) < 16) ? (x * cs - pt * sn) : (pt * sn + x * cs);
      if (lane < 32) {
        const ushort_t ob = f2bf(o);
        KPE[(size_t)row * 32 + lane] = ob;
        if (valid) {
          if (isP) P.out[OUT_PPE + ((size_t)l * LTOK + tok) * 32 + lane] = o;
          else P.out[OUT_SPE + (((size_t)l * 32 + sb) * 16 + st) * 32 + lane] = o;
        }
        if (isP) {
#pragma unroll
          for (int hh = 0; hh < 8; ++hh) KF[(size_t)row * 768 + hh * 96 + 64 + lane] = ob;
        }
      }
    }
    {
      const float* cs = P.state_conv + ((size_t)l * 32 + (isP ? 0 : sb)) * 3 * 1536;
#pragma unroll 4
      for (int s = 0; s < 12; ++s) {
        float u2[2];
#pragma unroll
        for (int e = 0; e < 2; ++e) {
          const int ch = s * 128 + e * 64 + lane;
          float y = 0.f;
          if (valid) {
            const float x0 = bf2f(pr[OFF_QKV + ch]);
            float xm1, xm2, xm3;
            if (isP) {
              xm1 = bf2f(pr[OFF_QKV + ch - INP]); xm2 = bf2f(pr[OFF_QKV + ch - 2 * INP]); xm3 = bf2f(pr[OFF_QKV + ch - 3 * INP]);
              if (row >= PEND - 3) P.out[OUT_PCONV + ((size_t)l * 3 + (row - (PEND - 3))) * 1536 + ch] = x0;
            } else {
              xm1 = (st >= 1) ? bf2f(pr[OFF_QKV + ch - INP]) : cs[(size_t)(2 + st) * 1536 + ch];
              xm2 = (st >= 2) ? bf2f(pr[OFF_QKV + ch - 2 * INP]) : cs[(size_t)(1 + st) * 1536 + ch];
              xm3 = (st >= 3) ? bf2f(pr[OFF_QKV + ch - 3 * INP]) : cs[(size_t)(st) * 1536 + ch];
              if (st >= 13) P.out[OUT_SCONV + (((size_t)l * 32 + sb) * 3 + (st - 13)) * 1536 + ch] = x0;
            }
            y = cw[3 * 1536 + ch] * x0 + cw[2 * 1536 + ch] * xm1 + cw[1 * 1536 + ch] * xm2 + cw[ch] * xm3;
          }
          u2[e] = siluf(y);
        }
        const float a = u2[0], b = u2[1];
        if (s < 8) {
          const float ss = wave_sum(a * a + b * b);
          float sc = rsqrtf(ss + EPS);
          if (s < 4) sc *= 0.08838834764831845f;
          float* dst = (s < 4 ? GQ : GK) + (size_t)row * 512 + (s & 3) * 128;
          dst[lane] = a * sc; dst[lane + 64] = b * sc;
        } else {
          float* dst = GV + (size_t)row * 512 + (s - 8) * 128;
          dst[lane] = a; dst[lane + 64] = b;
        }
      }
    }
    if (lane < 4) {
      float beta = 0.f, g = 0.f;
      if (valid) {
        const float bb = bf2f(pr[OFF_B + lane]), aa = bf2f(pr[OFF_A + lane]) + P.dt_bias[l * 4 + lane];
        beta = 1.f / (1.f + expf(-bb));
        const float sp = aa > 20.f ? aa : log1pf(expf(aa));
        g = -expf(P.a_log[l * 4 + lane]) * sp;
      }
      GB[(size_t)row * 4 + lane] = beta; GG[(size_t)row * 4 + lane] = g;
    }
  }
}

DI void gdn_prep(const Params& P, int item, char* smem) {
  const float* GQ = (const float*)(P.ws + O_GQ); const float* GK = (const float*)(P.ws + O_GK); const float* GV = (const float*)(P.ws + O_GV);
  const float* GB = (const float*)(P.ws + O_GB); const float* GG = (const float*)(P.ws + O_GG);
  float* UT = (float*)(P.ws + O_UT) + (size_t)item * 8192;
  ushort_t* WN = (ushort_t*)(P.ws + O_WN) + (size_t)item * 8192;
  ushort_t* QG = (ushort_t*)(P.ws + O_QG) + (size_t)item * 8192;
  ushort_t* AN = (ushort_t*)(P.ws + O_AN) + (size_t)item * 16384;
  float* BN = (float*)(P.ws + O_BN) + (size_t)item * 16384;
  ushort_t* WTs = (ushort_t*)smem;
  ushort_t* UTs = WTs + 128 * 72;
  ushort_t* KDTs = (ushort_t*)(smem + 53248);
  ushort_t* QKM = (ushort_t*)(P.ws + O_QKM) + (size_t)item * 4096;
  float* GL = (float*)(P.ws + O_GL);
  ushort_t* Ks = (ushort_t*)smem;
  ushort_t* Qs = Ks + 64 * 136;
  float* Ms = (float*)(smem + 34816);
  float* gcs = (float*)(smem + 52224);
  float* bts = gcs + 64;
  float* egs = bts + 64;
  const int tid = get_tid(), lane = tid & 63, wave = tid >> 6, r = lane & 31, h = lane >> 5;
  const int n = item >> 2, hd = item & 3, row0 = 64 * n;
  __syncthreads();
  if (wave == 0) {
    float x = GG[(size_t)(row0 + lane) * 4 + hd];
    const float bt = GB[(size_t)(row0 + lane) * 4 + hd];
#pragma unroll
    for (int d = 1; d < 64; d <<= 1) { float y = __shfl_up(x, d, 64); if (lane >= d) x += y; }
    gcs[lane] = x; bts[lane] = bt; egs[lane] = expf(x);
    if (lane == 63) GL[item] = expf(x);
  }
#pragma unroll
  for (int i = 0; i < 8; ++i) {
    const int idx = tid + 256 * i, row = idx >> 5, c4 = (idx & 31) * 4;
    const float4 kv = *(const float4*)(GK + (size_t)(row0 + row) * 512 + hd * 128 + c4);
    const float4 qv = *(const float4*)(GQ + (size_t)(row0 + row) * 512 + hd * 128 + c4);
    *(uint2*)(Ks + row * 136 + c4) = make_uint2(pk2(kv.x, kv.y), pk2(kv.z, kv.w));
    *(uint2*)(Qs + row * 136 + c4) = make_uint2(pk2(qv.x, qv.y), pk2(qv.z, qv.w));
  }
  __syncthreads();
  {
    const int bi = wave >> 1, bj = wave & 1;
    f32x16 kk = zero16(), qk = zero16();
#pragma unroll
    for (int s = 0; s < 8; ++s) {
      const bf16x8 bfr = *(const bf16x8*)(Ks + (32 * bj + r) * 136 + 16 * s + 8 * h);
      const bf16x8 ak = *(const bf16x8*)(Ks + (32 * bi + r) * 136 + 16 * s + 8 * h);
      const bf16x8 aq = *(const bf16x8*)(Qs + (32 * bi + r) * 136 + 16 * s + 8 * h);
      kk = MFMA(ak, bfr, kk); qk = MFMA(aq, bfr, qk);
    }
    const int j = 32 * bj + r;
    const float gcj = gcs[j];
#pragma unroll
    for (int rg = 0; rg < 16; ++rg) {
      const int i = 32 * bi + crow(rg, h);
      const float dec = (j <= i) ? expf(gcs[i] - gcj) : 0.f;
      Ms[i * 68 + j] = (j < i) ? bts[i] * kk[rg] * dec : 0.f;
      QKM[i * 64 + j] = f2bf(qk[rg] * dec);
    }
  }
#pragma unroll
  for (int i = 0; i < 8; ++i) {
    const int idx = tid + 256 * i, row = idx >> 5, c4 = (idx & 31) * 4;
    const float4 qv = *(const float4*)(GQ + (size_t)(row0 + row) * 512 + hd * 128 + c4);
    const float e = egs[row];
    *(uint2*)(QG + row * 128 + c4) = make_uint2(pk2(qv.x * e, qv.y * e), pk2(qv.z * e, qv.w * e));
  }
  {
    const int dk = tid & 127, ch = tid >> 7;
    const float gl = gcs[63];
    unsigned pkd[16];
#pragma unroll
    for (int cc = 0; cc < 16; ++cc) {
      const int c0 = 32 * ch + 2 * cc;
      const float a = GK[(size_t)(row0 + c0) * 512 + hd * 128 + dk] * expf(gl - gcs[c0]);
      const float b = GK[(size_t)(row0 + c0 + 1) * 512 + hd * 128 + dk] * expf(gl - gcs[c0 + 1]);
      pkd[cc] = pk2(a, b);
    }
#pragma unroll
    for (int q4 = 0; q4 < 4; ++q4)
      *(uint4*)(KDTs + dk * 72 + 32 * ch + 8 * q4) = make_uint4(pkd[4 * q4], pkd[4 * q4 + 1], pkd[4 * q4 + 2], pkd[4 * q4 + 3]);
  }
  __syncthreads();
  {
    const int col = tid & 127;
    const bool isW = tid >= 128;
    float x[64];
#pragma unroll
    for (int c = 0; c < 64; ++c) {
      const float bt = bts[c];
      x[c] = isW ? GK[(size_t)(row0 + c) * 512 + hd * 128 + col] * (bt * egs[c]) : GV[(size_t)(row0 + c) * 512 + hd * 128 + col] * bt;
    }
#pragma unroll
    for (int i = 1; i < 64; ++i) {
      float acc = x[i];
#pragma unroll
      for (int j = 0; j < i; ++j) acc -= Ms[i * 68 + j] * x[j];
      x[i] = acc;
    }
    __syncthreads();
    if (!isW) {
#pragma unroll
      for (int c = 0; c < 64; c += 4) *(float4*)(UT + col * 64 + c) = make_float4(x[c], x[c + 1], x[c + 2], x[c + 3]);
#pragma unroll
      for (int c = 0; c < 64; c += 8)
        *(uint4*)(UTs + col * 72 + c) = make_uint4(pk2(x[c], x[c + 1]), pk2(x[c + 2], x[c + 3]), pk2(x[c + 4], x[c + 5]), pk2(x[c + 6], x[c + 7]));
    } else {
#pragma unroll
      for (int c = 0; c < 64; ++c) WN[c * 128 + col] = f2bf(-x[c]);
#pragma unroll
      for (int c = 0; c < 64; c += 8)
        *(uint4*)(WTs + col * 72 + c) = make_uint4(pk2(-x[c], -x[c + 1]), pk2(-x[c + 2], -x[c + 3]), pk2(-x[c + 4], -x[c + 5]), pk2(-x[c + 6], -x[c + 7]));
    }
  }
  __syncthreads();
  {
    const int bi = wave;
    const float gl = expf(gcs[63]);
    bf16x8 kf[4];
#pragma unroll
    for (int sx = 0; sx < 4; ++sx) kf[sx] = *(const bf16x8*)(KDTs + (32 * bi + r) * 72 + 16 * sx + 8 * h);
#pragma unroll
    for (int bj = 0; bj < 4; ++bj) {
      f32x16 ab = zero16(), aa = zero16();
#pragma unroll
      for (int sx = 0; sx < 4; ++sx) {
        ab = MFMA(kf[sx], *(const bf16x8*)(UTs + (32 * bj + r) * 72 + 16 * sx + 8 * h), ab);
        aa = MFMA(*(const bf16x8*)(WTs + (32 * bj + r) * 72 + 16 * sx + 8 * h), kf[sx], aa);
      }
#pragma unroll
      for (int g = 0; g < 4; ++g) {
        *(float4*)(BN + (((bi * 4 + bj) * 4 + g) * 64 + lane) * 4) = make_float4(ab[4 * g], ab[4 * g + 1], ab[4 * g + 2], ab[4 * g + 3]);
        float a0 = aa[4 * g], a1 = aa[4 * g + 1], a2 = aa[4 * g + 2], a3 = aa[4 * g + 3];
        if (bi == bj) {
          const int jb = 8 * g + 4 * h;
          if (jb == r) a0 += gl;
          if (jb + 1 == r) a1 += gl;
          if (jb + 2 == r) a2 += gl;
          if (jb + 3 == r) a3 += gl;
        }
        *(uint2*)(AN + (32 * bi + r) * 128 + 32 * bj + 8 * g + 4 * h) = make_uint2(pk2(a0, a1), pk2(a2, a3));
      }
    }
  }
}

DI void gdn_sample(const Params& P, int l, int item, char* smem) {
  const float* GQ = (const float*)(P.ws + O_GQ); const float* GK = (const float*)(P.ws + O_GK); const float* GV = (const float*)(P.ws + O_GV);
  const float* GB = (const float*)(P.ws + O_GB); const float* GG = (const float*)(P.ws + O_GG);
  float* OG = (float*)(P.ws + O_OG);
  float* ks = (float*)smem;
  float* qs = ks + 2048;
  float* vs = qs + 2048;
  float* egb = vs + 2048;
  float* red = egb + 32;
  float* red2 = red + 256;
  const int tid = get_tid(), dv = tid & 127, half = tid >> 7;
  const int b = item >> 2, hd = item & 3, row0 = SOFF + 16 * b;
  __syncthreads();
#pragma unroll
  for (int i = 0; i < 8; ++i) {
    const int idx = tid + 256 * i, t = idx >> 7, c = idx & 127;
    ks[idx] = GK[(size_t)(row0 + t) * 512 + hd * 128 + c];
    qs[idx] = GQ[(size_t)(row0 + t) * 512 + hd * 128 + c];
    vs[idx] = GV[(size_t)(row0 + t) * 512 + hd * 128 + c];
  }
  if (tid < 16) { egb[2 * tid] = expf(GG[(size_t)(row0 + tid) * 4 + hd]); egb[2 * tid + 1] = GB[(size_t)(row0 + tid) * 4 + hd]; }
  const size_t sbase = ((((size_t)l * 32 + b) * 4 + hd) * 128 + 64 * half) * 128 + dv;
  float S[64];
#pragma unroll
  for (int i = 0; i < 64; ++i) S[i] = P.state_gdn[sbase + (size_t)i * 128];
  __syncthreads();
  for (int t = 0; t < 16; ++t) {
    const float eg = egb[2 * t], bt = egb[2 * t + 1];
    const float* kt = ks + t * 128 + 64 * half;
    const float* qt = qs + t * 128 + 64 * half;
    float acc = 0.f;
#pragma unroll
    for (int i = 0; i < 64; ++i) { S[i] *= eg; acc += kt[i] * S[i]; }
    red[half * 128 + dv] = acc;
    __syncthreads();
    const float kS = red[dv] + red[128 + dv];
    const float d = bt * (vs[t * 128 + dv] - kS);
    float acc2 = 0.f;
#pragma unroll
    for (int i = 0; i < 64; ++i) { S[i] += kt[i] * d; acc2 += qt[i] * S[i]; }
    red2[half * 128 + dv] = acc2;
    __syncthreads();
    if (half == 0) OG[(size_t)(row0 + t) * 512 + hd * 128 + dv] = red2[dv] + red2[128 + dv];
  }
#pragma unroll
  for (int i = 0; i < 64; ++i) P.out[OUT_SGDN + sbase + (size_t)i * 128] = S[i];
}

DI void gdn_scan(const Params& P, int l, int item, char* smem) {
  const ushort_t* ANg = (const ushort_t*)(P.ws + O_AN);
  const float* BNg = (const float*)(P.ws + O_BN);
  u32x4* SPK = (u32x4*)(P.ws + O_SPK);
  ushort_t* ST = (ushort_t*)smem;
  const int tid = get_tid(), lane = tid & 63, b = tid >> 6, r = lane & 31, h = lane >> 5;
  const int hd = item >> 2, dvs = item & 3;
  __syncthreads();
  for (int i = tid; i < 32 * 136 / 2; i += 256) ((unsigned*)ST)[i] = 0u;
  {
    const u32x4 z = {0u, 0u, 0u, 0u};
    SPK[((((size_t)(0 * 4 + hd) * 4 + dvs) * 4 + b) * 2 + 0) * 64 + lane] = z;
    SPK[((((size_t)(0 * 4 + hd) * 4 + dvs) * 4 + b) * 2 + 1) * 64 + lane] = z;
  }
  bf16x8 Ac[8]; f32x16 Bc;
  {
    const int it = hd;
#pragma unroll
    for (int sx = 0; sx < 8; ++sx) Ac[sx] = *(const bf16x8*)(ANg + (size_t)it * 16384 + (32 * b + r) * 128 + 16 * sx + 8 * h);
#pragma unroll
    for (int g = 0; g < 4; ++g) {
      const float4 t = *(const float4*)(BNg + (size_t)it * 16384 + (((b * 4 + dvs) * 4 + g) * 64 + lane) * 4);
      Bc[4 * g] = t.x; Bc[4 * g + 1] = t.y; Bc[4 * g + 2] = t.z; Bc[4 * g + 3] = t.w;
    }
  }
  f32x16 acc = zero16();
  for (int n = 0; n < NCH; ++n) {
    const int cur = n & 1;
    bf16x8 An[8]; f32x16 Bn;
    {
      const int it = (n + 1 < NCH ? n + 1 : n) * 4 + hd;
#pragma unroll
      for (int sx = 0; sx < 8; ++sx) An[sx] = *(const bf16x8*)(ANg + (size_t)it * 16384 + (32 * b + r) * 128 + 16 * sx + 8 * h);
#pragma unroll
      for (int g = 0; g < 4; ++g) {
        const float4 t = *(const float4*)(BNg + (size_t)it * 16384 + (((b * 4 + dvs) * 4 + g) * 64 + lane) * 4);
        Bn[4 * g] = t.x; Bn[4 * g + 1] = t.y; Bn[4 * g + 2] = t.z; Bn[4 * g + 3] = t.w;
      }
    }
    __syncthreads();
    const ushort_t* Sc = ST + cur * (32 * 136);
    f32x16 a0 = Bc, a1 = zero16();
#pragma unroll
    for (int sx = 0; sx < 8; sx += 2) {
      a0 = MFMA(Ac[sx], *(const bf16x8*)(Sc + r * 136 + 16 * sx + 8 * h), a0);
      a1 = MFMA(Ac[sx + 1], *(const bf16x8*)(Sc + r * 136 + 16 * (sx + 1) + 8 * h), a1);
    }
#pragma unroll
    for (int i = 0; i < 16; ++i) acc[i] = a0[i] + a1[i];
    const u32x4 p0 = __builtin_bit_cast(u32x4, pack8<0>(acc));
    const u32x4 p1 = __builtin_bit_cast(u32x4, pack8<1>(acc));
    ushort_t* Sn = ST + (cur ^ 1) * (32 * 136) + r * 136 + 32 * b + 4 * h;
    *(uint2*)(Sn) = make_uint2(p0[0], p0[1]);
    *(uint2*)(Sn + 8) = make_uint2(p0[2], p0[3]);
    *(uint2*)(Sn + 16) = make_uint2(p1[0], p1[1]);
    *(uint2*)(Sn + 24) = make_uint2(p1[2], p1[3]);
    if (n + 1 < NCH) {
      SPK[((((size_t)((n + 1) * 4 + hd) * 4 + dvs) * 4 + b) * 2 + 0) * 64 + lane] = p0;
      SPK[((((size_t)((n + 1) * 4 + hd) * 4 + dvs) * 4 + b) * 2 + 1) * 64 + lane] = p1;
    }
#pragma unroll
    for (int sx = 0; sx < 8; ++sx) Ac[sx] = An[sx];
    Bc = Bn;
  }
#pragma unroll
  for (int i = 0; i < 16; ++i)
    P.out[OUT_PGDN + (((size_t)l * 4 + hd) * 128 + 32 * b + crow(i, h)) * 128 + 32 * dvs + r] = acc[i];
}

DI void gdn_out(const Params& P, int l, int item, char* smem) {
  const float* UTg = (const float*)(P.ws + O_UT);
  const ushort_t* WNg = (const ushort_t*)(P.ws + O_WN); const ushort_t* QGg = (const ushort_t*)(P.ws + O_QG);
  const ushort_t* QKMg = (const ushort_t*)(P.ws + O_QKM);
  const u32x4* SPK = (const u32x4*)(P.ws + O_SPK);
  const ushort_t* PROJ = (const ushort_t*)(P.ws + O_PROJ);
  ushort_t* MIX = (ushort_t*)(P.ws + O_MIX);
  ushort_t* WNs = (ushort_t*)smem;
  ushort_t* QGs = WNs + 64 * 136;
  ushort_t* QKs = QGs + 64 * 136;
  float* Os = (float*)smem;
  const int tid = get_tid(), lane = tid & 63, wave = tid >> 6, r = lane & 31, h = lane >> 5;
  const int n = item >> 2, hd = item & 3, dv0 = 32 * wave;
  __syncthreads();
  {
    const ushort_t* wsrc = WNg + (size_t)item * 8192; const ushort_t* qsrc = QGg + (size_t)item * 8192;
    const ushort_t* msrc = QKMg + (size_t)item * 4096;
#pragma unroll
    for (int i = 0; i < 4; ++i) {
      const int c = tid + 256 * i;
      *(u32x4*)(WNs + (c >> 4) * 136 + (c & 15) * 8) = *(const u32x4*)(wsrc + c * 8);
      *(u32x4*)(QGs + (c >> 4) * 136 + (c & 15) * 8) = *(const u32x4*)(qsrc + c * 8);
    }
#pragma unroll
    for (int i = 0; i < 2; ++i) {
      const int c = tid + 256 * i;
      *(u32x4*)(QKs + (c >> 3) * 72 + (c & 7) * 8) = *(const u32x4*)(msrc + c * 8);
    }
  }
  f32x16 vn[2];
#pragma unroll
  for (int cb = 0; cb < 2; ++cb)
#pragma unroll
    for (int g = 0; g < 4; ++g) {
      const float4 t = *(const float4*)(UTg + (size_t)item * 8192 + (dv0 + r) * 64 + 32 * cb + 8 * g + 4 * h);
      vn[cb][4 * g] = t.x; vn[cb][4 * g + 1] = t.y; vn[cb][4 * g + 2] = t.z; vn[cb][4 * g + 3] = t.w;
    }
  bf16x8 Sp[4][2];
#pragma unroll
  for (int b = 0; b < 4; ++b)
#pragma unroll
    for (int sx = 0; sx < 2; ++sx) Sp[b][sx] = __builtin_bit_cast(bf16x8, SPK[((((size_t)item * 4 + wave) * 4 + b) * 2 + sx) * 64 + lane]);
  __syncthreads();
#pragma unroll
  for (int cb = 0; cb < 2; ++cb)
#pragma unroll
    for (int b = 0; b < 4; ++b)
#pragma unroll
      for (int sx = 0; sx < 2; ++sx) vn[cb] = MFMA(fragP(WNs + (32 * cb + r) * 136 + 32 * b + 16 * sx, h), Sp[b][sx], vn[cb]);
  bf16x8 Vp[2][2];
  Vp[0][0] = pack8<0>(vn[0]); Vp[0][1] = pack8<1>(vn[0]); Vp[1][0] = pack8<0>(vn[1]); Vp[1][1] = pack8<1>(vn[1]);
  f32x16 o[2];
#pragma unroll
  for (int cb = 0; cb < 2; ++cb) {
    o[cb] = zero16();
#pragma unroll
    for (int b = 0; b < 4; ++b)
#pragma unroll
      for (int sx = 0; sx < 2; ++sx) o[cb] = MFMA(fragP(QGs + (32 * cb + r) * 136 + 32 * b + 16 * sx, h), Sp[b][sx], o[cb]);
#pragma unroll
    for (int cb2 = 0; cb2 <= cb; ++cb2)
#pragma unroll
      for (int sx = 0; sx < 2; ++sx) o[cb] = MFMA(fragP(QKs + (32 * cb + r) * 72 + 32 * cb2 + 16 * sx, h), Vp[cb2][sx], o[cb]);
  }
  __syncthreads();
#pragma unroll
  for (int cb = 0; cb < 2; ++cb)
#pragma unroll
    for (int i = 0; i < 16; ++i) Os[(32 * cb + crow(i, h)) * 132 + dv0 + r] = o[cb][i];
  __syncthreads();
  const float gw0 = P.gdn_norm[l * 128 + lane], gw1 = P.gdn_norm[l * 128 + 64 + lane];
#pragma unroll 4
  for (int rr = 0; rr < 16; ++rr) {
    const int c = 16 * wave + rr, row = 64 * n + c;
    const float o0 = Os[c * 132 + lane], o1 = Os[c * 132 + 64 + lane];
    const float z0 = bf2f(PROJ[(size_t)row * INP + OFF_Z + hd * 128 + lane]), z1 = bf2f(PROJ[(size_t)row * INP + OFF_Z + hd * 128 + 64 + lane]);
    const float ss = wave_sum(o0 * o0 + o1 * o1);
    const float rstd = rsqrtf(ss * (1.f / 128.f) + EPS);
    MIX[(size_t)row * 1024 + 512 + hd * 128 + lane] = f2bf(o0 * rstd * gw0 * siluf(z0));
    MIX[(size_t)row * 1024 + 512 + hd * 128 + 64 + lane] = f2bf(o1 * rstd * gw1 * siluf(z1));
  }
}

template <int NDB>
DI void softmax_pv(f32x16 (&st)[2], f32x16 (&o)[NDB], float& m, float& l, const ushort_t* Vs, int vpitch, int vcol0, int lane) {
  const int h = lane >> 5, i16 = lane & 15, q = i16 >> 2, p = i16 & 3, blk = (lane >> 4) & 1;
  float mt = st[0][0];
#pragma unroll
  for (int kb = 0; kb < 2; ++kb)
#pragma unroll
    for (int i = 0; i < 16; ++i) mt = fmaxf(mt, st[kb][i]);
  mt = swap_max(mt);
  const float mn = fmaxf(m, mt);
  const float alpha = __builtin_amdgcn_exp2f(m - mn);
  m = mn;
  float ls = 0.f;
#pragma unroll
  for (int kb = 0; kb < 2; ++kb)
#pragma unroll
    for (int i = 0; i < 16; ++i) { const float pv = __builtin_amdgcn_exp2f(st[kb][i] - mn); st[kb][i] = pv; ls += pv; }
  l = l * alpha + ls;
#pragma unroll
  for (int db = 0; db < NDB; ++db)
#pragma unroll
    for (int i = 0; i < 16; ++i) o[db][i] *= alpha;
  const ushort_t* vb = Vs + (4 * h + q) * vpitch + vcol0 + 16 * blk + 4 * p;
  __builtin_amdgcn_s_setprio(1);
#pragma unroll
  for (int kb = 0; kb < 2; ++kb) {
    const bf16x8 p0 = pack8<0>(st[kb]);
    const bf16x8 p1 = pack8<1>(st[kb]);
#pragma unroll
    for (int db = 0; db < NDB; ++db) {
      const ushort_t* v0 = vb + (32 * kb) * vpitch + 32 * db;
      o[db] = MFMA(cat8(vtr(v0), vtr(v0 + 8 * vpitch)), p0, o[db]);
      o[db] = MFMA(cat8(vtr(v0 + 16 * vpitch), vtr(v0 + 24 * vpitch)), p1, o[db]);
    }
  }
  __builtin_amdgcn_s_setprio(0);
}

DI void attn_prompt(const Params& P, int qt, int head, char* smem) {
  const ushort_t* QF = (const ushort_t*)(P.ws + O_QF); const ushort_t* KF = (const ushort_t*)(P.ws + O_KF);
  const ushort_t* VV = (const ushort_t*)(P.ws + O_VV); ushort_t* MIX = (ushort_t*)(P.ws + O_MIX);
  constexpr int KP = 104, VP = 72;
  ushort_t* Kb = (ushort_t*)smem;
  ushort_t* Vb = Kb + 2 * 64 * KP;
  const int tid = get_tid(), lane = tid & 63, wave = tid >> 6, r = lane & 31, h = lane >> 5;
  const int qrow = 128 * qt + 32 * wave + r;
  const int cq = 2 * qt + (wave >> 1);
  const int ntile = 2 * qt + 2;
  bf16x8 qf[6];
#pragma unroll
  for (int s = 0; s < 6; ++s) qf[s] = *(const bf16x8*)(QF + (size_t)qrow * 768 + head * 96 + 16 * s + 8 * h);
  f32x16 o[2]; o[0] = zero16(); o[1] = zero16();
  float m = -1e30f, l = 0.f;
  u32x4 rk0, rk1, rk2, rv0, rv1;
  u32x4 sk0, sk1, sk2, sv0, sv1;
  const int kr0 = tid / 12, kc0 = tid % 12, kr1 = (tid + 256) / 12, kc1 = (tid + 256) % 12, kr2 = (tid + 512) / 12, kc2 = (tid + 512) % 12;
  const int vr0 = tid >> 3, vc0 = tid & 7, vr1 = (tid + 256) >> 3;
  const ushort_t* kg0 = KF + (size_t)kr0 * 768 + head * 96 + kc0 * 8;
  const ushort_t* kg1 = KF + (size_t)kr1 * 768 + head * 96 + kc1 * 8;
  const ushort_t* kg2 = KF + (size_t)kr2 * 768 + head * 96 + kc2 * 8;
  const ushort_t* vg0 = VV + (size_t)vr0 * 512 + head * 64 + vc0 * 8;
  const ushort_t* vg1 = VV + (size_t)vr1 * 512 + head * 64 + vc0 * 8;
#define ATT_GLOAD0(kt) { const size_t ko = (size_t)(kt) * 64 * 768, vo = (size_t)(kt) * 64 * 512; \
    rk0 = *(const u32x4*)(kg0 + ko); rk1 = *(const u32x4*)(kg1 + ko); rk2 = *(const u32x4*)(kg2 + ko); rv0 = *(const u32x4*)(vg0 + vo); rv1 = *(const u32x4*)(vg1 + vo); }
#define ATT_GLOAD1(kt) { const size_t ko = (size_t)(kt) * 64 * 768, vo = (size_t)(kt) * 64 * 512; \
    sk0 = *(const u32x4*)(kg0 + ko); sk1 = *(const u32x4*)(kg1 + ko); sk2 = *(const u32x4*)(kg2 + ko); sv0 = *(const u32x4*)(vg0 + vo); sv1 = *(const u32x4*)(vg1 + vo); }
#define ATT_LSTORE0(buf) { ushort_t* kd = Kb + (buf) * 64 * KP; ushort_t* vd = Vb + (buf) * 64 * VP; \
    *(u32x4*)(kd + kr0 * KP + kc0 * 8) = rk0; *(u32x4*)(kd + kr1 * KP + kc1 * 8) = rk1; *(u32x4*)(kd + kr2 * KP + kc2 * 8) = rk2; \
    *(u32x4*)(vd + vr0 * VP + vc0 * 8) = rv0; *(u32x4*)(vd + vr1 * VP + vc0 * 8) = rv1; }
#define ATT_LSTORE1(buf) { ushort_t* kd = Kb + (buf) * 64 * KP; ushort_t* vd = Vb + (buf) * 64 * VP; \
    *(u32x4*)(kd + kr0 * KP + kc0 * 8) = sk0; *(u32x4*)(kd + kr1 * KP + kc1 * 8) = sk1; *(u32x4*)(kd + kr2 * KP + kc2 * 8) = sk2; \
    *(u32x4*)(vd + vr0 * VP + vc0 * 8) = sv0; *(u32x4*)(vd + vr1 * VP + vc0 * 8) = sv1; }
#define ATT_COMPUTE(kt, buf) if ((kt) <= cq) { \
      const ushort_t* Ks = Kb + (buf) * 64 * KP; \
      f32x16 st[2]; st[0] = zero16(); st[1] = zero16(); \
      __builtin_amdgcn_s_setprio(1); \
      _Pragma("unroll") for (int s = 0; s < 6; ++s) { \
        _Pragma("unroll") for (int kb = 0; kb < 2; ++kb) st[kb] = MFMA(*(const bf16x8*)(Ks + (32 * kb + r) * KP + 16 * s + 8 * h), qf[s], st[kb]); } \
      __builtin_amdgcn_s_setprio(0); \
      if ((kt) == 0) { \
        _Pragma("unroll") for (int kb = 0; kb < 2; ++kb) \
          _Pragma("unroll") for (int i = 0; i < 16; ++i) if (32 * kb + crow(i, h) < POFF) st[kb][i] = -1e30f; } \
      softmax_pv<2>(st, o, m, l, Vb + (buf) * 64 * VP, VP, 0, lane); }
  __syncthreads();
  ATT_GLOAD0(0);
  ATT_GLOAD1(1);
  ATT_LSTORE0(0);
  const int lastt = ntile - 1;
  ATT_GLOAD0(min(2, lastt));
  __syncthreads();
  for (int kt = 0; kt < ntile; kt += 2) {
    ATT_COMPUTE(kt, 0);
    ATT_LSTORE1(1);
    ATT_GLOAD1(min(kt + 3, lastt));
    __syncthreads();
    ATT_COMPUTE(kt + 1, 1);
    ATT_LSTORE0(0);
    ATT_GLOAD0(min(kt + 4, lastt));
    __syncthreads();
  }
#undef ATT_GLOAD0
#undef ATT_GLOAD1
#undef ATT_LSTORE0
#undef ATT_LSTORE1
#undef ATT_COMPUTE
  const float inv = 1.f / swap_sum(l);
#pragma unroll
  for (int db = 0; db < 2; ++db)
#pragma unroll
    for (int g = 0; g < 4; ++g)
      *(uint2*)(MIX + (size_t)qrow * 1024 + head * 64 + 32 * db + 8 * g + 4 * h) =
          make_uint2(pk2(o[db][4 * g] * inv, o[db][4 * g + 1] * inv), pk2(o[db][4 * g + 2] * inv, o[db][4 * g + 3] * inv));
}

DI void attn_sample(const Params& P, int l, int b, int sp, int hg, char* smem) {
  const ushort_t* QF = (const ushort_t*)(P.ws + O_QF); const ushort_t* QL = (const ushort_t*)(P.ws + O_QL);
  const ushort_t* CKV = (const ushort_t*)(P.ws + O_CKV); const ushort_t* KPE = (const ushort_t*)(P.ws + O_KPE);
  float* PO = (float*)(P.ws + O_PO); float* PML = (float*)(P.ws + O_PML);
  constexpr int KP = 296;
  ushort_t* Qs = (ushort_t*)smem;
  ushort_t* Kt = Qs + 64 * KP;
  const int tid = get_tid(), lane = tid & 63, wave = tid >> 6, r = lane & 31, h = lane >> 5;
  const int qb = wave & 1, dvh = wave >> 1;
  __syncthreads();
#pragma unroll
  for (int i = 0; i < 9; ++i) {
    const int c = tid + 256 * i, q = c / 36, cc = c % 36;
    const int hh = q >> 4, tok = q & 15, head = 4 * hg + hh, srow = 16 * b + tok;
    uint4 v;
    if (cc < 32) v = *(const uint4*)(QL + (size_t)srow * 2048 + head * 256 + cc * 8);
    else v = *(const uint4*)(QF + (size_t)(SOFF + srow) * 768 + head * 96 + 64 + (cc - 32) * 8);
    *(uint4*)(Qs + q * KP + cc * 8) = v;
  }
  f32x16 o[4]; o[0] = zero16(); o[1] = zero16(); o[2] = zero16(); o[3] = zero16();
  float m = -1e30f, lsum = 0.f;
  const int nt = (sp == 7) ? 9 : 8;
  const float* clat = P.cache_lat + (((size_t)l * 32 + b) * PAST + (size_t)sp * 512) * 256;
  const float* cpe = P.cache_pe + (((size_t)l * 32 + b) * PAST + (size_t)sp * 512) * 32;
  for (int ti = 0; ti < nt; ++ti) {
    __syncthreads();
    if (ti < 8) {
      const float* lat = clat + (size_t)ti * 64 * 256;
#pragma unroll
      for (int bt = 0; bt < 2; ++bt) {
        float4 t[8];
#pragma unroll
        for (int i = 0; i < 8; ++i) t[i] = *(const float4*)(lat + (size_t)(tid + 256 * (8 * bt + i)) * 4);
#pragma unroll
        for (int i = 0; i < 8; ++i) {
          const int c = tid + 256 * (8 * bt + i), row = c >> 6, c4 = (c & 63) * 4;
          *(uint2*)(Kt + row * KP + c4) = make_uint2(pk2(t[i].x, t[i].y), pk2(t[i].z, t[i].w));
        }
      }
      const float* pe = cpe + (size_t)ti * 64 * 32;
#pragma unroll
      for (int i = 0; i < 2; ++i) {
        const int c = tid + 256 * i, row = c >> 3, c4 = (c & 7) * 4;
        const float4 t = *(const float4*)(pe + (size_t)c * 4);
        *(uint2*)(Kt + row * KP + 256 + c4) = make_uint2(pk2(t.x, t.y), pk2(t.z, t.w));
      }
    } else {
#pragma unroll
      for (int i = 0; i < 9; ++i) {
        const int c = tid + 256 * i, row = c / 36, cc = c % 36;
        uint4 v = make_uint4(0u, 0u, 0u, 0u);
        if (row < 16) {
          if (cc < 32) v = *(const uint4*)(CKV + (size_t)(SOFF + 16 * b + row) * 256 + cc * 8);
          else v = *(const uint4*)(KPE + (size_t)(SOFF + 16 * b + row) * 32 + (cc - 32) * 8);
        }
        *(uint4*)(Kt + row * KP + cc * 8) = v;
      }
    }
    __syncthreads();
    f32x16 st[2]; st[0] = zero16(); st[1] = zero16();
#pragma unroll
    for (int s = 0; s < 18; ++s) {
      const bf16x8 qv = *(const bf16x8*)(Qs + (32 * qb + r) * KP + 16 * s + 8 * h);
#pragma unroll
      for (int kb = 0; kb < 2; ++kb) st[kb] = MFMA(*(const bf16x8*)(Kt + (32 * kb + r) * KP + 16 * s + 8 * h), qv, st[kb]);
    }
    if (ti == 8) {
#pragma unroll
      for (int kb = 0; kb < 2; ++kb)
#pragma unroll
        for (int i = 0; i < 16; ++i) if (32 * kb + crow(i, h) >= 16) st[kb][i] = -1e30f;
    }
    softmax_pv<4>(st, o, m, lsum, Kt, KP, 128 * dvh, lane);
  }
  const float lt = swap_sum(lsum);
  const int gq = 64 * hg + 32 * qb + r;
  const size_t pbase = ((size_t)(b * 8 + sp) * 128 + gq);
  if (dvh == 0 && h == 0) { PML[pbase * 2] = m; PML[pbase * 2 + 1] = lt; }
#pragma unroll
  for (int db = 0; db < 4; ++db)
#pragma unroll
    for (int g = 0; g < 4; ++g)
      *(float4*)(PO + pbase * 256 + 128 * dvh + 32 * db + 8 * g + 4 * h) = make_float4(o[db][4 * g], o[db][4 * g + 1], o[db][4 * g + 2], o[db][4 * g + 3]);
}


DI bool tile_swz(int t, int MT, int NT, int& mt, int& nt) {
  const int G = gridDim.x, b = blockIdx.x;
  int u = t;
  if ((G & 7) == 0) u = (t / G) * G + (b & 7) * (G >> 3) + (b >> 3);
  if (u >= MT * NT) return false;
  const int full = (NT >> 3) * MT * 8;
  if (u < full) { const int g = u / (MT * 8), rem = u % (MT * 8); mt = rem >> 3; nt = g * 8 + (rem & 7); }
  else { const int rem = u - full, w = NT & 7; mt = rem / w; nt = (NT >> 3) * 8 + rem % w; }
  return true;
}
DI int round_up_grid(int n) { const int G = gridDim.x; return ((n + G - 1) / G) * G; }

DI void phase_g1(const Params& P, int l, char* smem) {
  const ushort_t* Wl = (const ushort_t*)(P.ws + O_W) + (size_t)l * E_WL;
  for (int t = blockIdx.x; t < round_up_grid(133 * 11); t += gridDim.x) {
    int mt, nt; if (!tile_swz(t, 133, 11, mt, nt)) continue;
    gemm_tile_w((const ushort_t*)(P.ws + O_XN), 1024, Wl + E_WT_IN, 1024, 1024, mt * 128, nt * 256, smem, EpiBF16{(ushort_t*)(P.ws + O_PROJ), INP, 1.f});
  }
}

DI void phase_mid(const Params& P, int l, char* smem) {
  const ushort_t* Wl = (const ushort_t*)(P.ws + O_W) + (size_t)l * E_WL;
  const ushort_t* CQN = (const ushort_t*)(P.ws + O_CQN);
  constexpr int N_G2 = 133 * 6, N_G2S = 4 * 16, N_G3 = 129 * 8, N_PREP = NITEM, N_GS = 128;
  constexpr int TOT = N_G2 + N_G2S + N_G3 + N_PREP + N_GS;
  for (int t0 = blockIdx.x; t0 < TOT; t0 += gridDim.x) {
    int t = t0;
    if (t < N_PREP) { gdn_prep(P, t, smem); continue; }
    t -= N_PREP;
    if (t < N_GS) { gdn_sample(P, l, t, smem); continue; }
    t -= N_GS;
    if (t < N_G3) { gemm_tile((const ushort_t*)(P.ws + O_CKV), 256, Wl + E_WT_UKV, 256, 256, (t / 8) * 128, (t % 8) * 128, smem, EpiKV{(ushort_t*)(P.ws + O_KF), (ushort_t*)(P.ws + O_VV)}); continue; }
    t -= N_G3;
    if (t < N_G2) { gemm_tile(CQN, 384, Wl + E_WT_UQ, 384, 384, (t / 6) * 128, (t % 6) * 128, smem, EpiQ{(ushort_t*)(P.ws + O_QF)}); continue; }
    t -= N_G2;
    gemm_tile(CQN, 384, Wl + E_WABS, 384, 384, SOFF + (t / 16) * 128, (t % 16) * 128, smem, EpiBF16{(ushort_t*)(P.ws + O_QL) - (size_t)SOFF * 2048, 2048, QSCALE});
  }
}

DI void phase_mix(const Params& P, int l, char* smem, int flags) {
  int* ctr = (int*)(P.ws + O_CTR) + l * 16;
  volatile int* slot = (volatile int*)(smem + 75776);
  const int myq = (int)(xcc_id_early() & 7u);
  if (threadIdx.x == 0) slot[1] = 0;
  while (true) {
    __syncthreads();
    if (threadIdx.x == 0) {
      int stg = slot[1], code = -1;
      while (stg < 10) {
        if (stg == 0) { const int t = atomicAdd(&ctr[0], 1); if (t < 16) { code = t; break; } stg = 1; }
        else if (stg == 2) { const int t = atomicAdd(&ctr[9], 1); if (t < 512) { code = 16 + 1032 + t; break; } stg = 3; }
        else { const int q = (stg == 1) ? myq : ((myq + stg - 2) & 7); const int t = atomicAdd(&ctr[1 + q], 1); if (t < 129) { code = 16 + (128 - t) * 8 + q; break; } ++stg; }
      }
      slot[1] = stg; slot[0] = code;
    }
    __syncthreads();
    int t = slot[0];
    if (t < 0) break;
    if (t < 16) { if (flags == 0 || flags == 1) gdn_scan(P, l, t, smem); continue; }
    t -= 16;
    if (t < 1032) { if (flags == 0 || flags == 2) attn_prompt(P, t >> 3, t & 7, smem); continue; }
    t -= 1032;
    if (flags == 0 || flags == 3) attn_sample(P, l, t >> 4, (t >> 1) & 7, t & 1, smem);
  }
}

DI void phase_gate(const Params& P, int l, char* smem) {
  const float* OG = (const float*)(P.ws + O_OG); const ushort_t* PROJ = (const ushort_t*)(P.ws + O_PROJ);
  ushort_t* MIX = (ushort_t*)(P.ws + O_MIX); ushort_t* MIXS = (ushort_t*)(P.ws + O_MIXS);
  const float* PO = (const float*)(P.ws + O_PO); const float* PML = (const float*)(P.ws + O_PML);
  const int tid = get_tid(), lane = tid & 63, gw = blockIdx.x * 4 + (tid >> 6), nw = gridDim.x * 4;
  for (int t = blockIdx.x; t < NITEM; t += gridDim.x) gdn_out(P, l, t, smem);
  for (int row = SOFF + gw; row < MTOT; row += nw) {
    const bool valid = row_valid(row);
#pragma unroll
    for (int hd = 0; hd < 4; ++hd) {
      float o0 = 0.f, o1 = 0.f, z0 = 0.f, z1 = 0.f;
      if (valid) {
        o0 = OG[(size_t)row * 512 + hd * 128 + lane]; o1 = OG[(size_t)row * 512 + hd * 128 + 64 + lane];
        z0 = bf2f(PROJ[(size_t)row * INP + OFF_Z + hd * 128 + lane]); z1 = bf2f(PROJ[(size_t)row * INP + OFF_Z + hd * 128 + 64 + lane]);
      }
      const float ss = wave_sum(o0 * o0 + o1 * o1);
      const float rstd = rsqrtf(ss * (1.f / 128.f) + EPS);
      const float v0 = o0 * rstd * P.gdn_norm[l * 128 + lane] * siluf(z0);
      const float v1 = o1 * rstd * P.gdn_norm[l * 128 + 64 + lane] * siluf(z1);
      if (row < SOFF) { MIX[(size_t)row * 1024 + 512 + hd * 128 + lane] = f2bf(v0); MIX[(size_t)row * 1024 + 512 + hd * 128 + 64 + lane] = f2bf(v1); }
      else { MIXS[(size_t)(row - SOFF) * 2560 + 2048 + hd * 128 + lane] = f2bf(v0); MIXS[(size_t)(row - SOFF) * 2560 + 2048 + hd * 128 + 64 + lane] = f2bf(v1); }
    }
  }
  for (int it = gw; it < 32 * 128; it += nw) {
    const int b = it >> 7, gq = it & 127, head = gq >> 4, tok = gq & 15;
    float ms[8], mx = -1e30f;
#pragma unroll
    for (int sp = 0; sp < 8; ++sp) { ms[sp] = PML[((size_t)(b * 8 + sp) * 128 + gq) * 2]; mx = fmaxf(mx, ms[sp]); }
    float L = 0.f; float4 acc = make_float4(0.f, 0.f, 0.f, 0.f);
#pragma unroll
    for (int sp = 0; sp < 8; ++sp) {
      const float w = __builtin_amdgcn_exp2f(ms[sp] - mx);
      L += w * PML[((size_t)(b * 8 + sp) * 128 + gq) * 2 + 1];
      const float4 t = *(const float4*)(PO + ((size_t)(b * 8 + sp) * 128 + gq) * 256 + lane * 4);
      acc.x += w * t.x; acc.y += w * t.y; acc.z += w * t.z; acc.w += w * t.w;
    }
    const float inv = 1.f / L;
    *(uint2*)(MIXS + (size_t)(16 * b + tok) * 2560 + head * 256 + lane * 4) = make_uint2(pk2(acc.x * inv, acc.y * inv), pk2(acc.z * inv, acc.w * inv));
  }
}

DI void phase_g6(const Params& P, int l, char* smem) {
  const ushort_t* Wl = (const ushort_t*)(P.ws + O_W) + (size_t)l * E_WL;
  ushort_t* OMIX = (ushort_t*)(P.ws + O_OMIX);
  for (int t = blockIdx.x; t < round_up_grid(133 * 16); t += gridDim.x) {
    int mt, n2; if (!tile_swz(t, 133, 16, mt, n2)) continue;
    const int nt = n2 >> 1, ks = n2 & 1;
    ushort_t* dst = OMIX + (size_t)ks * MTOT * 1024;
    if (mt < 129) gemm_tile((const ushort_t*)(P.ws + O_MIX) + ks * 512, 1024, Wl + E_WT_O + ks * 512, 1024, 512, mt * 128, nt * 128, smem, EpiBF16{dst, 1024, 1.f});
    else gemm_tile((const ushort_t*)(P.ws + O_MIXS) - (size_t)SOFF * 2560 + ks * 1280, 2560, Wl + E_WT_OS + ks * 1280, 2560, 1280, mt * 128, nt * 128, smem, EpiBF16{dst, 1024, 1.f});
  }
}

DI void phase_resid(const Params& P, const float* w1, const float* w2, bool final_out, bool first) {
  const ushort_t* OMIX = (const ushort_t*)(P.ws + O_OMIX);
  const float* X = (const float*)(P.ws + (first ? O_X : O_X2)); float* XO = (float*)(P.ws + (first ? O_X2 : O_X)); ushort_t* XN = (ushort_t*)(P.ws + O_XN);
  const int tid = get_tid(), lane = tid & 63, gw = blockIdx.x * 4 + (tid >> 6), nw = gridDim.x * 4;
  for (int row = gw; row < MTOT; row += nw) {
    const bool valid = row_valid(row);
    float v[16], ss = 0.f;
#pragma unroll
    for (int j = 0; j < 4; ++j) {
      const uint2 t = *(const uint2*)(OMIX + (size_t)row * 1024 + 4 * lane + 256 * j);
      const uint2 t2 = *(const uint2*)(OMIX + (size_t)MTOT * 1024 + (size_t)row * 1024 + 4 * lane + 256 * j);
      v[4 * j] = __uint_as_float(t.x << 16) + __uint_as_float(t2.x << 16); v[4 * j + 1] = __uint_as_float(t.x & 0xffff0000u) + __uint_as_float(t2.x & 0xffff0000u);
      v[4 * j + 2] = __uint_as_float(t.y << 16) + __uint_as_float(t2.y << 16); v[4 * j + 3] = __uint_as_float(t.y & 0xffff0000u) + __uint_as_float(t2.y & 0xffff0000u);
    }
#pragma unroll
    for (int i = 0; i < 16; ++i) { v[i] = valid ? v[i] : 0.f; ss += v[i] * v[i]; }
    ss = wave_sum(ss);
    const float rstd = rsqrtf(ss * (1.f / 1024.f) + EPS);
#pragma unroll
    for (int j = 0; j < 4; ++j) {
      const int c = 4 * lane + 256 * j;
      const float4 xv = *(const float4*)(X + (size_t)row * 1024 + c);
      const float4 wv = *(const float4*)(w1 + c);
      v[4 * j] = xv.x + v[4 * j] * rstd * wv.x; v[4 * j + 1] = xv.y + v[4 * j + 1] * rstd * wv.y;
      v[4 * j + 2] = xv.z + v[4 * j + 2] * rstd * wv.z; v[4 * j + 3] = xv.w + v[4 * j + 3] * rstd * wv.w;
    }
    if (final_out) {
      if (valid) {
        float* dst = nullptr;
        if (row >= SOFF) dst = P.out + OUT_YS + (size_t)(row - SOFF) * 1024;
        else if (row >= POFF + 16) dst = P.out + OUT_YP + (size_t)(row - POFF - 16) * 1024;
        if (dst) {
#pragma unroll
          for (int j = 0; j < 4; ++j) *(float4*)(dst + 4 * lane + 256 * j) = make_float4(v[4 * j], v[4 * j + 1], v[4 * j + 2], v[4 * j + 3]);
        }
      }
    } else {
      norm_store_row(v, XO + (size_t)row * 1024, XN + (size_t)row * 1024, w2, lane, valid);
    }
  }
}

DI void phase_g7(const Params& P, int l, char* smem) {
  const ushort_t* Wl = (const ushort_t*)(P.ws + O_W) + (size_t)l * E_WL;
  for (int t = blockIdx.x; t < round_up_grid(133 * 22); t += gridDim.x) {
    int mt, nt; if (!tile_swz(t, 133, 22, mt, nt)) continue;
    gemm_tile_w((const ushort_t*)(P.ws + O_XN), 1024, Wl + E_WT_GU, 1024, 1024, mt * 128, nt * 256, smem, EpiSwiGLU{(ushort_t*)(P.ws + O_ACT)});
  }
}
DI void phase_g8(const Params& P, int l, char* smem) {
  const ushort_t* Wl = (const ushort_t*)(P.ws + O_W) + (size_t)l * E_WL;
  for (int t = blockIdx.x; t < round_up_grid(133 * 16); t += gridDim.x) {
    int mt, n2; if (!tile_swz(t, 133, 16, mt, n2)) continue;
    const int nt = n2 >> 1, ks = n2 & 1;
    gemm_tile((const ushort_t*)(P.ws + O_ACT) + ks * 1408, DFF, Wl + E_WT_DOWN + ks * 1408, DFF, 1408, mt * 128, nt * 128, smem,
              EpiBF16{(ushort_t*)(P.ws + O_OMIX) + (size_t)ks * MTOT * 1024, 1024, 1.f});
  }
}

#define XB_TMO      128
#define XB_XCNT(j)  (256  + 64 * (j))
#define XB_XSUB(j)  (1280 + 64 * (j))
#define XB_XGEN(j)  (2304 + 64 * (j))
#define XB_TOP      3328
#define XB_TOPGEN   3392
#define XCD_BAR_WORDS 3456
#define XB_SPIN_CAP (1u << 22)
#define LAS __attribute__((address_space(3)))
DI unsigned xb_ld(unsigned* p) { return __hip_atomic_load(p, __ATOMIC_RELAXED, __HIP_MEMORY_SCOPE_AGENT); }
DI unsigned xb_add(unsigned* p, unsigned v) { return __hip_atomic_fetch_add(p, v, __ATOMIC_RELAXED, __HIP_MEMORY_SCOPE_AGENT); }
DI unsigned xb_xcc_id() { return (unsigned)__builtin_amdgcn_s_getreg((3 << 11) | 20) & 0xFu; }
#define XB_SPIN(cond, bar) do { unsigned _sp = 0; while (cond) { __builtin_amdgcn_s_sleep(1); \
    if ((++_sp & 255u) == 0u) { if (xb_ld(&(bar)[XB_TMO])) break; if (_sp > XB_SPIN_CAP) { atomicAdd(&(bar)[XB_TMO], 1u); break; } } } } while (0)
struct XcdBarrier { unsigned* bar; unsigned x; volatile LAS unsigned* st; };
DI XcdBarrier xcd_barrier_post(unsigned* bar, volatile LAS unsigned* st) {
  XcdBarrier b; b.bar = bar; b.x = xb_xcc_id(); b.st = st;
  if (threadIdx.x == 0) (void)xb_add(&bar[XB_XCNT(b.x)], 1u);
  return b;
}
DI void xcd_barrier_complete(unsigned* bar, unsigned x, unsigned& nloc, unsigned& nx) {
  const unsigned G = gridDim.x * gridDim.y * gridDim.z;
  unsigned sum, cnt, mine, sp = 0u;
  for (;;) {
    sum = 0u; cnt = 0u; mine = 0u;
#pragma unroll
    for (unsigned j = 0; j < 16; ++j) { const unsigned c = xb_ld(&bar[XB_XCNT(j)]); sum += c; cnt += (c > 0u) ? 1u : 0u; mine = (j == x) ? c : mine; }
    if (sum == G) break;
    __builtin_amdgcn_s_sleep(1);
    if ((++sp & 255u) == 0u) { if (xb_ld(&bar[XB_TMO])) break; if (sp > XB_SPIN_CAP) { atomicAdd(&bar[XB_TMO], 1u); break; } }
  }
  nloc = mine > 0u ? mine : 1u; nx = cnt > 0u ? cnt : 1u;
}
DI void xcd_barrier(const XcdBarrier& b) {
  asm volatile("s_waitcnt vmcnt(0)" ::: "memory");
  __syncthreads();
  if (threadIdx.x == 0) {
    unsigned* bar = b.bar;
    __builtin_amdgcn_s_waitcnt(0);
    unsigned nloc = b.st[0], nx = b.st[1];
    if (nloc == 0u) { xcd_barrier_complete(bar, b.x, nloc, nx); b.st[0] = nloc; b.st[1] = nx; }
    const unsigned old = xb_add(&bar[XB_XSUB(b.x)], 1u);
    const unsigned gen = old / nloc;
    if (old + 1u == (gen + 1u) * nloc) {
      __builtin_amdgcn_fence(__ATOMIC_RELEASE, "agent");
      asm volatile("s_waitcnt vmcnt(0)" ::: "memory");
      const unsigned og = xb_add(&bar[XB_TOP], 1u);
      const unsigned tg = og / nx;
      if (og + 1u == (tg + 1u) * nx) xb_add(&bar[XB_TOPGEN], 1u);
      else XB_SPIN(xb_ld(&bar[XB_TOPGEN]) == tg, bar);
      __builtin_amdgcn_fence(__ATOMIC_ACQUIRE, "agent");
      xb_add(&bar[XB_XGEN(b.x)], 1u);
      asm volatile("s_waitcnt vmcnt(0)" ::: "memory");
    } else {
      XB_SPIN(xb_ld(&bar[XB_XGEN(b.x)]) == gen, bar);
      __builtin_amdgcn_fence(__ATOMIC_ACQUIRE, "agent");
      asm volatile("s_waitcnt vmcnt(0)" ::: "memory");
    }
  }
  __syncthreads();
}

constexpr int NPHASE = 2 + 10 * DEPTH;

DI void run_phase(const Params& P, int ph, char* smem, int flags) {
  if (ph == 0) { phase_prep0(P, smem); return; }
  if (ph == 1) { phase_prep1(P, smem); return; }
  const int l = (ph - 2) / 10, sub = (ph - 2) % 10;
  switch (sub) {
    case 0: phase_g1(P, l, smem); break;
    case 1: phase_rowpass(P, l); break;
    case 2: phase_mid(P, l, smem); break;
    case 3: phase_mix(P, l, smem, flags); break;
    case 4: phase_gate(P, l, smem); break;
    case 5: phase_g6(P, l, smem); break;
    case 6: phase_resid(P, P.post_mix + l * 1024, P.pre_ffn + l * 1024, false, true); break;
    case 7: phase_g7(P, l, smem); break;
    case 8: phase_g8(P, l, smem); break;
    default: phase_resid(P, P.post_ffn + l * 1024, P.pre_mix + (l < 3 ? l + 1 : 0) * 1024, l == 3, false); break;
  }
}

template <bool COOP>
__global__ void __launch_bounds__(256, 2) mega_kernel(Params P, int ph0, int ph1, int flags) {
  __shared__ __attribute__((aligned(16))) char smem[SMEM_BYTES];
  if (COOP) {
    __shared__ uint4 xb_words;
    if (threadIdx.x == 0) xb_words = make_uint4(0u, 0u, 0u, 0u);
    __syncthreads();
    XcdBarrier xb = xcd_barrier_post((unsigned*)(P.ws + O_BAR), (volatile LAS unsigned*)&xb_words);
    for (int ph = ph0; ph < ph1; ++ph) {
      run_phase(P, ph, smem, flags);
      if (ph + 1 < ph1) {
        if (flags == 0x7fffffff) cg::this_grid().sync();
        xcd_barrier(xb);
      }
    }
  } else {
    for (int ph = ph0; ph < ph1; ++ph) run_phase(P, ph, smem, flags);
  }
}

extern "C" void kernel_launch(void* const* d_in, const int* in_sizes, int n_in, void* d_out, int out_size, void* d_ws,
                              size_t ws_size, hipStream_t stream) {
  Params P{};
  const float** pp = (const float**)&P;
  for (int i = 0; i < 25; ++i) pp[i] = (const float*)d_in[i];
  P.out = (float*)d_out;
  P.ws = (char*)d_ws;
  if (ws_size < O_END) { fprintf(stderr, "workspace too small: %zu < %zu\n", ws_size, (size_t)O_END); return; }
#if ONE_LAUNCH
  static int grid_blocks = 0;
  if (!grid_blocks) {
    int dev = 0, cus = 0, per_cu = 0;
    hipGetDevice(&dev);
    hipDeviceGetAttribute(&cus, hipDeviceAttributeMultiprocessorCount, dev);
    hipOccupancyMaxActiveBlocksPerMultiprocessor(&per_cu, mega_kernel<true>, 256, 0);
    if (per_cu > 2) per_cu = 2;
    grid_blocks = cus * per_cu;
  }
  hipMemsetAsync((char*)d_ws + O_BAR, 0, XCD_BAR_WORDS * 4, stream);
  int ph0 = 0, ph1 = NPHASE, flags = 0;
  void* args[] = {&P, &ph0, &ph1, &flags};
  hipError_t e = hipLaunchCooperativeKernel((void*)mega_kernel<true>, dim3(grid_blocks), dim3(256), args, 0, stream);
  if (e != hipSuccess) fprintf(stderr, "cooperative launch failed: %s (grid %d)\n", hipGetErrorString(e), grid_blocks);
#else
  for (int ph = 0; ph < NPHASE; ++ph) {
    mega_kernel<false><<<512, 256, 0, stream>>>(P, ph, ph + 1, 0);
    if ((ph >= 2 && ((PROBE_MASK >> ((ph - 2) % 10)) & 1)) || (ph < 2 && ((PROBE_MASK >> (10 + ph)) & 1))) {
      if (ph >= 2 && (ph - 2) % 10 == 3) hipMemsetAsync((char*)d_ws + O_CTR, 0, 256, stream);
      mega_kernel<false><<<512, 256, 0, stream>>>(P, ph, ph + 1, PROBE_FLAGS);
    }
  }
#endif
}
```

```cpp
#include <hip/hip_runtime.h>
#include <hip/hip_cooperative_groups.h>
#include <cstdio>
namespace cg = cooperative_groups;

#ifndef ONE_LAUNCH
#define ONE_LAUNCH 1
#endif
#ifndef PROBE_MASK
#define PROBE_MASK 0
#endif
#ifndef PROBE_FLAGS
#define PROBE_FLAGS 0
#endif

#define DI __device__ __forceinline__
typedef unsigned short ushort_t;
typedef short bf16x8 __attribute__((ext_vector_type(8)));
typedef short s16x4 __attribute__((ext_vector_type(4)));
typedef float f32x16 __attribute__((ext_vector_type(16)));
typedef float f32x2v __attribute__((ext_vector_type(2)));
typedef __bf16 bf16x2v __attribute__((ext_vector_type(2)));
typedef unsigned u32x4 __attribute__((ext_vector_type(4)));
#define MFMA(a, b, c) __builtin_amdgcn_mfma_f32_32x32x16_bf16((a), (b), (c), 0, 0, 0)

constexpr int DM = 1024, LTOK = 16400, DEPTH = 4, DECB = 32, DECT = 16, PAST = 4096;
constexpr int POFF = 48, PEND = 16448, SOFF = 16512, MTOT = 17024;
constexpr int NCH = 257, NITEM = NCH * 4;
constexpr int INP = 2816, DFF = 2816;
constexpr int OFF_KV = 384, OFF_PE = 640, OFF_QKV = 672, OFF_Z = 2208, OFF_B = 2720, OFF_A = 2724, INW = 2728;
constexpr float EPS = 1e-6f;
constexpr float QSCALE = 0.10206207261596577f * 1.4426950408889634f;
constexpr int SMEM_BYTES = 75776 + 16;

constexpr size_t OUT_YP = 0;
constexpr size_t OUT_YS = OUT_YP + (size_t)16384 * 1024;
constexpr size_t OUT_PLAT = OUT_YS + (size_t)512 * 1024;
constexpr size_t OUT_PPE = OUT_PLAT + (size_t)4 * LTOK * 256;
constexpr size_t OUT_PGDN = OUT_PPE + (size_t)4 * LTOK * 32;
constexpr size_t OUT_PCONV = OUT_PGDN + (size_t)4 * 4 * 128 * 128;
constexpr size_t OUT_SLAT = OUT_PCONV + (size_t)4 * 3 * 1536;
constexpr size_t OUT_SPE = OUT_SLAT + (size_t)4 * 32 * 16 * 256;
constexpr size_t OUT_SGDN = OUT_SPE + (size_t)4 * 32 * 16 * 32;
constexpr size_t OUT_SCONV = OUT_SGDN + (size_t)4 * 32 * 4 * 128 * 128;

constexpr size_t al256(size_t x) { return (x + 255) & ~(size_t)255; }
constexpr size_t E_WT_IN = 0;
constexpr size_t E_WT_UQ = E_WT_IN + (size_t)2816 * 1024;
constexpr size_t E_WUQ_BF = E_WT_UQ + (size_t)768 * 384;
constexpr size_t E_WT_UKV = E_WUQ_BF + (size_t)384 * 768;
constexpr size_t E_WUK_BF = E_WT_UKV + (size_t)1024 * 256;
constexpr size_t E_WUV_BF = E_WUK_BF + (size_t)256 * 512;
constexpr size_t E_WABS = E_WUV_BF + (size_t)256 * 512;
constexpr size_t E_WT_O = E_WABS + (size_t)2048 * 384;
constexpr size_t E_WT_OS = E_WT_O + (size_t)1024 * 1024;
constexpr size_t E_WT_GU = E_WT_OS + (size_t)1024 * 2560;
constexpr size_t E_WT_DOWN = E_WT_GU + (size_t)5632 * 1024;
constexpr size_t E_WL = E_WT_DOWN + (size_t)1024 * 2816;

constexpr size_t O_CTR = 0;
constexpr size_t O_BAR = 1024;
constexpr size_t O_W = 16384;
constexpr size_t O_X = al256(O_W + 4 * E_WL * 2);
constexpr size_t O_XN = al256(O_X + (size_t)MTOT * 1024 * 4);
constexpr size_t O_PROJ = al256(O_XN + (size_t)MTOT * 1024 * 2);
constexpr size_t O_CQN = al256(O_PROJ + (size_t)MTOT * INP * 4);
constexpr size_t O_CKV = al256(O_CQN + (size_t)MTOT * 384 * 2);
constexpr size_t O_KPE = al256(O_CKV + (size_t)MTOT * 256 * 2);
constexpr size_t O_QF = al256(O_KPE + (size_t)MTOT * 32 * 2);
constexpr size_t O_QL = al256(O_QF + (size_t)MTOT * 768 * 2);
constexpr size_t O_KF = al256(O_QL + (size_t)512 * 2048 * 2);
constexpr size_t O_VV = al256(O_KF + (size_t)SOFF * 768 * 2);
constexpr size_t O_GQ = al256(O_VV + (size_t)SOFF * 512 * 2);
constexpr size_t O_GK = al256(O_GQ + (size_t)MTOT * 512 * 4);
constexpr size_t O_GV = al256(O_GK + (size_t)MTOT * 512 * 4);
constexpr size_t O_GB = al256(O_GV + (size_t)MTOT * 512 * 4);
constexpr size_t O_GG = al256(O_GB + (size_t)MTOT * 4 * 4);
constexpr size_t O_UT = al256(O_GG + (size_t)MTOT * 4 * 4);
constexpr size_t O_WN = al256(O_UT + (size_t)NITEM * 8192 * 4);
constexpr size_t O_QG = al256(O_WN + (size_t)NITEM * 8192 * 2);
constexpr size_t O_KDT = al256(O_QG + (size_t)NITEM * 8192 * 2);
constexpr size_t O_QKM = al256(O_KDT + (size_t)NITEM * 8192 * 2);
constexpr size_t O_GL = al256(O_QKM + (size_t)NITEM * 4096 * 2);
constexpr size_t O_OG = al256(O_GL + (size_t)NITEM * 4);
constexpr size_t O_MIX = al256(O_OG + (size_t)MTOT * 512 * 4);
constexpr size_t O_MIXS = al256(O_MIX + (size_t)MTOT * 1024 * 2);
constexpr size_t O_PO = al256(O_MIXS + (size_t)512 * 2560 * 2);
constexpr size_t O_PML = al256(O_PO + (size_t)32 * 8 * 128 * 256 * 4);
constexpr size_t O_OMIX = al256(O_PML + (size_t)32 * 8 * 128 * 2 * 4);
constexpr size_t O_ACT = al256(O_OMIX + (size_t)MTOT * 1024 * 4);
constexpr size_t O_X2 = al256(O_ACT + (size_t)MTOT * DFF * 2);
constexpr size_t O_AN = al256(O_X2 + (size_t)MTOT * 1024 * 4);
constexpr size_t O_BN = al256(O_AN + (size_t)NITEM * 16384 * 2);
constexpr size_t O_SPK = al256(O_BN + (size_t)NITEM * 16384 * 4);
constexpr size_t O_END = al256(O_SPK + (size_t)NITEM * 32768);

struct Params {
  const float *x_prompt, *x_sample, *cache_lat, *cache_pe, *state_gdn, *state_conv, *meta, *pre_mix, *w_in, *q_norm,
      *kv_norm, *w_uq, *w_uk, *w_uv, *conv_w, *a_log, *dt_bias, *gdn_norm, *w_o, *post_mix, *pre_ffn, *w_gate, *w_up,
      *w_down, *post_ffn;
  float* out;
  char* ws;
};

DI unsigned pk2(float a, float b) { f32x2v f = {a, b}; bf16x2v r = __builtin_convertvector(f, bf16x2v); return __builtin_bit_cast(unsigned, r); }
DI ushort_t f2bf(float x) { return (ushort_t)(pk2(x, 0.f) & 0xffffu); }
DI float bf2f(ushort_t u) { return __uint_as_float(((unsigned)u) << 16); }
DI int crow(int reg, int h) { return (reg & 3) + 8 * (reg >> 2) + 4 * h; }
DI f32x16 zero16() { f32x16 z;
#pragma unroll
  for (int i = 0; i < 16; ++i) z[i] = 0.f; return z; }
template <int S> DI bf16x8 pack8(const f32x16& x) {
  u32x4 p;
  p[0] = pk2(x[8 * S + 0], x[8 * S + 1]); p[1] = pk2(x[8 * S + 2], x[8 * S + 3]);
  p[2] = pk2(x[8 * S + 4], x[8 * S + 5]); p[3] = pk2(x[8 * S + 6], x[8 * S + 7]);
  return __builtin_bit_cast(bf16x8, p);
}
DI float wave_sum(float v) {
#pragma unroll
  for (int d = 32; d >= 1; d >>= 1) v += __shfl_xor(v, d, 64);
  return v;
}
DI float swap_max(float m) { auto rr = __builtin_amdgcn_permlane32_swap(__float_as_uint(m), __float_as_uint(m), false, false); return fmaxf(__uint_as_float(rr[0]), __uint_as_float(rr[1])); }
DI float swap_sum(float m) { auto rr = __builtin_amdgcn_permlane32_swap(__float_as_uint(m), __float_as_uint(m), false, false); return __uint_as_float(rr[0]) + __uint_as_float(rr[1]); }
typedef short v4i16_t __attribute__((ext_vector_type(4)));
DI s16x4 vtr(const ushort_t* p) { return __builtin_bit_cast(s16x4, __builtin_amdgcn_ds_read_tr16_b64_v4i16((__attribute__((address_space(3))) v4i16_t*)p)); }
DI bf16x8 cat8(s16x4 lo, s16x4 hi) { return __builtin_shufflevector(lo, hi, 0, 1, 2, 3, 4, 5, 6, 7); }
DI bf16x8 fragP(const ushort_t* base, int h) { s16x4 lo = *(const s16x4*)(base + 4 * h); s16x4 hi = *(const s16x4*)(base + 8 + 4 * h); return cat8(lo, hi); }
DI unsigned xcc_id_early() { return (unsigned)__builtin_amdgcn_s_getreg((3 << 11) | 20) & 0xFu; }
DI int get_tid() { int t = threadIdx.x; asm volatile("" : "+v"(t)); return t; }
DI float siluf(float x) { return x * __builtin_amdgcn_rcpf(1.f + __expf(-x)); }
DI float row_pos(int row) { return row < SOFF ? (float)(row - POFF) : (float)(16 + PAST + ((row - SOFF) & 15)); }
DI bool row_valid(int row) { return row >= SOFF || (row >= POFF && row < PEND); }
DI float rope_inv(int j) { return exp2f(-(float)j * (13.287712379549449f / 16.f)); }

constexpr int GP = 72;
template <class Epi>
DI void gemm_tile(const ushort_t* __restrict__ A, int lda, const ushort_t* __restrict__ Wt, int ldb, int K, int m0, int n0,
                  char* smem, Epi epi) {
  ushort_t* L0 = (ushort_t*)smem;
  ushort_t* L1 = L0 + 256 * GP;
  const int tid = get_tid(), lane = tid & 63, wave = tid >> 6, r = lane & 31, h = lane >> 5;
  const int wm = wave >> 1, wn = wave & 1;
  const int lrow = tid >> 3, lcol = (tid & 7) * 8;
  const ushort_t* Ag = A + (size_t)(m0 + lrow) * lda + lcol;
  const ushort_t* Bg = Wt + (size_t)(n0 + lrow) * ldb + lcol;
  const size_t a32 = (size_t)32 * lda, b32 = (size_t)32 * ldb;
  u32x4 pa0, pa1, pa2, pa3, pb0, pb1, pb2, pb3;
  u32x4 qa0, qa1, qa2, qa3, qb0, qb1, qb2, qb3;
#define G_LOAD0(kk) { pa0 = *(const u32x4*)(Ag + (kk)); pa1 = *(const u32x4*)(Ag + a32 + (kk)); pa2 = *(const u32x4*)(Ag + 2 * a32 + (kk)); pa3 = *(const u32x4*)(Ag + 3 * a32 + (kk)); \
                      pb0 = *(const u32x4*)(Bg + (kk)); pb1 = *(const u32x4*)(Bg + b32 + (kk)); pb2 = *(const u32x4*)(Bg + 2 * b32 + (kk)); pb3 = *(const u32x4*)(Bg + 3 * b32 + (kk)); }
#define G_LOAD1(kk) { qa0 = *(const u32x4*)(Ag + (kk)); qa1 = *(const u32x4*)(Ag + a32 + (kk)); qa2 = *(const u32x4*)(Ag + 2 * a32 + (kk)); qa3 = *(const u32x4*)(Ag + 3 * a32 + (kk)); \
                      qb0 = *(const u32x4*)(Bg + (kk)); qb1 = *(const u32x4*)(Bg + b32 + (kk)); qb2 = *(const u32x4*)(Bg + 2 * b32 + (kk)); qb3 = *(const u32x4*)(Bg + 3 * b32 + (kk)); }
#define L_STORE0(L) { ushort_t* la = (L) + lrow * GP + lcol; ushort_t* lb = la + 128 * GP; \
                      *(u32x4*)(la) = pa0; *(u32x4*)(la + 32 * GP) = pa1; *(u32x4*)(la + 64 * GP) = pa2; *(u32x4*)(la + 96 * GP) = pa3; \
                      *(u32x4*)(lb) = pb0; *(u32x4*)(lb + 32 * GP) = pb1; *(u32x4*)(lb + 64 * GP) = pb2; *(u32x4*)(lb + 96 * GP) = pb3; }
#define L_STORE1(L) { ushort_t* la = (L) + lrow * GP + lcol; ushort_t* lb = la + 128 * GP; \
                      *(u32x4*)(la) = qa0; *(u32x4*)(la + 32 * GP) = qa1; *(u32x4*)(la + 64 * GP) = qa2; *(u32x4*)(la + 96 * GP) = qa3; \
                      *(u32x4*)(lb) = qb0; *(u32x4*)(lb + 32 * GP) = qb1; *(u32x4*)(lb + 64 * GP) = qb2; *(u32x4*)(lb + 96 * GP) = qb3; }
#define G_COMPUTE(L) { const ushort_t* As = (L); const ushort_t* Bs = (L) + 128 * GP; \
    _Pragma("unroll") for (int ks = 0; ks < 4; ++ks) { \
      const bf16x8 af0 = *(const bf16x8*)(As + (64 * wm + r) * GP + ks * 16 + h * 8); \
      const bf16x8 af1 = *(const bf16x8*)(As + (64 * wm + 32 + r) * GP + ks * 16 + h * 8); \
      const bf16x8 bf0 = *(const bf16x8*)(Bs + (64 * wn + r) * GP + ks * 16 + h * 8); \
      const bf16x8 bf1 = *(const bf16x8*)(Bs + (64 * wn + 32 + r) * GP + ks * 16 + h * 8); \
      acc00 = MFMA(bf0, af0, acc00); acc01 = MFMA(bf1, af0, acc01); acc10 = MFMA(bf0, af1, acc10); acc11 = MFMA(bf1, af1, acc11); } }
  f32x16 acc00 = zero16(), acc01 = zero16(), acc10 = zero16(), acc11 = zero16();
  __syncthreads();
  if (K == 64) {
    G_LOAD0(0);
    L_STORE0(L0);
    __syncthreads();
    G_COMPUTE(L0);
    __syncthreads();
  } else {
    const int klast = K - 64;
    G_LOAD0(0);
    G_LOAD1(64);
    L_STORE0(L0);
    G_LOAD0(min(128, klast));
    __syncthreads();
    for (int k0 = 0; k0 < K; k0 += 128) {
      G_COMPUTE(L0);
      L_STORE1(L1);
      G_LOAD1(min(k0 + 192, klast));
      __syncthreads();
      G_COMPUTE(L1);
      L_STORE0(L0);
      G_LOAD0(min(k0 + 256, klast));
      __syncthreads();
    }
  }
#undef G_LOAD0
#undef G_LOAD1
#undef L_STORE0
#undef L_STORE1
#undef G_COMPUTE
  epi(m0 + 64 * wm + r, n0 + 64 * wn, acc00, acc01, h);
  epi(m0 + 64 * wm + 32 + r, n0 + 64 * wn, acc10, acc11, h);
}

template <class Epi>
DI void gemm_tile_w(const ushort_t* __restrict__ A, int lda, const ushort_t* __restrict__ Wt, int ldb, int K, int m0, int n0,
                    char* smem, Epi epi) {
  ushort_t* As = (ushort_t*)smem;
  ushort_t* Bs = As + 128 * GP;
  const int tid = get_tid(), lane = tid & 63, wave = tid >> 6, r = lane & 31, h = lane >> 5;
  const int wm = wave >> 1, wn = wave & 1;
  const int lrow = tid >> 3, lcol = (tid & 7) * 8;
  const ushort_t* Ag = A + (size_t)(m0 + lrow) * lda + lcol;
  const ushort_t* Bg = Wt + (size_t)(n0 + lrow) * ldb + lcol;
  const size_t a32 = (size_t)32 * lda, b32 = (size_t)32 * ldb;
  u32x4 ra[4], rb[8];
#pragma unroll
  for (int i = 0; i < 4; ++i) ra[i] = *(const u32x4*)(Ag + i * a32);
#pragma unroll
  for (int i = 0; i < 8; ++i) rb[i] = *(const u32x4*)(Bg + i * b32);
  f32x16 acc[2][4];
#pragma unroll
  for (int mi = 0; mi < 2; ++mi)
#pragma unroll
    for (int ni = 0; ni < 4; ++ni) acc[mi][ni] = zero16();
  for (int k0 = 0; k0 < K; k0 += 64) {
    __syncthreads();
#pragma unroll
    for (int i = 0; i < 4; ++i) *(u32x4*)(As + (lrow + 32 * i) * GP + lcol) = ra[i];
#pragma unroll
    for (int i = 0; i < 8; ++i) *(u32x4*)(Bs + (lrow + 32 * i) * GP + lcol) = rb[i];
    __syncthreads();
    if (k0 + 64 < K) {
#pragma unroll
      for (int i = 0; i < 4; ++i) ra[i] = *(const u32x4*)(Ag + i * a32 + k0 + 64);
#pragma unroll
      for (int i = 0; i < 8; ++i) rb[i] = *(const u32x4*)(Bg + i * b32 + k0 + 64);
    }
#pragma unroll
    for (int ks = 0; ks < 4; ++ks) {
      bf16x8 af[2], bfv[4];
#pragma unroll
      for (int mi = 0; mi < 2; ++mi) af[mi] = *(const bf16x8*)(As + (64 * wm + 32 * mi + r) * GP + ks * 16 + h * 8);
#pragma unroll
      for (int ni = 0; ni < 4; ++ni) bfv[ni] = *(const bf16x8*)(Bs + (128 * wn + 32 * ni + r) * GP + ks * 16 + h * 8);
#pragma unroll
      for (int mi = 0; mi < 2; ++mi)
#pragma unroll
        for (int ni = 0; ni < 4; ++ni) acc[mi][ni] = MFMA(bfv[ni], af[mi], acc[mi][ni]);
    }
  }
#pragma unroll
  for (int mi = 0; mi < 2; ++mi) {
    epi(m0 + 64 * wm + 32 * mi + r, n0 + 128 * wn, acc[mi][0], acc[mi][1], h);
    epi(m0 + 64 * wm + 32 * mi + r, n0 + 128 * wn + 64, acc[mi][2], acc[mi][3], h);
  }
}

struct EpiF32 {
  float* C; int ldc;
  DI void operator()(int m, int nb, const f32x16& a0, const f32x16& a1, int h) const {
#pragma unroll
    for (int g = 0; g < 4; ++g) {
      *(float4*)(C + (size_t)m * ldc + nb + 8 * g + 4 * h) = make_float4(a0[4 * g], a0[4 * g + 1], a0[4 * g + 2], a0[4 * g + 3]);
      *(float4*)(C + (size_t)m * ldc + nb + 32 + 8 * g + 4 * h) = make_float4(a1[4 * g], a1[4 * g + 1], a1[4 * g + 2], a1[4 * g + 3]);
    }
  }
};
struct EpiBF16 {
  ushort_t* C; int ldc; float scale;
  DI void operator()(int m, int nb, const f32x16& a0, const f32x16& a1, int h) const {
#pragma unroll
    for (int g = 0; g < 4; ++g) {
      *(uint2*)(C + (size_t)m * ldc + nb + 8 * g + 4 * h) = make_uint2(pk2(a0[4 * g] * scale, a0[4 * g + 1] * scale), pk2(a0[4 * g + 2] * scale, a0[4 * g + 3] * scale));
      *(uint2*)(C + (size_t)m * ldc + nb + 32 + 8 * g + 4 * h) = make_uint2(pk2(a1[4 * g] * scale, a1[4 * g + 1] * scale), pk2(a1[4 * g + 2] * scale, a1[4 * g + 3] * scale));
    }
  }
};
struct EpiQ {
  ushort_t* QF;
  DI void one(int m, int nb, f32x16 a, int h) const {
    if ((nb % 96) == 64) {
      const float pos = row_pos(m);
#pragma unroll
      for (int i = 0; i < 8; ++i) {
        const int j = crow(i, h);
        float sn, cs; sincosf(pos * rope_inv(j), &sn, &cs);
        const float x1 = a[i], x2 = a[i + 8];
        a[i] = x1 * cs - x2 * sn; a[i + 8] = x1 * sn + x2 * cs;
      }
    }
#pragma unroll
    for (int g = 0; g < 4; ++g)
      *(uint2*)(QF + (size_t)m * 768 + nb + 8 * g + 4 * h) = make_uint2(pk2(a[4 * g] * QSCALE, a[4 * g + 1] * QSCALE), pk2(a[4 * g + 2] * QSCALE, a[4 * g + 3] * QSCALE));
  }
  DI void operator()(int m, int nb, const f32x16& a0, const f32x16& a1, int h) const { one(m, nb, a0, h); one(m, nb + 32, a1, h); }
};
struct EpiKV {
  ushort_t* KF; ushort_t* VV;
  DI void one(int m, int nb, const f32x16& a, int h) const {
#pragma unroll
    for (int g = 0; g < 4; ++g) {
      const int n = nb + 8 * g + 4 * h;
      uint2 v = make_uint2(pk2(a[4 * g], a[4 * g + 1]), pk2(a[4 * g + 2], a[4 * g + 3]));
      if (n < 512) *(uint2*)(KF + (size_t)m * 768 + (n >> 6) * 96 + (n & 63)) = v;
      else *(uint2*)(VV + (size_t)m * 512 + (n - 512)) = v;
    }
  }
  DI void operator()(int m, int nb, const f32x16& a0, const f32x16& a1, int h) const { one(m, nb, a0, h); one(m, nb + 32, a1, h); }
};
struct EpiSwiGLU {
  ushort_t* ACT;
  DI void operator()(int m, int nb, const f32x16& a0, const f32x16& a1, int h) const {
    const int cb = nb >> 1;
#pragma unroll
    for (int g = 0; g < 4; ++g) {
      float v0 = siluf(a0[4 * g]) * a1[4 * g], v1 = siluf(a0[4 * g + 1]) * a1[4 * g + 1];
      float v2 = siluf(a0[4 * g + 2]) * a1[4 * g + 2], v3 = siluf(a0[4 * g + 3]) * a1[4 * g + 3];
      *(uint2*)(ACT + (size_t)m * DFF + cb + 8 * g + 4 * h) = make_uint2(pk2(v0, v1), pk2(v2, v3));
    }
  }
};

DI void tconv_tile(const float* __restrict__ src, int K, int N, ushort_t* dst, int ldd, int mode, ushort_t* dst2, int kt, int nt, char* smem) {
  float* tile = (float*)smem;
  const int tid = get_tid();
  const int k0 = kt * 64, n0 = nt * 64;
  __syncthreads();
#pragma unroll
  for (int it = 0; it < 16; ++it) {
    int k = it * 4 + (tid >> 6), n = tid & 63;
    float v = (n0 + n < N) ? src[(size_t)(k0 + k) * N + n0 + n] : 0.f;
    tile[k * 65 + n] = v;
  }
  __syncthreads();
#pragma unroll
  for (int it = 0; it < 16; ++it) {
    int n = it * 4 + (tid >> 6), k = tid & 63;
    int gn = n0 + n;
    int row = gn;
    if (mode == 1) row = (gn >> 5) * 64 + (gn & 31);
    else if (mode == 2) row = (gn >> 5) * 64 + 32 + (gn & 31);
    ushort_t v = f2bf(tile[k * 65 + n]);
    dst[(size_t)row * ldd + k0 + k] = v;
    if (mode == 3 && k0 >= 512) dst2[(size_t)gn * 2560 + 2048 + (k0 - 512) + k] = v;
  }
}

DI void norm_store_row(const float (&v)[16], float* Xrow, ushort_t* XNrow, const float* w, int lane, bool valid) {
  float ss = 0.f;
#pragma unroll
  for (int i = 0; i < 16; ++i) ss += v[i] * v[i];
  ss = wave_sum(ss);
  const float rstd = rsqrtf(ss * (1.f / 1024.f) + EPS);
#pragma unroll
  for (int j = 0; j < 4; ++j) {
    const int c = 4 * lane + 256 * j;
    float4 wv = *(const float4*)(w + c);
    float o0 = valid ? v[4 * j] : 0.f, o1 = valid ? v[4 * j + 1] : 0.f, o2 = valid ? v[4 * j + 2] : 0.f, o3 = valid ? v[4 * j + 3] : 0.f;
    if (Xrow) *(float4*)(Xrow + c) = make_float4(o0, o1, o2, o3);
    *(uint2*)(XNrow + c) = make_uint2(pk2(o0 * rstd * wv.x, o1 * rstd * wv.y), pk2(o2 * rstd * wv.z, o3 * rstd * wv.w));
  }
}

DI void phase_prep0(const Params& P, char* smem) {
  ushort_t* W = (ushort_t*)(P.ws + O_W);
  const int tid = get_tid();
  if (blockIdx.x == 0 && tid < 64) ((int*)(P.ws + O_CTR))[tid] = 0;
  constexpr int T_IN = 704, T_UQ = 72, T_UK = 32, T_UV = 32, T_O = 256, T_G = 704, T_U = 704, T_D = 704;
  constexpr int TL = T_IN + T_UQ + T_UK + T_UV + T_O + T_G + T_U + T_D;
  for (int t = blockIdx.x; t < TL * 4; t += gridDim.x) {
    const int l = t / TL; int rm = t % TL;
    ushort_t* Wl = W + (size_t)l * E_WL;
    if (rm < T_IN) { tconv_tile(P.w_in + (size_t)l * 1024 * INW, 1024, INW, Wl + E_WT_IN, 1024, 0, nullptr, rm / 44, rm % 44, smem); continue; }
    rm -= T_IN;
    if (rm < T_UQ) { tconv_tile(P.w_uq + (size_t)l * 384 * 768, 384, 768, Wl + E_WT_UQ, 384, 0, nullptr, rm / 12, rm % 12, smem); continue; }
    rm -= T_UQ;
    if (rm < T_UK) { tconv_tile(P.w_uk + (size_t)l * 256 * 512, 256, 512, Wl + E_WT_UKV, 256, 0, nullptr, rm / 8, rm % 8, smem); continue; }
    rm -= T_UK;
    if (rm < T_UV) { tconv_tile(P.w_uv + (size_t)l * 256 * 512, 256, 512, Wl + E_WT_UKV + (size_t)512 * 256, 256, 0, nullptr, rm / 8, rm % 8, smem); continue; }
    rm -= T_UV;
    if (rm < T_O) { tconv_tile(P.w_o + (size_t)l * 1024 * 1024, 1024, 1024, Wl + E_WT_O, 1024, 3, Wl + E_WT_OS, rm / 16, rm % 16, smem); continue; }
    rm -= T_O;
    if (rm < T_G) { tconv_tile(P.w_gate + (size_t)l * 1024 * DFF, 1024, DFF, Wl + E_WT_GU, 1024, 1, nullptr, rm / 44, rm % 44, smem); continue; }
    rm -= T_G;
    if (rm < T_U) { tconv_tile(P.w_up + (size_t)l * 1024 * DFF, 1024, DFF, Wl + E_WT_GU, 1024, 2, nullptr, rm / 44, rm % 44, smem); continue; }
    rm -= T_U;
    tconv_tile(P.w_down + (size_t)l * DFF * 1024, DFF, 1024, Wl + E_WT_DOWN, DFF, 0, nullptr, rm / 16, rm % 16, smem);
  }
  const int gt = blockIdx.x * 256 + tid, gs = gridDim.x * 256;
  for (int l = 0; l < 4; ++l) {
    ushort_t* Wl = W + (size_t)l * E_WL;
    for (int i = gt; i < 384 * 768; i += gs) Wl[E_WUQ_BF + i] = f2bf(P.w_uq[(size_t)l * 384 * 768 + i]);
    for (int i = gt; i < 256 * 512; i += gs) { Wl[E_WUK_BF + i] = f2bf(P.w_uk[(size_t)l * 256 * 512 + i]); Wl[E_WUV_BF + i] = f2bf(P.w_uv[(size_t)l * 256 * 512 + i]); }
  }
  float* X = (float*)(P.ws + O_X);
  ushort_t* XN = (ushort_t*)(P.ws + O_XN);
  const int lane = tid & 63, gw = blockIdx.x * 4 + (tid >> 6), nw = gridDim.x * 4;
  for (int row = gw; row < MTOT; row += nw) {
    const bool valid = row_valid(row);
    const float* src = nullptr;
    if (valid) {
      if (row >= SOFF) src = P.x_sample + (size_t)(row - SOFF) * 1024;
      else if (row < POFF + 16) src = P.meta + (size_t)(row - POFF) * 1024;
      else src = P.x_prompt + (size_t)(row - POFF - 16) * 1024;
    }
    float v[16];
#pragma unroll
    for (int j = 0; j < 4; ++j) {
      float4 t = valid ? *(const float4*)(src + 4 * lane + 256 * j) : make_float4(0.f, 0.f, 0.f, 0.f);
      v[4 * j] = t.x; v[4 * j + 1] = t.y; v[4 * j + 2] = t.z; v[4 * j + 3] = t.w;
    }
    norm_store_row(v, X + (size_t)row * 1024, XN + (size_t)row * 1024, P.pre_mix, lane, valid);
  }
}

DI void phase_prep1(const Params& P, char* smem) {
  ushort_t* W = (ushort_t*)(P.ws + O_W);
  for (int t = blockIdx.x; t < 4 * 176; t += gridDim.x) {
    const int l = t / 176; int rm = t % 176;
    ushort_t* Wl = W + (size_t)l * E_WL;
    if (rm < 48) {
      const int hd = rm / 6, mt = (rm % 6) / 3, nt = rm % 3;
      gemm_tile(Wl + E_WUK_BF + hd * 64, 512, Wl + E_WUQ_BF + hd * 96, 768, 64, mt * 128, nt * 128, smem,
                EpiBF16{Wl + E_WABS + (size_t)hd * 256 * 384, 384, 1.f});
    } else {
      rm -= 48;
      const int hd = rm / 16, mt = (rm % 16) / 2, nt = rm % 2;
      gemm_tile(Wl + E_WT_O + hd * 64, 1024, Wl + E_WUV_BF + hd * 64, 512, 64, mt * 128, nt * 128, smem,
                EpiBF16{Wl + E_WT_OS + hd * 256, 2560, 1.f});
    }
  }
}

DI float bflo(unsigned u) { return __uint_as_float(u << 16); }
DI float bfhi(unsigned u) { return __uint_as_float(u & 0xffff0000u); }
DI unsigned ld32(const ushort_t* p) { return *(const unsigned*)p; }
DI void phase_rowpass(const Params& P, int l) {
  const ushort_t* __restrict__ PROJ = (const ushort_t*)(P.ws + O_PROJ);
  ushort_t* CQN = (ushort_t*)(P.ws + O_CQN); ushort_t* CKV = (ushort_t*)(P.ws + O_CKV); ushort_t* KPE = (ushort_t*)(P.ws + O_KPE);
  ushort_t* KF = (ushort_t*)(P.ws + O_KF);
  float* GQ = (float*)(P.ws + O_GQ); float* GK = (float*)(P.ws + O_GK); float* GV = (float*)(P.ws + O_GV);
  float* GB = (float*)(P.ws + O_GB); float* GG = (float*)(P.ws + O_GG);
  const int tid = get_tid(), lane = tid & 63, gw = blockIdx.x * 4 + (tid >> 6), nw = gridDim.x * 4;
  const float* cw = P.conv_w + (size_t)l * 4 * 1536;
  float2 w[12][4];
#pragma unroll
  for (int s = 0; s < 12; ++s)
#pragma unroll
    for (int k = 0; k < 4; ++k) w[s][k] = *(const float2*)(cw + k * 1536 + 128 * s + 2 * lane);
  float2 qn[3], kn[2];
#pragma unroll
  for (int j = 0; j < 3; ++j) qn[j] = *(const float2*)(P.q_norm + l * 384 + 2 * lane + 128 * j);
#pragma unroll
  for (int j = 0; j < 2; ++j) kn[j] = *(const float2*)(P.kv_norm + l * 256 + 2 * lane + 128 * j);
  for (int row = gw; row < MTOT; row += nw) {
    const ushort_t* pr = PROJ + (size_t)row * INP;
    const bool isP = row < SOFF, valid = row_valid(row);
    const int tok = row - POFF, sb = (row - SOFF) >> 4, st = (row - SOFF) & 15;
    const float pos = row_pos(row);
    unsigned t0[12], t1[12], t2[12], t3[12];
    if (valid) {
      const ushort_t* px = pr + OFF_QKV + 2 * lane;
#pragma unroll
      for (int s = 0; s < 12; ++s) t0[s] = ld32(px + 128 * s);
      if (isP) {
#pragma unroll
        for (int s = 0; s < 12; ++s) { t1[s] = ld32(px - INP + 128 * s); t2[s] = ld32(px - 2 * INP + 128 * s); t3[s] = ld32(px - 3 * INP + 128 * s); }
      } else {
        const float* cs = P.state_conv + ((size_t)l * 32 + sb) * 3 * 1536 + 2 * lane;
#pragma unroll
        for (int s = 0; s < 12; ++s) {
          if (st >= 1) t1[s] = ld32(px - INP + 128 * s); else { const float2 f = *(const float2*)(cs + (size_t)(2 + st) * 1536 + 128 * s); t1[s] = pk2(f.x, f.y); }
          if (st >= 2) t2[s] = ld32(px - 2 * INP + 128 * s); else { const float2 f = *(const float2*)(cs + (size_t)(1 + st) * 1536 + 128 * s); t2[s] = pk2(f.x, f.y); }
          if (st >= 3) t3[s] = ld32(px - 3 * INP + 128 * s); else { const float2 f = *(const float2*)(cs + (size_t)(st) * 1536 + 128 * s); t3[s] = pk2(f.x, f.y); }
        }
      }
    } else {
#pragma unroll
      for (int s = 0; s < 12; ++s) { t0[s] = 0u; t1[s] = 0u; t2[s] = 0u; t3[s] = 0u; }
    }
    unsigned cq[3], ck[2];
#pragma unroll
    for (int j = 0; j < 3; ++j) cq[j] = ld32(pr + 2 * lane + 128 * j);
#pragma unroll
    for (int j = 0; j < 2; ++j) ck[j] = ld32(pr + OFF_KV + 2 * lane + 128 * j);
    const float xr = bf2f(pr[OFF_PE + (lane & 31)]);
    const float bbv = bf2f(pr[OFF_B + (lane & 3)]), aav = bf2f(pr[OFF_A + (lane & 3)]);
    {
      float ss = 0.f;
#pragma unroll
      for (int j = 0; j < 3; ++j) { const float a = bflo(cq[j]), b = bfhi(cq[j]); ss += a * a + b * b; }
      ss = wave_sum(ss);
      const float rstd = rsqrtf(ss * (1.f / 384.f) + EPS);
#pragma unroll
      for (int j = 0; j < 3; ++j)
        *(unsigned*)(CQN + (size_t)row * 384 + 2 * lane + 128 * j) = pk2(bflo(cq[j]) * rstd * qn[j].x, bfhi(cq[j]) * rstd * qn[j].y);
    }
    {
      float ss = 0.f;
#pragma unroll
      for (int j = 0; j < 2; ++j) { const float a = bflo(ck[j]), b = bfhi(ck[j]); ss += a * a + b * b; }
      ss = wave_sum(ss);
      const float rstd = rsqrtf(ss * (1.f / 256.f) + EPS);
      float* olat = nullptr;
      if (valid) olat = isP ? P.out + OUT_PLAT + ((size_t)l * LTOK + tok) * 256 : P.out + OUT_SLAT + (((size_t)l * 32 + sb) * 16 + st) * 256;
#pragma unroll
      for (int j = 0; j < 2; ++j) {
        const float o0 = bflo(ck[j]) * rstd * kn[j].x, o1 = bfhi(ck[j]) * rstd * kn[j].y;
        *(unsigned*)(CKV + (size_t)row * 256 + 2 * lane + 128 * j) = pk2(o0, o1);
        if (valid) *(float2*)(olat + 2 * lane + 128 * j) = make_float2(o0, o1);
      }
    }
    {
      const float pt = __shfl_xor(xr, 16, 64);
      float sn, cs; sincosf(pos * rope_inv(lane & 15), &sn, &cs);
      const float o = ((lane & 31) < 16) ? (xr * cs - pt * sn) : (pt * sn + xr * cs);
      if (lane < 32) {
        const ushort_t ob = f2bf(o);
        KPE[(size_t)row * 32 + lane] = ob;
        if (valid) {
          if (isP) P.out[OUT_PPE + ((size_t)l * LTOK + tok) * 32 + lane] = o;
          else P.out[OUT_SPE + (((size_t)l * 32 + sb) * 16 + st) * 32 + lane] = o;
        }
        if (isP) {
#pragma unroll
          for (int hh = 0; hh < 8; ++hh) KF[(size_t)row * 768 + hh * 96 + 64 + lane] = ob;
        }
      }
    }
    {
      float* cso = nullptr;
      if (valid) {
        if (isP) { if (row >= PEND - 3) cso = P.out + OUT_PCONV + ((size_t)l * 3 + (row - (PEND - 3))) * 1536; }
        else if (st >= 13) cso = P.out + OUT_SCONV + (((size_t)l * 32 + sb) * 3 + (st - 13)) * 1536;
      }
#pragma unroll
      for (int s = 0; s < 12; ++s) {
        const float x0a = bflo(t0[s]), x0b = bfhi(t0[s]);
        if (cso) *(float2*)(cso + 128 * s + 2 * lane) = make_float2(x0a, x0b);
        const float ya = w[s][3].x * x0a + w[s][2].x * bflo(t1[s]) + w[s][1].x * bflo(t2[s]) + w[s][0].x * bflo(t3[s]);
        const float yb = w[s][3].y * x0b + w[s][2].y * bfhi(t1[s]) + w[s][1].y * bfhi(t2[s]) + w[s][0].y * bfhi(t3[s]);
        const float a = siluf(ya), b = siluf(yb);
        if (s < 8) {
          const float ss = wave_sum(a * a + b * b);
          float sc = rsqrtf(ss + EPS);
          if (s < 4) sc *= 0.08838834764831845f;
          float* dst = (s < 4 ? GQ : GK) + (size_t)row * 512 + (s & 3) * 128 + 2 * lane;
          *(float2*)dst = make_float2(a * sc, b * sc);
        } else {
          *(float2*)(GV + (size_t)row * 512 + (s - 8) * 128 + 2 * lane) = make_float2(a, b);
        }
      }
    }
    if (lane < 4) {
      float beta = 0.f, g = 0.f;
      if (valid) {
        const float aa = aav + P.dt_bias[l * 4 + lane];
        beta = 1.f / (1.f + expf(-bbv));
        const float sp = aa > 20.f ? aa : log1pf(expf(aa));
        g = -expf(P.a_log[l * 4 + lane]) * sp;
      }
      GB[(size_t)row * 4 + lane] = beta; GG[(size_t)row * 4 + lane] = g;
    }
  }
}

DI void gdn_prep(const Params& P, int item, char* smem) {
  const float* GQ = (const float*)(P.ws + O_GQ); const float* GK = (const float*)(P.ws + O_GK); const float* GV = (const float*)(P.ws + O_GV);
  const float* GB = (const float*)(P.ws + O_GB); const float* GG = (const float*)(P.ws + O_GG);
  float* UT = (float*)(P.ws + O_UT) + (size_t)item * 8192;
  ushort_t* WN = (ushort_t*)(P.ws + O_WN) + (size_t)item * 8192;
  ushort_t* QG = (ushort_t*)(P.ws + O_QG) + (size_t)item * 8192;
  ushort_t* AN = (ushort_t*)(P.ws + O_AN) + (size_t)item * 16384;
  float* BN = (float*)(P.ws + O_BN) + (size_t)item * 16384;
  ushort_t* WTs = (ushort_t*)smem;
  ushort_t* UTs = WTs + 128 * 72;
  ushort_t* KDTs = (ushort_t*)(smem + 53248);
  ushort_t* QKM = (ushort_t*)(P.ws + O_QKM) + (size_t)item * 4096;
  float* GL = (float*)(P.ws + O_GL);
  ushort_t* Ks = (ushort_t*)smem;
  ushort_t* Qs = Ks + 64 * 136;
  float* Ms = (float*)(smem + 34816);
  float* gcs = (float*)(smem + 52224);
  float* bts = gcs + 64;
  float* egs = bts + 64;
  const int tid = get_tid(), lane = tid & 63, wave = tid >> 6, r = lane & 31, h = lane >> 5;
  const int n = item >> 2, hd = item & 3, row0 = 64 * n;
  __syncthreads();
  if (wave == 0) {
    float x = GG[(size_t)(row0 + lane) * 4 + hd];
    const float bt = GB[(size_t)(row0 + lane) * 4 + hd];
#pragma unroll
    for (int d = 1; d < 64; d <<= 1) { float y = __shfl_up(x, d, 64); if (lane >= d) x += y; }
    gcs[lane] = x; bts[lane] = bt; egs[lane] = expf(x);
    if (lane == 63) GL[item] = expf(x);
  }
#pragma unroll
  for (int i = 0; i < 8; ++i) {
    const int idx = tid + 256 * i, row = idx >> 5, c4 = (idx & 31) * 4;
    const float4 kv = *(const float4*)(GK + (size_t)(row0 + row) * 512 + hd * 128 + c4);
    const float4 qv = *(const float4*)(GQ + (size_t)(row0 + row) * 512 + hd * 128 + c4);
    *(uint2*)(Ks + row * 136 + c4) = make_uint2(pk2(kv.x, kv.y), pk2(kv.z, kv.w));
    *(uint2*)(Qs + row * 136 + c4) = make_uint2(pk2(qv.x, qv.y), pk2(qv.z, qv.w));
  }
  __syncthreads();
  {
    const int bi = wave >> 1, bj = wave & 1;
    f32x16 kk = zero16(), qk = zero16();
#pragma unroll
    for (int s = 0; s < 8; ++s) {
      const bf16x8 bfr = *(const bf16x8*)(Ks + (32 * bj + r) * 136 + 16 * s + 8 * h);
      const bf16x8 ak = *(const bf16x8*)(Ks + (32 * bi + r) * 136 + 16 * s + 8 * h);
      const bf16x8 aq = *(const bf16x8*)(Qs + (32 * bi + r) * 136 + 16 * s + 8 * h);
      kk = MFMA(ak, bfr, kk); qk = MFMA(aq, bfr, qk);
    }
    const int j = 32 * bj + r;
    const float gcj = gcs[j];
#pragma unroll
    for (int rg = 0; rg < 16; ++rg) {
      const int i = 32 * bi + crow(rg, h);
      const float dec = (j <= i) ? expf(gcs[i] - gcj) : 0.f;
      Ms[i * 68 + j] = (j < i) ? bts[i] * kk[rg] * dec : 0.f;
      QKM[i * 64 + j] = f2bf(qk[rg] * dec);
    }
  }
#pragma unroll
  for (int i = 0; i < 8; ++i) {
    const int idx = tid + 256 * i, row = idx >> 5, c4 = (idx & 31) * 4;
    const float4 qv = *(const float4*)(GQ + (size_t)(row0 + row) * 512 + hd * 128 + c4);
    const float e = egs[row];
    *(uint2*)(QG + row * 128 + c4) = make_uint2(pk2(qv.x * e, qv.y * e), pk2(qv.z * e, qv.w * e));
  }
  {
    const int dk = tid & 127, ch = tid >> 7;
    const float gl = gcs[63];
    unsigned pkd[16];
#pragma unroll
    for (int cc = 0; cc < 16; ++cc) {
      const int c0 = 32 * ch + 2 * cc;
      const float a = GK[(size_t)(row0 + c0) * 512 + hd * 128 + dk] * expf(gl - gcs[c0]);
      const float b = GK[(size_t)(row0 + c0 + 1) * 512 + hd * 128 + dk] * expf(gl - gcs[c0 + 1]);
      pkd[cc] = pk2(a, b);
    }
#pragma unroll
    for (int q4 = 0; q4 < 4; ++q4)
      *(uint4*)(KDTs + dk * 72 + 32 * ch + 8 * q4) = make_uint4(pkd[4 * q4], pkd[4 * q4 + 1], pkd[4 * q4 + 2], pkd[4 * q4 + 3]);
  }
  __syncthreads();
  {
    const int col = tid & 127;
    const bool isW = tid >= 128;
    float x[64];
#pragma unroll
    for (int c = 0; c < 64; ++c) {
      const float bt = bts[c];
      x[c] = isW ? GK[(size_t)(row0 + c) * 512 + hd * 128 + col] * (bt * egs[c]) : GV[(size_t)(row0 + c) * 512 + hd * 128 + col] * bt;
    }
#pragma unroll
    for (int i = 1; i < 64; ++i) {
      float acc = x[i];
#pragma unroll
      for (int j = 0; j < i; ++j) acc -= Ms[i * 68 + j] * x[j];
      x[i] = acc;
    }
    __syncthreads();
    if (!isW) {
#pragma unroll
      for (int c = 0; c < 64; c += 4) *(float4*)(UT + col * 64 + c) = make_float4(x[c], x[c + 1], x[c + 2], x[c + 3]);
#pragma unroll
      for (int c = 0; c < 64; c += 8)
        *(uint4*)(UTs + col * 72 + c) = make_uint4(pk2(x[c], x[c + 1]), pk2(x[c + 2], x[c + 3]), pk2(x[c + 4], x[c + 5]), pk2(x[c + 6], x[c + 7]));
    } else {
#pragma unroll
      for (int c = 0; c < 64; ++c) WN[c * 128 + col] = f2bf(-x[c]);
#pragma unroll
      for (int c = 0; c < 64; c += 8)
        *(uint4*)(WTs + col * 72 + c) = make_uint4(pk2(-x[c], -x[c + 1]), pk2(-x[c + 2], -x[c + 3]), pk2(-x[c + 4], -x[c + 5]), pk2(-x[c + 6], -x[c + 7]));
    }
  }
  __syncthreads();
  {
    const int bi = wave;
    const float gl = expf(gcs[63]);
    bf16x8 kf[4];
#pragma unroll
    for (int sx = 0; sx < 4; ++sx) kf[sx] = *(const bf16x8*)(KDTs + (32 * bi + r) * 72 + 16 * sx + 8 * h);
#pragma unroll
    for (int bj = 0; bj < 4; ++bj) {
      f32x16 ab = zero16(), aa = zero16();
#pragma unroll
      for (int sx = 0; sx < 4; ++sx) {
        ab = MFMA(kf[sx], *(const bf16x8*)(UTs + (32 * bj + r) * 72 + 16 * sx + 8 * h), ab);
        aa = MFMA(*(const bf16x8*)(WTs + (32 * bj + r) * 72 + 16 * sx + 8 * h), kf[sx], aa);
      }
#pragma unroll
      for (int g = 0; g < 4; ++g) {
        *(float4*)(BN + (((bi * 4 + bj) * 4 + g) * 64 + lane) * 4) = make_float4(ab[4 * g], ab[4 * g + 1], ab[4 * g + 2], ab[4 * g + 3]);
        float a0 = aa[4 * g], a1 = aa[4 * g + 1], a2 = aa[4 * g + 2], a3 = aa[4 * g + 3];
        if (bi == bj) {
          const int jb = 8 * g + 4 * h;
          if (jb == r) a0 += gl;
          if (jb + 1 == r) a1 += gl;
          if (jb + 2 == r) a2 += gl;
          if (jb + 3 == r) a3 += gl;
        }
        *(uint2*)(AN + (32 * bi + r) * 128 + 32 * bj + 8 * g + 4 * h) = make_uint2(pk2(a0, a1), pk2(a2, a3));
      }
    }
  }
}

DI void gdn_sample(const Params& P, int l, int item, char* smem) {
  const float* GQ = (const float*)(P.ws + O_GQ); const float* GK = (const float*)(P.ws + O_GK); const float* GV = (const float*)(P.ws + O_GV);
  const float* GB = (const float*)(P.ws + O_GB); const float* GG = (const float*)(P.ws + O_GG);
  float* OG = (float*)(P.ws + O_OG);
  float* ks = (float*)smem;
  float* qs = ks + 2048;
  float* vs = qs + 2048;
  float* egb = vs + 2048;
  float* red = egb + 32;
  float* red2 = red + 256;
  const int tid = get_tid(), dv = tid & 127, half = tid >> 7;
  const int b = item >> 2, hd = item & 3, row0 = SOFF + 16 * b;
  __syncthreads();
#pragma unroll
  for (int i = 0; i < 8; ++i) {
    const int idx = tid + 256 * i, t = idx >> 7, c = idx & 127;
    ks[idx] = GK[(size_t)(row0 + t) * 512 + hd * 128 + c];
    qs[idx] = GQ[(size_t)(row0 + t) * 512 + hd * 128 + c];
    vs[idx] = GV[(size_t)(row0 + t) * 512 + hd * 128 + c];
  }
  if (tid < 16) { egb[2 * tid] = expf(GG[(size_t)(row0 + tid) * 4 + hd]); egb[2 * tid + 1] = GB[(size_t)(row0 + tid) * 4 + hd]; }
  const size_t sbase = ((((size_t)l * 32 + b) * 4 + hd) * 128 + 64 * half) * 128 + dv;
  float S[64];
#pragma unroll
  for (int i = 0; i < 64; ++i) S[i] = P.state_gdn[sbase + (size_t)i * 128];
  __syncthreads();
  for (int t = 0; t < 16; ++t) {
    const float eg = egb[2 * t], bt = egb[2 * t + 1];
    const float* kt = ks + t * 128 + 64 * half;
    const float* qt = qs + t * 128 + 64 * half;
    float acc = 0.f;
#pragma unroll
    for (int i = 0; i < 64; ++i) { S[i] *= eg; acc += kt[i] * S[i]; }
    red[half * 128 + dv] = acc;
    __syncthreads();
    const float kS = red[dv] + red[128 + dv];
    const float d = bt * (vs[t * 128 + dv] - kS);
    float acc2 = 0.f;
#pragma unroll
    for (int i = 0; i < 64; ++i) { S[i] += kt[i] * d; acc2 += qt[i] * S[i]; }
    red2[half * 128 + dv] = acc2;
    __syncthreads();
    if (half == 0) OG[(size_t)(row0 + t) * 512 + hd * 128 + dv] = red2[dv] + red2[128 + dv];
  }
#pragma unroll
  for (int i = 0; i < 64; ++i) P.out[OUT_SGDN + sbase + (size_t)i * 128] = S[i];
}

DI void gdn_scan(const Params& P, int l, int item, char* smem) {
  const ushort_t* ANg = (const ushort_t*)(P.ws + O_AN);
  const float* BNg = (const float*)(P.ws + O_BN);
  u32x4* SPK = (u32x4*)(P.ws + O_SPK);
  ushort_t* ST = (ushort_t*)smem;
  const int tid = get_tid(), lane = tid & 63, b = tid >> 6, r = lane & 31, h = lane >> 5;
  const int hd = item >> 2, dvs = item & 3;
  __syncthreads();
  for (int i = tid; i < 32 * 136 / 2; i += 256) ((unsigned*)ST)[i] = 0u;
  {
    const u32x4 z = {0u, 0u, 0u, 0u};
    SPK[((((size_t)(0 * 4 + hd) * 4 + dvs) * 4 + b) * 2 + 0) * 64 + lane] = z;
    SPK[((((size_t)(0 * 4 + hd) * 4 + dvs) * 4 + b) * 2 + 1) * 64 + lane] = z;
  }
  bf16x8 Ac[8]; f32x16 Bc;
  {
    const int it = hd;
#pragma unroll
    for (int sx = 0; sx < 8; ++sx) Ac[sx] = *(const bf16x8*)(ANg + (size_t)it * 16384 + (32 * b + r) * 128 + 16 * sx + 8 * h);
#pragma unroll
    for (int g = 0; g < 4; ++g) {
      const float4 t = *(const float4*)(BNg + (size_t)it * 16384 + (((b * 4 + dvs) * 4 + g) * 64 + lane) * 4);
      Bc[4 * g] = t.x; Bc[4 * g + 1] = t.y; Bc[4 * g + 2] = t.z; Bc[4 * g + 3] = t.w;
    }
  }
  f32x16 acc = zero16();
  for (int n = 0; n < NCH; ++n) {
    const int cur = n & 1;
    bf16x8 An[8]; f32x16 Bn;
    {
      const int it = (n + 1 < NCH ? n + 1 : n) * 4 + hd;
#pragma unroll
      for (int sx = 0; sx < 8; ++sx) An[sx] = *(const bf16x8*)(ANg + (size_t)it * 16384 + (32 * b + r) * 128 + 16 * sx + 8 * h);
#pragma unroll
      for (int g = 0; g < 4; ++g) {
        const float4 t = *(const float4*)(BNg + (size_t)it * 16384 + (((b * 4 + dvs) * 4 + g) * 64 + lane) * 4);
        Bn[4 * g] = t.x; Bn[4 * g + 1] = t.y; Bn[4 * g + 2] = t.z; Bn[4 * g + 3] = t.w;
      }
    }
    __syncthreads();
    const ushort_t* Sc = ST + cur * (32 * 136);
    f32x16 a0 = Bc, a1 = zero16();
#pragma unroll
    for (int sx = 0; sx < 8; sx += 2) {
      a0 = MFMA(Ac[sx], *(const bf16x8*)(Sc + r * 136 + 16 * sx + 8 * h), a0);
      a1 = MFMA(Ac[sx + 1], *(const bf16x8*)(Sc + r * 136 + 16 * (sx + 1) + 8 * h), a1);
    }
#pragma unroll
    for (int i = 0; i < 16; ++i) acc[i] = a0[i] + a1[i];
    const u32x4 p0 = __builtin_bit_cast(u32x4, pack8<0>(acc));
    const u32x4 p1 = __builtin_bit_cast(u32x4, pack8<1>(acc));
    ushort_t* Sn = ST + (cur ^ 1) * (32 * 136) + r * 136 + 32 * b + 4 * h;
    *(uint2*)(Sn) = make_uint2(p0[0], p0[1]);
    *(uint2*)(Sn + 8) = make_uint2(p0[2], p0[3]);
    *(uint2*)(Sn + 16) = make_uint2(p1[0], p1[1]);
    *(uint2*)(Sn + 24) = make_uint2(p1[2], p1[3]);
    if (n + 1 < NCH) {
      SPK[((((size_t)((n + 1) * 4 + hd) * 4 + dvs) * 4 + b) * 2 + 0) * 64 + lane] = p0;
      SPK[((((size_t)((n + 1) * 4 + hd) * 4 + dvs) * 4 + b) * 2 + 1) * 64 + lane] = p1;
    }
#pragma unroll
    for (int sx = 0; sx < 8; ++sx) Ac[sx] = An[sx];
    Bc = Bn;
  }
#pragma unroll
  for (int i = 0; i < 16; ++i)
    P.out[OUT_PGDN + (((size_t)l * 4 + hd) * 128 + 32 * b + crow(i, h)) * 128 + 32 * dvs + r] = acc[i];
}

DI void gdn_out(const Params& P, int l, int item, char* smem) {
  const float* UTg = (const float*)(P.ws + O_UT);
  const ushort_t* WNg = (const ushort_t*)(P.ws + O_WN); const ushort_t* QGg = (const ushort_t*)(P.ws + O_QG);
  const ushort_t* QKMg = (const ushort_t*)(P.ws + O_QKM);
  const u32x4* SPK = (const u32x4*)(P.ws + O_SPK);
  const ushort_t* PROJ = (const ushort_t*)(P.ws + O_PROJ);
  ushort_t* MIX = (ushort_t*)(P.ws + O_MIX);
  ushort_t* WNs = (ushort_t*)smem;
  ushort_t* QGs = WNs + 64 * 136;
  ushort_t* QKs = QGs + 64 * 136;
  float* Os = (float*)smem;
  const int tid = get_tid(), lane = tid & 63, wave = tid >> 6, r = lane & 31, h = lane >> 5;
  const int n = item >> 2, hd = item & 3, dv0 = 32 * wave;
  __syncthreads();
  {
    const ushort_t* wsrc = WNg + (size_t)item * 8192; const ushort_t* qsrc = QGg + (size_t)item * 8192;
    const ushort_t* msrc = QKMg + (size_t)item * 4096;
#pragma unroll
    for (int i = 0; i < 4; ++i) {
      const int c = tid + 256 * i;
      *(u32x4*)(WNs + (c >> 4) * 136 + (c & 15) * 8) = *(const u32x4*)(wsrc + c * 8);
      *(u32x4*)(QGs + (c >> 4) * 136 + (c & 15) * 8) = *(const u32x4*)(qsrc + c * 8);
    }
#pragma unroll
    for (int i = 0; i < 2; ++i) {
      const int c = tid + 256 * i;
      *(u32x4*)(QKs + (c >> 3) * 72 + (c & 7) * 8) = *(const u32x4*)(msrc + c * 8);
    }
  }
  f32x16 vn[2];
#pragma unroll
  for (int cb = 0; cb < 2; ++cb)
#pragma unroll
    for (int g = 0; g < 4; ++g) {
      const float4 t = *(const float4*)(UTg + (size_t)item * 8192 + (dv0 + r) * 64 + 32 * cb + 8 * g + 4 * h);
      vn[cb][4 * g] = t.x; vn[cb][4 * g + 1] = t.y; vn[cb][4 * g + 2] = t.z; vn[cb][4 * g + 3] = t.w;
    }
  bf16x8 Sp[4][2];
#pragma unroll
  for (int b = 0; b < 4; ++b)
#pragma unroll
    for (int sx = 0; sx < 2; ++sx) Sp[b][sx] = __builtin_bit_cast(bf16x8, SPK[((((size_t)item * 4 + wave) * 4 + b) * 2 + sx) * 64 + lane]);
  __syncthreads();
#pragma unroll
  for (int cb = 0; cb < 2; ++cb)
#pragma unroll
    for (int b = 0; b < 4; ++b)
#pragma unroll
      for (int sx = 0; sx < 2; ++sx) vn[cb] = MFMA(fragP(WNs + (32 * cb + r) * 136 + 32 * b + 16 * sx, h), Sp[b][sx], vn[cb]);
  bf16x8 Vp[2][2];
  Vp[0][0] = pack8<0>(vn[0]); Vp[0][1] = pack8<1>(vn[0]); Vp[1][0] = pack8<0>(vn[1]); Vp[1][1] = pack8<1>(vn[1]);
  f32x16 o[2];
#pragma unroll
  for (int cb = 0; cb < 2; ++cb) {
    o[cb] = zero16();
#pragma unroll
    for (int b = 0; b < 4; ++b)
#pragma unroll
      for (int sx = 0; sx < 2; ++sx) o[cb] = MFMA(fragP(QGs + (32 * cb + r) * 136 + 32 * b + 16 * sx, h), Sp[b][sx], o[cb]);
#pragma unroll
    for (int cb2 = 0; cb2 <= cb; ++cb2)
#pragma unroll
      for (int sx = 0; sx < 2; ++sx) o[cb] = MFMA(fragP(QKs + (32 * cb + r) * 72 + 32 * cb2 + 16 * sx, h), Vp[cb2][sx], o[cb]);
  }
  __syncthreads();
#pragma unroll
  for (int cb = 0; cb < 2; ++cb)
#pragma unroll
    for (int i = 0; i < 16; ++i) Os[(32 * cb + crow(i, h)) * 132 + dv0 + r] = o[cb][i];
  __syncthreads();
  const float gw0 = P.gdn_norm[l * 128 + lane], gw1 = P.gdn_norm[l * 128 + 64 + lane];
#pragma unroll 4
  for (int rr = 0; rr < 16; ++rr) {
    const int c = 16 * wave + rr, row = 64 * n + c;
    const float o0 = Os[c * 132 + lane], o1 = Os[c * 132 + 64 + lane];
    const float z0 = bf2f(PROJ[(size_t)row * INP + OFF_Z + hd * 128 + lane]), z1 = bf2f(PROJ[(size_t)row * INP + OFF_Z + hd * 128 + 64 + lane]);
    const float ss = wave_sum(o0 * o0 + o1 * o1);
    const float rstd = rsqrtf(ss * (1.f / 128.f) + EPS);
    MIX[(size_t)row * 1024 + 512 + hd * 128 + lane] = f2bf(o0 * rstd * gw0 * siluf(z0));
    MIX[(size_t)row * 1024 + 512 + hd * 128 + 64 + lane] = f2bf(o1 * rstd * gw1 * siluf(z1));
  }
}

template <int NDB>
DI void softmax_pv(f32x16 (&st)[2], f32x16 (&o)[NDB], float& m, float& l, f32x16& negm, bool first, const ushort_t* Vs, int vpitch, int vcol0, int lane) {
  const int h = lane >> 5, i16 = lane & 15, q = i16 >> 2, p = i16 & 3, blk = (lane >> 4) & 1;
  const ushort_t* vb = Vs + (4 * h + q) * vpitch + vcol0 + 16 * blk + 4 * p;
  s16x4 vf[2][NDB][4];
#pragma unroll
  for (int kb = 0; kb < 2; ++kb)
#pragma unroll
    for (int db = 0; db < NDB; ++db)
#pragma unroll
      for (int j = 0; j < 4; ++j) vf[kb][db][j] = vtr(vb + (32 * kb + 8 * j) * vpitch + 32 * db);
  __builtin_amdgcn_sched_barrier(0);
  float mt = st[0][0];
#pragma unroll
  for (int kb = 0; kb < 2; ++kb)
#pragma unroll
    for (int i = 0; i < 16; ++i) mt = fmaxf(mt, st[kb][i]);
  mt = swap_max(mt);
  if (__builtin_amdgcn_ballot_w64(first || (mt > 8.f)) != 0ull) {
    const float d = first ? mt : fmaxf(mt, 0.f);
    const float alpha = first ? 1.f : __builtin_amdgcn_exp2f(-d);
    m += d;
    l *= alpha;
#pragma unroll
    for (int db = 0; db < NDB; ++db)
#pragma unroll
      for (int i = 0; i < 16; ++i) o[db][i] *= alpha;
#pragma unroll
    for (int kb = 0; kb < 2; ++kb)
#pragma unroll
      for (int i = 0; i < 16; ++i) st[kb][i] -= d;
    const float nm = -m;
#pragma unroll
    for (int i = 0; i < 16; ++i) negm[i] = nm;
  }
  float ls = 0.f;
#pragma unroll
  for (int kb = 0; kb < 2; ++kb)
#pragma unroll
    for (int i = 0; i < 16; ++i) { const float pv = __builtin_amdgcn_exp2f(st[kb][i]); st[kb][i] = pv; ls += pv; }
  l += ls;
  __builtin_amdgcn_s_setprio(1);
#pragma unroll
  for (int kb = 0; kb < 2; ++kb) {
    const bf16x8 p0 = pack8<0>(st[kb]);
    const bf16x8 p1 = pack8<1>(st[kb]);
#pragma unroll
    for (int db = 0; db < NDB; ++db) {
      o[db] = MFMA(cat8(vf[kb][db][0], vf[kb][db][1]), p0, o[db]);
      o[db] = MFMA(cat8(vf[kb][db][2], vf[kb][db][3]), p1, o[db]);
    }
  }
  __builtin_amdgcn_s_setprio(0);
}

template <int NDB>
DI void softmax_pv_simple(f32x16 (&st)[2], f32x16 (&o)[NDB], float& m, float& l, const ushort_t* Vs, int vpitch, int vcol0, int lane) {
  const int h = lane >> 5, i16 = lane & 15, q = i16 >> 2, p = i16 & 3, blk = (lane >> 4) & 1;
  float mt = st[0][0];
#pragma unroll
  for (int kb = 0; kb < 2; ++kb)
#pragma unroll
    for (int i = 0; i < 16; ++i) mt = fmaxf(mt, st[kb][i]);
  mt = swap_max(mt);
  const float mn = fmaxf(m, mt);
  const float alpha = __builtin_amdgcn_exp2f(m - mn);
  m = mn;
  float ls = 0.f;
#pragma unroll
  for (int kb = 0; kb < 2; ++kb)
#pragma unroll
    for (int i = 0; i < 16; ++i) { const float pv = __builtin_amdgcn_exp2f(st[kb][i] - mn); st[kb][i] = pv; ls += pv; }
  l = l * alpha + ls;
#pragma unroll
  for (int db = 0; db < NDB; ++db)
#pragma unroll
    for (int i = 0; i < 16; ++i) o[db][i] *= alpha;
  const ushort_t* vb = Vs + (4 * h + q) * vpitch + vcol0 + 16 * blk + 4 * p;
#pragma unroll
  for (int kb = 0; kb < 2; ++kb) {
    const bf16x8 p0 = pack8<0>(st[kb]);
    const bf16x8 p1 = pack8<1>(st[kb]);
#pragma unroll
    for (int db = 0; db < NDB; ++db) {
      const ushort_t* v0 = vb + (32 * kb) * vpitch + 32 * db;
      o[db] = MFMA(cat8(vtr(v0), vtr(v0 + 8 * vpitch)), p0, o[db]);
      o[db] = MFMA(cat8(vtr(v0 + 16 * vpitch), vtr(v0 + 24 * vpitch)), p1, o[db]);
    }
  }
}

DI void attn_prompt(const Params& P, int qt, int head, char* smem) {
  const ushort_t* QF = (const ushort_t*)(P.ws + O_QF); const ushort_t* KF = (const ushort_t*)(P.ws + O_KF);
  const ushort_t* VV = (const ushort_t*)(P.ws + O_VV); ushort_t* MIX = (ushort_t*)(P.ws + O_MIX);
  constexpr int KP = 104, VP = 72;
  ushort_t* Kb = (ushort_t*)smem;
  ushort_t* Vb = Kb + 2 * 64 * KP;
  const int tid = get_tid(), lane = tid & 63, wave = tid >> 6, r = lane & 31, h = lane >> 5;
  const int qrow = 128 * qt + 32 * wave + r;
  const int cq = 2 * qt + (wave >> 1);
  const int ntile = 2 * qt + 2;
  bf16x8 qf[6];
#pragma unroll
  for (int s = 0; s < 6; ++s) qf[s] = *(const bf16x8*)(QF + (size_t)qrow * 768 + head * 96 + 16 * s + 8 * h);
  f32x16 o[2]; o[0] = zero16(); o[1] = zero16();
  float m = 0.f, l = 0.f;
  f32x16 negm = zero16();
  u32x4 rk0, rk1, rk2, rv0, rv1;
  u32x4 sk0, sk1, sk2, sv0, sv1;
  const int kr0 = tid / 12, kc0 = tid % 12, kr1 = (tid + 256) / 12, kc1 = (tid + 256) % 12, kr2 = (tid + 512) / 12, kc2 = (tid + 512) % 12;
  const int vr0 = tid >> 3, vc0 = tid & 7, vr1 = (tid + 256) >> 3;
  const ushort_t* kg0 = KF + (size_t)kr0 * 768 + head * 96 + kc0 * 8;
  const ushort_t* kg1 = KF + (size_t)kr1 * 768 + head * 96 + kc1 * 8;
  const ushort_t* kg2 = KF + (size_t)kr2 * 768 + head * 96 + kc2 * 8;
  const ushort_t* vg0 = VV + (size_t)vr0 * 512 + head * 64 + vc0 * 8;
  const ushort_t* vg1 = VV + (size_t)vr1 * 512 + head * 64 + vc0 * 8;
#define ATT_GLOAD0(kt) { const size_t ko = (size_t)(kt) * 64 * 768, vo = (size_t)(kt) * 64 * 512; \
    rk0 = *(const u32x4*)(kg0 + ko); rk1 = *(const u32x4*)(kg1 + ko); rk2 = *(const u32x4*)(kg2 + ko); rv0 = *(const u32x4*)(vg0 + vo); rv1 = *(const u32x4*)(vg1 + vo); }
#define ATT_GLOAD1(kt) { const size_t ko = (size_t)(kt) * 64 * 768, vo = (size_t)(kt) * 64 * 512; \
    sk0 = *(const u32x4*)(kg0 + ko); sk1 = *(const u32x4*)(kg1 + ko); sk2 = *(const u32x4*)(kg2 + ko); sv0 = *(const u32x4*)(vg0 + vo); sv1 = *(const u32x4*)(vg1 + vo); }
#define ATT_LSTORE0(buf) { ushort_t* kd = Kb + (buf) * 64 * KP; ushort_t* vd = Vb + (buf) * 64 * VP; \
    *(u32x4*)(kd + kr0 * KP + kc0 * 8) = rk0; *(u32x4*)(kd + kr1 * KP + kc1 * 8) = rk1; *(u32x4*)(kd + kr2 * KP + kc2 * 8) = rk2; \
    *(u32x4*)(vd + vr0 * VP + vc0 * 8) = rv0; *(u32x4*)(vd + vr1 * VP + vc0 * 8) = rv1; }
#define ATT_LSTORE1(buf) { ushort_t* kd = Kb + (buf) * 64 * KP; ushort_t* vd = Vb + (buf) * 64 * VP; \
    *(u32x4*)(kd + kr0 * KP + kc0 * 8) = sk0; *(u32x4*)(kd + kr1 * KP + kc1 * 8) = sk1; *(u32x4*)(kd + kr2 * KP + kc2 * 8) = sk2; \
    *(u32x4*)(vd + vr0 * VP + vc0 * 8) = sv0; *(u32x4*)(vd + vr1 * VP + vc0 * 8) = sv1; }
#define ATT_COMPUTE(kt, buf) if ((kt) <= cq) { \
      const ushort_t* Ks = Kb + (buf) * 64 * KP; \
      f32x16 st[2]; st[0] = negm; st[1] = negm; \
      bf16x8 kf[12]; \
      _Pragma("unroll") for (int s = 0; s < 6; ++s) { \
        _Pragma("unroll") for (int kb = 0; kb < 2; ++kb) kf[2 * s + kb] = *(const bf16x8*)(Ks + (32 * kb + r) * KP + 16 * s + 8 * h); } \
      __builtin_amdgcn_sched_barrier(0); \
      __builtin_amdgcn_s_setprio(1); \
      _Pragma("unroll") for (int s = 0; s < 6; ++s) { \
        _Pragma("unroll") for (int kb = 0; kb < 2; ++kb) st[kb] = MFMA(kf[2 * s + kb], qf[s], st[kb]); } \
      __builtin_amdgcn_s_setprio(0); \
      if ((kt) == 0) { \
        _Pragma("unroll") for (int kb = 0; kb < 2; ++kb) \
          _Pragma("unroll") for (int i = 0; i < 16; ++i) if (32 * kb + crow(i, h) < POFF) st[kb][i] = -1e30f; } \
      softmax_pv<2>(st, o, m, l, negm, (kt) == 0, Vb + (buf) * 64 * VP, VP, 0, lane); }
  __syncthreads();
  ATT_GLOAD0(0);
  ATT_GLOAD1(1);
  ATT_LSTORE0(0);
  const int lastt = ntile - 1;
  ATT_GLOAD0(min(2, lastt));
  __syncthreads();
  for (int kt = 0; kt < ntile; kt += 2) {
    ATT_COMPUTE(kt, 0);
    ATT_LSTORE1(1);
    ATT_GLOAD1(min(kt + 3, lastt));
    __syncthreads();
    ATT_COMPUTE(kt + 1, 1);
    ATT_LSTORE0(0);
    ATT_GLOAD0(min(kt + 4, lastt));
    __syncthreads();
  }
#undef ATT_GLOAD0
#undef ATT_GLOAD1
#undef ATT_LSTORE0
#undef ATT_LSTORE1
#undef ATT_COMPUTE
  const float inv = 1.f / swap_sum(l);
#pragma unroll
  for (int db = 0; db < 2; ++db)
#pragma unroll
    for (int g = 0; g < 4; ++g)
      *(uint2*)(MIX + (size_t)qrow * 1024 + head * 64 + 32 * db + 8 * g + 4 * h) =
          make_uint2(pk2(o[db][4 * g] * inv, o[db][4 * g + 1] * inv), pk2(o[db][4 * g + 2] * inv, o[db][4 * g + 3] * inv));
}

DI void attn_sample(const Params& P, int l, int b, int sp, int hg, char* smem) {
  const ushort_t* QF = (const ushort_t*)(P.ws + O_QF); const ushort_t* QL = (const ushort_t*)(P.ws + O_QL);
  const ushort_t* CKV = (const ushort_t*)(P.ws + O_CKV); const ushort_t* KPE = (const ushort_t*)(P.ws + O_KPE);
  float* PO = (float*)(P.ws + O_PO); float* PML = (float*)(P.ws + O_PML);
  constexpr int KP = 296;
  ushort_t* Qs = (ushort_t*)smem;
  ushort_t* Kt = Qs + 64 * KP;
  const int tid = get_tid(), lane = tid & 63, wave = tid >> 6, r = lane & 31, h = lane >> 5;
  const int qb = wave & 1, dvh = wave >> 1;
  __syncthreads();
#pragma unroll
  for (int i = 0; i < 9; ++i) {
    const int c = tid + 256 * i, q = c / 36, cc = c % 36;
    const int hh = q >> 4, tok = q & 15, head = 4 * hg + hh, srow = 16 * b + tok;
    uint4 v;
    if (cc < 32) v = *(const uint4*)(QL + (size_t)srow * 2048 + head * 256 + cc * 8);
    else v = *(const uint4*)(QF + (size_t)(SOFF + srow) * 768 + head * 96 + 64 + (cc - 32) * 8);
    *(uint4*)(Qs + q * KP + cc * 8) = v;
  }
  f32x16 o[4]; o[0] = zero16(); o[1] = zero16(); o[2] = zero16(); o[3] = zero16();
  float m = -1e30f, lsum = 0.f;
  const int nt = (sp == 7) ? 9 : 8;
  const float* clat = P.cache_lat + (((size_t)l * 32 + b) * PAST + (size_t)sp * 512) * 256;
  const float* cpe = P.cache_pe + (((size_t)l * 32 + b) * PAST + (size_t)sp * 512) * 32;
  for (int ti = 0; ti < nt; ++ti) {
    __syncthreads();
    if (ti < 8) {
      const float* lat = clat + (size_t)ti * 64 * 256;
#pragma unroll
      for (int bt = 0; bt < 4; ++bt) {
        float4 t[4];
#pragma unroll
        for (int i = 0; i < 4; ++i) t[i] = *(const float4*)(lat + (size_t)(tid + 256 * (4 * bt + i)) * 4);
#pragma unroll
        for (int i = 0; i < 4; ++i) {
          const int c = tid + 256 * (4 * bt + i), row = c >> 6, c4 = (c & 63) * 4;
          *(uint2*)(Kt + row * KP + c4) = make_uint2(pk2(t[i].x, t[i].y), pk2(t[i].z, t[i].w));
        }
      }
      const float* pe = cpe + (size_t)ti * 64 * 32;
#pragma unroll
      for (int i = 0; i < 2; ++i) {
        const int c = tid + 256 * i, row = c >> 3, c4 = (c & 7) * 4;
        const float4 t = *(const float4*)(pe + (size_t)c * 4);
        *(uint2*)(Kt + row * KP + 256 + c4) = make_uint2(pk2(t.x, t.y), pk2(t.z, t.w));
      }
    } else {
#pragma unroll
      for (int i = 0; i < 9; ++i) {
        const int c = tid + 256 * i, row = c / 36, cc = c % 36;
        uint4 v = make_uint4(0u, 0u, 0u, 0u);
        if (row < 16) {
          if (cc < 32) v = *(const uint4*)(CKV + (size_t)(SOFF + 16 * b + row) * 256 + cc * 8);
          else v = *(const uint4*)(KPE + (size_t)(SOFF + 16 * b + row) * 32 + (cc - 32) * 8);
        }
        *(uint4*)(Kt + row * KP + cc * 8) = v;
      }
    }
    __syncthreads();
    f32x16 st[2]; st[0] = zero16(); st[1] = zero16();
#pragma unroll
    for (int s = 0; s < 18; ++s) {
      const bf16x8 qv = *(const bf16x8*)(Qs + (32 * qb + r) * KP + 16 * s + 8 * h);
#pragma unroll
      for (int kb = 0; kb < 2; ++kb) st[kb] = MFMA(*(const bf16x8*)(Kt + (32 * kb + r) * KP + 16 * s + 8 * h), qv, st[kb]);
    }
    if (ti == 8) {
#pragma unroll
      for (int kb = 0; kb < 2; ++kb)
#pragma unroll
        for (int i = 0; i < 16; ++i) if (32 * kb + crow(i, h) >= 16) st[kb][i] = -1e30f;
    }
    softmax_pv_simple<4>(st, o, m, lsum, Kt, KP, 128 * dvh, lane);
  }
  const float lt = swap_sum(lsum);
  const int gq = 64 * hg + 32 * qb + r;
  const size_t pbase = ((size_t)(b * 8 + sp) * 128 + gq);
  if (dvh == 0 && h == 0) { PML[pbase * 2] = m; PML[pbase * 2 + 1] = lt; }
#pragma unroll
  for (int db = 0; db < 4; ++db)
#pragma unroll
    for (int g = 0; g < 4; ++g)
      *(float4*)(PO + pbase * 256 + 128 * dvh + 32 * db + 8 * g + 4 * h) = make_float4(o[db][4 * g], o[db][4 * g + 1], o[db][4 * g + 2], o[db][4 * g + 3]);
}


DI bool tile_swz(int t, int MT, int NT, int& mt, int& nt) {
  const int G = gridDim.x, b = blockIdx.x;
  int u = t;
  if ((G & 7) == 0) u = (t / G) * G + (b & 7) * (G >> 3) + (b >> 3);
  if (u >= MT * NT) return false;
  const int full = (NT >> 3) * MT * 8;
  if (u < full) { const int g = u / (MT * 8), rem = u % (MT * 8); mt = rem >> 3; nt = g * 8 + (rem & 7); }
  else { const int rem = u - full, w = NT & 7; mt = rem / w; nt = (NT >> 3) * 8 + rem % w; }
  return true;
}
DI int round_up_grid(int n) { const int G = gridDim.x; return ((n + G - 1) / G) * G; }

DI void phase_g1(const Params& P, int l, char* smem) {
  const ushort_t* Wl = (const ushort_t*)(P.ws + O_W) + (size_t)l * E_WL;
  for (int t = blockIdx.x; t < round_up_grid(133 * 11); t += gridDim.x) {
    int mt, nt; if (!tile_swz(t, 133, 11, mt, nt)) continue;
    gemm_tile_w((const ushort_t*)(P.ws + O_XN), 1024, Wl + E_WT_IN, 1024, 1024, mt * 128, nt * 256, smem, EpiBF16{(ushort_t*)(P.ws + O_PROJ), INP, 1.f});
  }
}

DI void phase_mid(const Params& P, int l, char* smem) {
  const ushort_t* Wl = (const ushort_t*)(P.ws + O_W) + (size_t)l * E_WL;
  const ushort_t* CQN = (const ushort_t*)(P.ws + O_CQN);
  constexpr int N_G2 = 133 * 6, N_G2S = 4 * 16, N_G3 = 129 * 8, N_PREP = NITEM, N_GS = 128;
  constexpr int TOT = N_G2 + N_G2S + N_G3 + N_PREP + N_GS;
  for (int t0 = blockIdx.x; t0 < TOT; t0 += gridDim.x) {
    int t = t0;
    if (t < N_PREP) { gdn_prep(P, t, smem); continue; }
    t -= N_PREP;
    if (t < N_GS) { gdn_sample(P, l, t, smem); continue; }
    t -= N_GS;
    if (t < N_G3) { gemm_tile((const ushort_t*)(P.ws + O_CKV), 256, Wl + E_WT_UKV, 256, 256, (t / 8) * 128, (t % 8) * 128, smem, EpiKV{(ushort_t*)(P.ws + O_KF), (ushort_t*)(P.ws + O_VV)}); continue; }
    t -= N_G3;
    if (t < N_G2) { gemm_tile(CQN, 384, Wl + E_WT_UQ, 384, 384, (t / 6) * 128, (t % 6) * 128, smem, EpiQ{(ushort_t*)(P.ws + O_QF)}); continue; }
    t -= N_G2;
    gemm_tile(CQN, 384, Wl + E_WABS, 384, 384, SOFF + (t / 16) * 128, (t % 16) * 128, smem, EpiBF16{(ushort_t*)(P.ws + O_QL) - (size_t)SOFF * 2048, 2048, QSCALE});
  }
}

DI void phase_mix(const Params& P, int l, char* smem, int flags) {
  int* ctr = (int*)(P.ws + O_CTR) + l * 16;
  volatile int* slot = (volatile int*)(smem + 75776);
  const int myq = (int)(xcc_id_early() & 7u);
  if (threadIdx.x == 0) slot[1] = 0;
  while (true) {
    __syncthreads();
    if (threadIdx.x == 0) {
      int stg = slot[1], code = -1;
      while (stg < 10) {
        if (stg == 0) { const int t = atomicAdd(&ctr[0], 1); if (t < 16) { code = t; break; } stg = 1; }
        else if (stg == 2) { const int t = atomicAdd(&ctr[9], 1); if (t < 512) { code = 16 + 1032 + t; break; } stg = 3; }
        else { const int q = (stg == 1) ? myq : ((myq + stg - 2) & 7); const int t = atomicAdd(&ctr[1 + q], 1); if (t < 129) { code = 16 + (128 - t) * 8 + q; break; } ++stg; }
      }
      slot[1] = stg; slot[0] = code;
    }
    __syncthreads();
    int t = slot[0];
    if (t < 0) break;
    if (t < 16) { if (flags == 0 || flags == 1) gdn_scan(P, l, t, smem); continue; }
    t -= 16;
    if (t < 1032) { if (flags == 0 || flags == 2) attn_prompt(P, t >> 3, t & 7, smem); continue; }
    t -= 1032;
    if (flags == 0 || flags == 3) attn_sample(P, l, t >> 4, (t >> 1) & 7, t & 1, smem);
  }
}

DI void phase_gate(const Params& P, int l, char* smem) {
  const float* OG = (const float*)(P.ws + O_OG); const ushort_t* PROJ = (const ushort_t*)(P.ws + O_PROJ);
  ushort_t* MIX = (ushort_t*)(P.ws + O_MIX); ushort_t* MIXS = (ushort_t*)(P.ws + O_MIXS);
  const float* PO = (const float*)(P.ws + O_PO); const float* PML = (const float*)(P.ws + O_PML);
  const int tid = get_tid(), lane = tid & 63, gw = blockIdx.x * 4 + (tid >> 6), nw = gridDim.x * 4;
  for (int t = blockIdx.x; t < NITEM; t += gridDim.x) gdn_out(P, l, t, smem);
  for (int row = SOFF + gw; row < MTOT; row += nw) {
    const bool valid = row_valid(row);
#pragma unroll
    for (int hd = 0; hd < 4; ++hd) {
      float o0 = 0.f, o1 = 0.f, z0 = 0.f, z1 = 0.f;
      if (valid) {
        o0 = OG[(size_t)row * 512 + hd * 128 + lane]; o1 = OG[(size_t)row * 512 + hd * 128 + 64 + lane];
        z0 = bf2f(PROJ[(size_t)row * INP + OFF_Z + hd * 128 + lane]); z1 = bf2f(PROJ[(size_t)row * INP + OFF_Z + hd * 128 + 64 + lane]);
      }
      const float ss = wave_sum(o0 * o0 + o1 * o1);
      const float rstd = rsqrtf(ss * (1.f / 128.f) + EPS);
      const float v0 = o0 * rstd * P.gdn_norm[l * 128 + lane] * siluf(z0);
      const float v1 = o1 * rstd * P.gdn_norm[l * 128 + 64 + lane] * siluf(z1);
      if (row < SOFF) { MIX[(size_t)row * 1024 + 512 + hd * 128 + lane] = f2bf(v0); MIX[(size_t)row * 1024 + 512 + hd * 128 + 64 + lane] = f2bf(v1); }
      else { MIXS[(size_t)(row - SOFF) * 2560 + 2048 + hd * 128 + lane] = f2bf(v0); MIXS[(size_t)(row - SOFF) * 2560 + 2048 + hd * 128 + 64 + lane] = f2bf(v1); }
    }
  }
  for (int it = gw; it < 32 * 128; it += nw) {
    const int b = it >> 7, gq = it & 127, head = gq >> 4, tok = gq & 15;
    float ms[8], mx = -1e30f;
#pragma unroll
    for (int sp = 0; sp < 8; ++sp) { ms[sp] = PML[((size_t)(b * 8 + sp) * 128 + gq) * 2]; mx = fmaxf(mx, ms[sp]); }
    float L = 0.f; float4 acc = make_float4(0.f, 0.f, 0.f, 0.f);
#pragma unroll
    for (int sp = 0; sp < 8; ++sp) {
      const float w = __builtin_amdgcn_exp2f(ms[sp] - mx);
      L += w * PML[((size_t)(b * 8 + sp) * 128 + gq) * 2 + 1];
      const float4 t = *(const float4*)(PO + ((size_t)(b * 8 + sp) * 128 + gq) * 256 + lane * 4);
      acc.x += w * t.x; acc.y += w * t.y; acc.z += w * t.z; acc.w += w * t.w;
    }
    const float inv = 1.f / L;
    *(uint2*)(MIXS + (size_t)(16 * b + tok) * 2560 + head * 256 + lane * 4) = make_uint2(pk2(acc.x * inv, acc.y * inv), pk2(acc.z * inv, acc.w * inv));
  }
}

DI void phase_g6(const Params& P, int l, char* smem) {
  const ushort_t* Wl = (const ushort_t*)(P.ws + O_W) + (size_t)l * E_WL;
  ushort_t* OMIX = (ushort_t*)(P.ws + O_OMIX);
  for (int t = blockIdx.x; t < round_up_grid(133 * 16); t += gridDim.x) {
    int mt, n2; if (!tile_swz(t, 133, 16, mt, n2)) continue;
    const int nt = n2 >> 1, ks = n2 & 1;
    ushort_t* dst = OMIX + (size_t)ks * MTOT * 1024;
    if (mt < 129) gemm_tile((const ushort_t*)(P.ws + O_MIX) + ks * 512, 1024, Wl + E_WT_O + ks * 512, 1024, 512, mt * 128, nt * 128, smem, EpiBF16{dst, 1024, 1.f});
    else gemm_tile((const ushort_t*)(P.ws + O_MIXS) - (size_t)SOFF * 2560 + ks * 1280, 2560, Wl + E_WT_OS + ks * 1280, 2560, 1280, mt * 128, nt * 128, smem, EpiBF16{dst, 1024, 1.f});
  }
}

DI void phase_resid(const Params& P, const float* w1, const float* w2, bool final_out, bool first) {
  const ushort_t* OMIX = (const ushort_t*)(P.ws + O_OMIX);
  const float* X = (const float*)(P.ws + (first ? O_X : O_X2)); float* XO = (float*)(P.ws + (first ? O_X2 : O_X)); ushort_t* XN = (ushort_t*)(P.ws + O_XN);
  const int tid = get_tid(), lane = tid & 63, gw = blockIdx.x * 4 + (tid >> 6), nw = gridDim.x * 4;
  for (int row = gw; row < MTOT; row += nw) {
    const bool valid = row_valid(row);
    float v[16], ss = 0.f;
#pragma unroll
    for (int j = 0; j < 4; ++j) {
      const uint2 t = *(const uint2*)(OMIX + (size_t)row * 1024 + 4 * lane + 256 * j);
      const uint2 t2 = *(const uint2*)(OMIX + (size_t)MTOT * 1024 + (size_t)row * 1024 + 4 * lane + 256 * j);
      v[4 * j] = __uint_as_float(t.x << 16) + __uint_as_float(t2.x << 16); v[4 * j + 1] = __uint_as_float(t.x & 0xffff0000u) + __uint_as_float(t2.x & 0xffff0000u);
      v[4 * j + 2] = __uint_as_float(t.y << 16) + __uint_as_float(t2.y << 16); v[4 * j + 3] = __uint_as_float(t.y & 0xffff0000u) + __uint_as_float(t2.y & 0xffff0000u);
    }
#pragma unroll
    for (int i = 0; i < 16; ++i) { v[i] = valid ? v[i] : 0.f; ss += v[i] * v[i]; }
    ss = wave_sum(ss);
    const float rstd = rsqrtf(ss * (1.f / 1024.f) + EPS);
#pragma unroll
    for (int j = 0; j < 4; ++j) {
      const int c = 4 * lane + 256 * j;
      const float4 xv = *(const float4*)(X + (size_t)row * 1024 + c);
      const float4 wv = *(const float4*)(w1 + c);
      v[4 * j] = xv.x + v[4 * j] * rstd * wv.x; v[4 * j + 1] = xv.y + v[4 * j + 1] * rstd * wv.y;
      v[4 * j + 2] = xv.z + v[4 * j + 2] * rstd * wv.z; v[4 * j + 3] = xv.w + v[4 * j + 3] * rstd * wv.w;
    }
    if (final_out) {
      if (valid) {
        float* dst = nullptr;
        if (row >= SOFF) dst = P.out + OUT_YS + (size_t)(row - SOFF) * 1024;
        else if (row >= POFF + 16) dst = P.out + OUT_YP + (size_t)(row - POFF - 16) * 1024;
        if (dst) {
#pragma unroll
          for (int j = 0; j < 4; ++j) *(float4*)(dst + 4 * lane + 256 * j) = make_float4(v[4 * j], v[4 * j + 1], v[4 * j + 2], v[4 * j + 3]);
        }
      }
    } else {
      norm_store_row(v, XO + (size_t)row * 1024, XN + (size_t)row * 1024, w2, lane, valid);
    }
  }
}

DI void phase_g7(const Params& P, int l, char* smem) {
  const ushort_t* Wl = (const ushort_t*)(P.ws + O_W) + (size_t)l * E_WL;
  for (int t = blockIdx.x; t < round_up_grid(133 * 22); t += gridDim.x) {
    int mt, nt; if (!tile_swz(t, 133, 22, mt, nt)) continue;
    gemm_tile_w((const ushort_t*)(P.ws + O_XN), 1024, Wl + E_WT_GU, 1024, 1024, mt * 128, nt * 256, smem, EpiSwiGLU{(ushort_t*)(P.ws + O_ACT)});
  }
}
DI void phase_g8(const Params& P, int l, char* smem) {
  const ushort_t* Wl = (const ushort_t*)(P.ws + O_W) + (size_t)l * E_WL;
  for (int t = blockIdx.x; t < round_up_grid(133 * 16); t += gridDim.x) {
    int mt, n2; if (!tile_swz(t, 133, 16, mt, n2)) continue;
    const int nt = n2 >> 1, ks = n2 & 1;
    gemm_tile((const ushort_t*)(P.ws + O_ACT) + ks * 1408, DFF, Wl + E_WT_DOWN + ks * 1408, DFF, 1408, mt * 128, nt * 128, smem,
              EpiBF16{(ushort_t*)(P.ws + O_OMIX) + (size_t)ks * MTOT * 1024, 1024, 1.f});
  }
}

#define XB_TMO      128
#define XB_XCNT(j)  (256  + 64 * (j))
#define XB_XSUB(j)  (1280 + 64 * (j))
#define XB_XGEN(j)  (2304 + 64 * (j))
#define XB_TOP      3328
#define XB_TOPGEN   3392
#define XCD_BAR_WORDS 3456
#define XB_SPIN_CAP (1u << 22)
#define LAS __attribute__((address_space(3)))
DI unsigned xb_ld(unsigned* p) { return __hip_atomic_load(p, __ATOMIC_RELAXED, __HIP_MEMORY_SCOPE_AGENT); }
DI unsigned xb_add(unsigned* p, unsigned v) { return __hip_atomic_fetch_add(p, v, __ATOMIC_RELAXED, __HIP_MEMORY_SCOPE_AGENT); }
DI unsigned xb_xcc_id() { return (unsigned)__builtin_amdgcn_s_getreg((3 << 11) | 20) & 0xFu; }
#define XB_SPIN(cond, bar) do { unsigned _sp = 0; while (cond) { __builtin_amdgcn_s_sleep(1); \
    if ((++_sp & 255u) == 0u) { if (xb_ld(&(bar)[XB_TMO])) break; if (_sp > XB_SPIN_CAP) { atomicAdd(&(bar)[XB_TMO], 1u); break; } } } } while (0)
struct XcdBarrier { unsigned* bar; unsigned x; volatile LAS unsigned* st; };
DI XcdBarrier xcd_barrier_post(unsigned* bar, volatile LAS unsigned* st) {
  XcdBarrier b; b.bar = bar; b.x = xb_xcc_id(); b.st = st;
  if (threadIdx.x == 0) (void)xb_add(&bar[XB_XCNT(b.x)], 1u);
  return b;
}
DI void xcd_barrier_complete(unsigned* bar, unsigned x, unsigned& nloc, unsigned& nx) {
  const unsigned G = gridDim.x * gridDim.y * gridDim.z;
  unsigned sum, cnt, mine, sp = 0u;
  for (;;) {
    sum = 0u; cnt = 0u; mine = 0u;
#pragma unroll
    for (unsigned j = 0; j < 16; ++j) { const unsigned c = xb_ld(&bar[XB_XCNT(j)]); sum += c; cnt += (c > 0u) ? 1u : 0u; mine = (j == x) ? c : mine; }
    if (sum == G) break;
    __builtin_amdgcn_s_sleep(1);
    if ((++sp & 255u) == 0u) { if (xb_ld(&bar[XB_TMO])) break; if (sp > XB_SPIN_CAP) { atomicAdd(&bar[XB_TMO], 1u); break; } }
  }
  nloc = mine > 0u ? mine : 1u; nx = cnt > 0u ? cnt : 1u;
}
DI void xcd_barrier(const XcdBarrier& b) {
  asm volatile("s_waitcnt vmcnt(0)" ::: "memory");
  __syncthreads();
  if (threadIdx.x == 0) {
    unsigned* bar = b.bar;
    __builtin_amdgcn_s_waitcnt(0);
    unsigned nloc = b.st[0], nx = b.st[1];
    if (nloc == 0u) { xcd_barrier_complete(bar, b.x, nloc, nx); b.st[0] = nloc; b.st[1] = nx; }
    const unsigned old = xb_add(&bar[XB_XSUB(b.x)], 1u);
    const unsigned gen = old / nloc;
    if (old + 1u == (gen + 1u) * nloc) {
      __builtin_amdgcn_fence(__ATOMIC_RELEASE, "agent");
      asm volatile("s_waitcnt vmcnt(0)" ::: "memory");
      const unsigned og = xb_add(&bar[XB_TOP], 1u);
      const unsigned tg = og / nx;
      if (og + 1u == (tg + 1u) * nx) xb_add(&bar[XB_TOPGEN], 1u);
      else XB_SPIN(xb_ld(&bar[XB_TOPGEN]) == tg, bar);
      __builtin_amdgcn_fence(__ATOMIC_ACQUIRE, "agent");
      xb_add(&bar[XB_XGEN(b.x)], 1u);
      asm volatile("s_waitcnt vmcnt(0)" ::: "memory");
    } else {
      XB_SPIN(xb_ld(&bar[XB_XGEN(b.x)]) == gen, bar);
      __builtin_amdgcn_fence(__ATOMIC_ACQUIRE, "agent");
      asm volatile("s_waitcnt vmcnt(0)" ::: "memory");
    }
  }
  __syncthreads();
}

constexpr int NPHASE = 2 + 10 * DEPTH;

DI void run_phase(const Params& P, int ph, char* smem, int flags) {
  if (ph == 0) { phase_prep0(P, smem); return; }
  if (ph == 1) { phase_prep1(P, smem); return; }
  const int l = (ph - 2) / 10, sub = (ph - 2) % 10;
  switch (sub) {
    case 0: phase_g1(P, l, smem); break;
    case 1: phase_rowpass(P, l); break;
    case 2: phase_mid(P, l, smem); break;
    case 3: phase_mix(P, l, smem, flags); break;
    case 4: phase_gate(P, l, smem); break;
    case 5: phase_g6(P, l, smem); break;
    case 6: phase_resid(P, P.post_mix + l * 1024, P.pre_ffn + l * 1024, false, true); break;
    case 7: phase_g7(P, l, smem); break;
    case 8: phase_g8(P, l, smem); break;
    default: phase_resid(P, P.post_ffn + l * 1024, P.pre_mix + (l < 3 ? l + 1 : 0) * 1024, l == 3, false); break;
  }
}

template <bool COOP>
__global__ void __launch_bounds__(256, 2) mega_kernel(Params P, int ph0, int ph1, int flags) {
  __shared__ __attribute__((aligned(16))) char smem[SMEM_BYTES];
  if (COOP) {
    __shared__ uint4 xb_words;
    if (threadIdx.x == 0) xb_words = make_uint4(0u, 0u, 0u, 0u);
    __syncthreads();
    XcdBarrier xb = xcd_barrier_post((unsigned*)(P.ws + O_BAR), (volatile LAS unsigned*)&xb_words);
    for (int ph = ph0; ph < ph1; ++ph) {
      run_phase(P, ph, smem, flags);
      if (ph + 1 < ph1) {
        if (flags == 0x7fffffff) cg::this_grid().sync();
        xcd_barrier(xb);
      }
    }
  } else {
    for (int ph = ph0; ph < ph1; ++ph) run_phase(P, ph, smem, flags);
  }
}

extern "C" void kernel_launch(void* const* d_in, const int* in_sizes, int n_in, void* d_out, int out_size, void* d_ws,
                              size_t ws_size, hipStream_t stream) {
  Params P{};
  const float** pp = (const float**)&P;
  for (int i = 0; i < 25; ++i) pp[i] = (const float*)d_in[i];
  P.out = (float*)d_out;
  P.ws = (char*)d_ws;
  if (ws_size < O_END) { fprintf(stderr, "workspace too small: %zu < %zu\n", ws_size, (size_t)O_END); return; }
#if ONE_LAUNCH
  static int grid_blocks = 0;
  if (!grid_blocks) {
    int dev = 0, cus = 0, per_cu = 0;
    hipGetDevice(&dev);
    hipDeviceGetAttribute(&cus, hipDeviceAttributeMultiprocessorCount, dev);
    hipOccupancyMaxActiveBlocksPerMultiprocessor(&per_cu, mega_kernel<true>, 256, 0);
    if (per_cu > 2) per_cu = 2;
    grid_blocks = cus * per_cu;
  }
  hipMemsetAsync((char*)d_ws + O_BAR, 0, XCD_BAR_WORDS * 4, stream);
  int ph0 = 0, ph1 = NPHASE, flags = 0;
  void* args[] = {&P, &ph0, &ph1, &flags};
  hipError_t e = hipLaunchCooperativeKernel((void*)mega_kernel<true>, dim3(grid_blocks), dim3(256), args, 0, stream);
  if (e != hipSuccess) fprintf(stderr, "cooperative launch failed: %s (grid %d)\n", hipGetErrorString(e), grid_blocks);
#else
  for (int ph = 0; ph < NPHASE; ++ph) {
    mega_kernel<false><<<512, 256, 0, stream>>>(P, ph, ph + 1, 0);
    if ((ph >= 2 && ((PROBE_MASK >> ((ph - 2) % 10)) & 1)) || (ph < 2 && ((PROBE_MASK >> (10 + ph)) & 1))) {
      if (ph >= 2 && (ph - 2) % 10 == 3) hipMemsetAsync((char*)d_ws + O_CTR, 0, 256, stream);
      mega_kernel<false><<<512, 256, 0, stream>>>(P, ph, ph + 1, PROBE_FLAGS);
    }
  }
#endif
}
```

```cpp
#include <hip/hip_runtime.h>
#include <hip/hip_cooperative_groups.h>
#include <cstdio>
namespace cg = cooperative_groups;

#ifndef ONE_LAUNCH
#define ONE_LAUNCH 1
#endif
#ifndef PROBE_MASK
#define PROBE_MASK 0
#endif
#ifndef PROBE_FLAGS
#define PROBE_FLAGS 0
#endif

#define DI __device__ __forceinline__
typedef unsigned short ushort_t;
typedef short bf16x8 __attribute__((ext_vector_type(8)));
typedef short s16x4 __attribute__((ext_vector_type(4)));
typedef float f32x16 __attribute__((ext_vector_type(16)));
typedef float f32x2v __attribute__((ext_vector_type(2)));
typedef __bf16 bf16x2v __attribute__((ext_vector_type(2)));
typedef unsigned u32x4 __attribute__((ext_vector_type(4)));
#define MFMA(a, b, c) __builtin_amdgcn_mfma_f32_32x32x16_bf16((a), (b), (c), 0, 0, 0)

constexpr int DM = 1024, LTOK = 16400, DEPTH = 4, DECB = 32, DECT = 16, PAST = 4096;
constexpr int POFF = 48, PEND = 16448, SOFF = 16512, MTOT = 17024;
constexpr int NCH = 257, NITEM = NCH * 4;
constexpr int INP = 2816, DFF = 2816;
constexpr int OFF_KV = 384, OFF_PE = 640, OFF_QKV = 672, OFF_Z = 2208, OFF_B = 2720, OFF_A = 2724, INW = 2728;
constexpr float EPS = 1e-6f;
constexpr float QSCALE = 0.10206207261596577f * 1.4426950408889634f;
constexpr int SMEM_BYTES = 75776 + 16;

constexpr size_t OUT_YP = 0;
constexpr size_t OUT_YS = OUT_YP + (size_t)16384 * 1024;
constexpr size_t OUT_PLAT = OUT_YS + (size_t)512 * 1024;
constexpr size_t OUT_PPE = OUT_PLAT + (size_t)4 * LTOK * 256;
constexpr size_t OUT_PGDN = OUT_PPE + (size_t)4 * LTOK * 32;
constexpr size_t OUT_PCONV = OUT_PGDN + (size_t)4 * 4 * 128 * 128;
constexpr size_t OUT_SLAT = OUT_PCONV + (size_t)4 * 3 * 1536;
constexpr size_t OUT_SPE = OUT_SLAT + (size_t)4 * 32 * 16 * 256;
constexpr size_t OUT_SGDN = OUT_SPE + (size_t)4 * 32 * 16 * 32;
constexpr size_t OUT_SCONV = OUT_SGDN + (size_t)4 * 32 * 4 * 128 * 128;

constexpr size_t al256(size_t x) { return (x + 255) & ~(size_t)255; }
constexpr size_t E_WT_IN = 0;
constexpr size_t E_WT_UQ = E_WT_IN + (size_t)2816 * 1024;
constexpr size_t E_WUQ_BF = E_WT_UQ + (size_t)768 * 384;
constexpr size_t E_WT_UKV = E_WUQ_BF + (size_t)384 * 768;
constexpr size_t E_WUK_BF = E_WT_UKV + (size_t)1024 * 256;
constexpr size_t E_WUV_BF = E_WUK_BF + (size_t)256 * 512;
constexpr size_t E_WABS = E_WUV_BF + (size_t)256 * 512;
constexpr size_t E_WT_O = E_WABS + (size_t)2048 * 384;
constexpr size_t E_WT_OS = E_WT_O + (size_t)1024 * 1024;
constexpr size_t E_WT_GU = E_WT_OS + (size_t)1024 * 2560;
constexpr size_t E_WT_DOWN = E_WT_GU + (size_t)5632 * 1024;
constexpr size_t E_WL = E_WT_DOWN + (size_t)1024 * 2816;

constexpr size_t O_CTR = 0;
constexpr size_t O_BAR = 1024;
constexpr size_t O_W = 16384;
constexpr size_t O_X = al256(O_W + 4 * E_WL * 2);
constexpr size_t O_XN = al256(O_X + (size_t)MTOT * 1024 * 4);
constexpr size_t O_PROJ = al256(O_XN + (size_t)MTOT * 1024 * 2);
constexpr size_t O_CQN = al256(O_PROJ + (size_t)MTOT * INP * 4);
constexpr size_t O_CKV = al256(O_CQN + (size_t)MTOT * 384 * 2);
constexpr size_t O_KPE = al256(O_CKV + (size_t)MTOT * 256 * 2);
constexpr size_t O_QF = al256(O_KPE + (size_t)MTOT * 32 * 2);
constexpr size_t O_QL = al256(O_QF + (size_t)MTOT * 768 * 2);
constexpr size_t O_KF = al256(O_QL + (size_t)512 * 2048 * 2);
constexpr size_t O_VV = al256(O_KF + (size_t)SOFF * 768 * 2);
constexpr size_t O_GQ = al256(O_VV + (size_t)SOFF * 512 * 2);
constexpr size_t O_GK = al256(O_GQ + (size_t)MTOT * 512 * 4);
constexpr size_t O_GV = al256(O_GK + (size_t)MTOT * 512 * 4);
constexpr size_t O_GB = al256(O_GV + (size_t)MTOT * 512 * 4);
constexpr size_t O_GG = al256(O_GB + (size_t)MTOT * 4 * 4);
constexpr size_t O_UT = al256(O_GG + (size_t)MTOT * 4 * 4);
constexpr size_t O_WN = al256(O_UT + (size_t)NITEM * 8192 * 4);
constexpr size_t O_QG = al256(O_WN + (size_t)NITEM * 8192 * 2);
constexpr size_t O_KDT = al256(O_QG + (size_t)NITEM * 8192 * 2);
constexpr size_t O_QKM = al256(O_KDT + (size_t)NITEM * 8192 * 2);
constexpr size_t O_GL = al256(O_QKM + (size_t)NITEM * 4096 * 2);
constexpr size_t O_OG = al256(O_GL + (size_t)NITEM * 4);
constexpr size_t O_MIX = al256(O_OG + (size_t)MTOT * 512 * 4);
constexpr size_t O_MIXS = al256(O_MIX + (size_t)MTOT * 1024 * 2);
constexpr size_t O_PO = al256(O_MIXS + (size_t)512 * 2560 * 2);
constexpr size_t O_PML = al256(O_PO + (size_t)32 * 8 * 128 * 256 * 4);
constexpr size_t O_OMIX = al256(O_PML + (size_t)32 * 8 * 128 * 2 * 4);
constexpr size_t O_ACT = al256(O_OMIX + (size_t)MTOT * 1024 * 4);
constexpr size_t O_X2 = al256(O_ACT + (size_t)MTOT * DFF * 2);
constexpr size_t O_AN = al256(O_X2 + (size_t)MTOT * 1024 * 4);
constexpr size_t O_BN = al256(O_AN + (size_t)NITEM * 16384 * 2);
constexpr size_t O_SPK = al256(O_BN + (size_t)NITEM * 16384 * 4);
constexpr size_t O_END = al256(O_SPK + (size_t)NITEM * 32768);

struct Params {
  const float *x_prompt, *x_sample, *cache_lat, *cache_pe, *state_gdn, *state_conv, *meta, *pre_mix, *w_in, *q_norm,
      *kv_norm, *w_uq, *w_uk, *w_uv, *conv_w, *a_log, *dt_bias, *gdn_norm, *w_o, *post_mix, *pre_ffn, *w_gate, *w_up,
      *w_down, *post_ffn;
  float* out;
  char* ws;
};

DI unsigned pk2(float a, float b) { f32x2v f = {a, b}; bf16x2v r = __builtin_convertvector(f, bf16x2v); return __builtin_bit_cast(unsigned, r); }
DI ushort_t f2bf(float x) { return (ushort_t)(pk2(x, 0.f) & 0xffffu); }
DI float bf2f(ushort_t u) { return __uint_as_float(((unsigned)u) << 16); }
DI int crow(int reg, int h) { return (reg & 3) + 8 * (reg >> 2) + 4 * h; }
DI f32x16 zero16() { f32x16 z;
#pragma unroll
  for (int i = 0; i < 16; ++i) z[i] = 0.f; return z; }
template <int S> DI bf16x8 pack8(const f32x16& x) {
  u32x4 p;
  p[0] = pk2(x[8 * S + 0], x[8 * S + 1]); p[1] = pk2(x[8 * S + 2], x[8 * S + 3]);
  p[2] = pk2(x[8 * S + 4], x[8 * S + 5]); p[3] = pk2(x[8 * S + 6], x[8 * S + 7]);
  return __builtin_bit_cast(bf16x8, p);
}
DI float wave_sum(float v) {
#pragma unroll
  for (int d = 32; d >= 1; d >>= 1) v += __shfl_xor(v, d, 64);
  return v;
}
DI float swap_max(float m) { auto rr = __builtin_amdgcn_permlane32_swap(__float_as_uint(m), __float_as_uint(m), false, false); return fmaxf(__uint_as_float(rr[0]), __uint_as_float(rr[1])); }
DI float swap_sum(float m) { auto rr = __builtin_amdgcn_permlane32_swap(__float_as_uint(m), __float_as_uint(m), false, false); return __uint_as_float(rr[0]) + __uint_as_float(rr[1]); }
typedef short v4i16_t __attribute__((ext_vector_type(4)));
DI s16x4 vtr(const ushort_t* p) { return __builtin_bit_cast(s16x4, __builtin_amdgcn_ds_read_tr16_b64_v4i16((__attribute__((address_space(3))) v4i16_t*)p)); }
DI bf16x8 cat8(s16x4 lo, s16x4 hi) { return __builtin_shufflevector(lo, hi, 0, 1, 2, 3, 4, 5, 6, 7); }
DI bf16x8 fragP(const ushort_t* base, int h) { s16x4 lo = *(const s16x4*)(base + 4 * h); s16x4 hi = *(const s16x4*)(base + 8 + 4 * h); return cat8(lo, hi); }
DI unsigned xcc_id_early() { return (unsigned)__builtin_amdgcn_s_getreg((3 << 11) | 20) & 0xFu; }
DI int get_tid() { int t = threadIdx.x; asm volatile("" : "+v"(t)); return t; }
DI float siluf(float x) { return x * __builtin_amdgcn_rcpf(1.f + __expf(-x)); }
DI float row_pos(int row) { return row < SOFF ? (float)(row - POFF) : (float)(16 + PAST + ((row - SOFF) & 15)); }
DI bool row_valid(int row) { return row >= SOFF || (row >= POFF && row < PEND); }
DI float rope_inv(int j) { return exp2f(-(float)j * (13.287712379549449f / 16.f)); }

constexpr int GP = 72;
template <class Epi>
DI void gemm_tile(const ushort_t* __restrict__ A, int lda, const ushort_t* __restrict__ Wt, int ldb, int K, int m0, int n0,
                  char* smem, Epi epi) {
  ushort_t* L0 = (ushort_t*)smem;
  ushort_t* L1 = L0 + 256 * GP;
  const int tid = get_tid(), lane = tid & 63, wave = tid >> 6, r = lane & 31, h = lane >> 5;
  const int wm = wave >> 1, wn = wave & 1;
  const int lrow = tid >> 3, lcol = (tid & 7) * 8;
  const ushort_t* Ag = A + (size_t)(m0 + lrow) * lda + lcol;
  const ushort_t* Bg = Wt + (size_t)(n0 + lrow) * ldb + lcol;
  const size_t a32 = (size_t)32 * lda, b32 = (size_t)32 * ldb;
  u32x4 pa0, pa1, pa2, pa3, pb0, pb1, pb2, pb3;
  u32x4 qa0, qa1, qa2, qa3, qb0, qb1, qb2, qb3;
#define G_LOAD0(kk) { pa0 = *(const u32x4*)(Ag + (kk)); pa1 = *(const u32x4*)(Ag + a32 + (kk)); pa2 = *(const u32x4*)(Ag + 2 * a32 + (kk)); pa3 = *(const u32x4*)(Ag + 3 * a32 + (kk)); \
                      pb0 = *(const u32x4*)(Bg + (kk)); pb1 = *(const u32x4*)(Bg + b32 + (kk)); pb2 = *(const u32x4*)(Bg + 2 * b32 + (kk)); pb3 = *(const u32x4*)(Bg + 3 * b32 + (kk)); }
#define G_LOAD1(kk) { qa0 = *(const u32x4*)(Ag + (kk)); qa1 = *(const u32x4*)(Ag + a32 + (kk)); qa2 = *(const u32x4*)(Ag + 2 * a32 + (kk)); qa3 = *(const u32x4*)(Ag + 3 * a32 + (kk)); \
                      qb0 = *(const u32x4*)(Bg + (kk)); qb1 = *(const u32x4*)(Bg + b32 + (kk)); qb2 = *(const u32x4*)(Bg + 2 * b32 + (kk)); qb3 = *(const u32x4*)(Bg + 3 * b32 + (kk)); }
#define L_STORE0(L) { ushort_t* la = (L) + lrow * GP + lcol; ushort_t* lb = la + 128 * GP; \
                      *(u32x4*)(la) = pa0; *(u32x4*)(la + 32 * GP) = pa1; *(u32x4*)(la + 64 * GP) = pa2; *(u32x4*)(la + 96 * GP) = pa3; \
                      *(u32x4*)(lb) = pb0; *(u32x4*)(lb + 32 * GP) = pb1; *(u32x4*)(lb + 64 * GP) = pb2; *(u32x4*)(lb + 96 * GP) = pb3; }
#define L_STORE1(L) { ushort_t* la = (L) + lrow * GP + lcol; ushort_t* lb = la + 128 * GP; \
                      *(u32x4*)(la) = qa0; *(u32x4*)(la + 32 * GP) = qa1; *(u32x4*)(la + 64 * GP) = qa2; *(u32x4*)(la + 96 * GP) = qa3; \
                      *(u32x4*)(lb) = qb0; *(u32x4*)(lb + 32 * GP) = qb1; *(u32x4*)(lb + 64 * GP) = qb2; *(u32x4*)(lb + 96 * GP) = qb3; }
#define G_COMPUTE(L) { const ushort_t* As = (L); const ushort_t* Bs = (L) + 128 * GP; \
    _Pragma("unroll") for (int ks = 0; ks < 4; ++ks) { \
      const bf16x8 af0 = *(const bf16x8*)(As + (64 * wm + r) * GP + ks * 16 + h * 8); \
      const bf16x8 af1 = *(const bf16x8*)(As + (64 * wm + 32 + r) * GP + ks * 16 + h * 8); \
      const bf16x8 bf0 = *(const bf16x8*)(Bs + (64 * wn + r) * GP + ks * 16 + h * 8); \
      const bf16x8 bf1 = *(const bf16x8*)(Bs + (64 * wn + 32 + r) * GP + ks * 16 + h * 8); \
      acc00 = MFMA(bf0, af0, acc00); acc01 = MFMA(bf1, af0, acc01); acc10 = MFMA(bf0, af1, acc10); acc11 = MFMA(bf1, af1, acc11); } }
  f32x16 acc00 = zero16(), acc01 = zero16(), acc10 = zero16(), acc11 = zero16();
  __syncthreads();
  if (K == 64) {
    G_LOAD0(0);
    L_STORE0(L0);
    __syncthreads();
    G_COMPUTE(L0);
    __syncthreads();
  } else {
    const int klast = K - 64;
    G_LOAD0(0);
    G_LOAD1(64);
    L_STORE0(L0);
    G_LOAD0(min(128, klast));
    __syncthreads();
    for (int k0 = 0; k0 < K; k0 += 128) {
      G_COMPUTE(L0);
      L_STORE1(L1);
      G_LOAD1(min(k0 + 192, klast));
      __syncthreads();
      G_COMPUTE(L1);
      L_STORE0(L0);
      G_LOAD0(min(k0 + 256, klast));
      __syncthreads();
    }
  }
#undef G_LOAD0
#undef G_LOAD1
#undef L_STORE0
#undef L_STORE1
#undef G_COMPUTE
  epi(m0 + 64 * wm + r, n0 + 64 * wn, acc00, acc01, h);
  epi(m0 + 64 * wm + 32 + r, n0 + 64 * wn, acc10, acc11, h);
}

template <class Epi>
DI void gemm_tile_w(const ushort_t* __restrict__ A, int lda, const ushort_t* __restrict__ Wt, int ldb, int K, int m0, int n0,
                    char* smem, Epi epi) {
  ushort_t* As = (ushort_t*)smem;
  ushort_t* Bs = As + 128 * GP;
  const int tid = get_tid(), lane = tid & 63, wave = tid >> 6, r = lane & 31, h = lane >> 5;
  const int wm = wave >> 1, wn = wave & 1;
  const int lrow = tid >> 3, lcol = (tid & 7) * 8;
  const ushort_t* Ag = A + (size_t)(m0 + lrow) * lda + lcol;
  const ushort_t* Bg = Wt + (size_t)(n0 + lrow) * ldb + lcol;
  const size_t a32 = (size_t)32 * lda, b32 = (size_t)32 * ldb;
  u32x4 ra[4], rb[8];
#pragma unroll
  for (int i = 0; i < 4; ++i) ra[i] = *(const u32x4*)(Ag + i * a32);
#pragma unroll
  for (int i = 0; i < 8; ++i) rb[i] = *(const u32x4*)(Bg + i * b32);
  f32x16 acc[2][4];
#pragma unroll
  for (int mi = 0; mi < 2; ++mi)
#pragma unroll
    for (int ni = 0; ni < 4; ++ni) acc[mi][ni] = zero16();
  for (int k0 = 0; k0 < K; k0 += 64) {
    __syncthreads();
#pragma unroll
    for (int i = 0; i < 4; ++i) *(u32x4*)(As + (lrow + 32 * i) * GP + lcol) = ra[i];
#pragma unroll
    for (int i = 0; i < 8; ++i) *(u32x4*)(Bs + (lrow + 32 * i) * GP + lcol) = rb[i];
    __syncthreads();
    if (k0 + 64 < K) {
#pragma unroll
      for (int i = 0; i < 4; ++i) ra[i] = *(const u32x4*)(Ag + i * a32 + k0 + 64);
#pragma unroll
      for (int i = 0; i < 8; ++i) rb[i] = *(const u32x4*)(Bg + i * b32 + k0 + 64);
    }
#pragma unroll
    for (int ks = 0; ks < 4; ++ks) {
      bf16x8 af[2], bfv[4];
#pragma unroll
      for (int mi = 0; mi < 2; ++mi) af[mi] = *(const bf16x8*)(As + (64 * wm + 32 * mi + r) * GP + ks * 16 + h * 8);
#pragma unroll
      for (int ni = 0; ni < 4; ++ni) bfv[ni] = *(const bf16x8*)(Bs + (128 * wn + 32 * ni + r) * GP + ks * 16 + h * 8);
#pragma unroll
      for (int mi = 0; mi < 2; ++mi)
#pragma unroll
        for (int ni = 0; ni < 4; ++ni) acc[mi][ni] = MFMA(bfv[ni], af[mi], acc[mi][ni]);
    }
  }
#pragma unroll
  for (int mi = 0; mi < 2; ++mi) {
    epi(m0 + 64 * wm + 32 * mi + r, n0 + 128 * wn, acc[mi][0], acc[mi][1], h);
    epi(m0 + 64 * wm + 32 * mi + r, n0 + 128 * wn + 64, acc[mi][2], acc[mi][3], h);
  }
}

struct EpiF32 {
  float* C; int ldc;
  DI void operator()(int m, int nb, const f32x16& a0, const f32x16& a1, int h) const {
#pragma unroll
    for (int g = 0; g < 4; ++g) {
      *(float4*)(C + (size_t)m * ldc + nb + 8 * g + 4 * h) = make_float4(a0[4 * g], a0[4 * g + 1], a0[4 * g + 2], a0[4 * g + 3]);
      *(float4*)(C + (size_t)m * ldc + nb + 32 + 8 * g + 4 * h) = make_float4(a1[4 * g], a1[4 * g + 1], a1[4 * g + 2], a1[4 * g + 3]);
    }
  }
};
struct EpiBF16 {
  ushort_t* C; int ldc; float scale;
  DI void operator()(int m, int nb, const f32x16& a0, const f32x16& a1, int h) const {
#pragma unroll
    for (int g = 0; g < 4; ++g) {
      *(uint2*)(C + (size_t)m * ldc + nb + 8 * g + 4 * h) = make_uint2(pk2(a0[4 * g] * scale, a0[4 * g + 1] * scale), pk2(a0[4 * g + 2] * scale, a0[4 * g + 3] * scale));
      *(uint2*)(C + (size_t)m * ldc + nb + 32 + 8 * g + 4 * h) = make_uint2(pk2(a1[4 * g] * scale, a1[4 * g + 1] * scale), pk2(a1[4 * g + 2] * scale, a1[4 * g + 3] * scale));
    }
  }
};
struct EpiQ {
  ushort_t* QF;
  DI void one(int m, int nb, f32x16 a, int h) const {
    if ((nb % 96) == 64) {
      const float pos = row_pos(m);
#pragma unroll
      for (int i = 0; i < 8; ++i) {
        const int j = crow(i, h);
        float sn, cs; sincosf(pos * rope_inv(j), &sn, &cs);
        const float x1 = a[i], x2 = a[i + 8];
        a[i] = x1 * cs - x2 * sn; a[i + 8] = x1 * sn + x2 * cs;
      }
    }
#pragma unroll
    for (int g = 0; g < 4; ++g)
      *(uint2*)(QF + (size_t)m * 768 + nb + 8 * g + 4 * h) = make_uint2(pk2(a[4 * g] * QSCALE, a[4 * g + 1] * QSCALE), pk2(a[4 * g + 2] * QSCALE, a[4 * g + 3] * QSCALE));
  }
  DI void operator()(int m, int nb, const f32x16& a0, const f32x16& a1, int h) const { one(m, nb, a0, h); one(m, nb + 32, a1, h); }
};
struct EpiKV {
  ushort_t* KF; ushort_t* VV;
  DI void one(int m, int nb, const f32x16& a, int h) const {
#pragma unroll
    for (int g = 0; g < 4; ++g) {
      const int n = nb + 8 * g + 4 * h;
      uint2 v = make_uint2(pk2(a[4 * g], a[4 * g + 1]), pk2(a[4 * g + 2], a[4 * g + 3]));
      if (n < 512) *(uint2*)(KF + (size_t)m * 768 + (n >> 6) * 96 + (n & 63)) = v;
      else *(uint2*)(VV + (size_t)m * 512 + (n - 512)) = v;
    }
  }
  DI void operator()(int m, int nb, const f32x16& a0, const f32x16& a1, int h) const { one(m, nb, a0, h); one(m, nb + 32, a1, h); }
};
struct EpiSwiGLU {
  ushort_t* ACT;
  DI void operator()(int m, int nb, const f32x16& a0, const f32x16& a1, int h) const {
    const int cb = nb >> 1;
#pragma unroll
    for (int g = 0; g < 4; ++g) {
      float v0 = siluf(a0[4 * g]) * a1[4 * g], v1 = siluf(a0[4 * g + 1]) * a1[4 * g + 1];
      float v2 = siluf(a0[4 * g + 2]) * a1[4 * g + 2], v3 = siluf(a0[4 * g + 3]) * a1[4 * g + 3];
      *(uint2*)(ACT + (size_t)m * DFF + cb + 8 * g + 4 * h) = make_uint2(pk2(v0, v1), pk2(v2, v3));
    }
  }
};

DI void tconv_tile(const float* __restrict__ src, int K, int N, ushort_t* dst, int ldd, int mode, ushort_t* dst2, int kt, int nt, char* smem) {
  float* tile = (float*)smem;
  const int tid = get_tid();
  const int k0 = kt * 64, n0 = nt * 64;
  __syncthreads();
#pragma unroll
  for (int it = 0; it < 16; ++it) {
    int k = it * 4 + (tid >> 6), n = tid & 63;
    float v = (n0 + n < N) ? src[(size_t)(k0 + k) * N + n0 + n] : 0.f;
    tile[k * 65 + n] = v;
  }
  __syncthreads();
#pragma unroll
  for (int it = 0; it < 16; ++it) {
    int n = it * 4 + (tid >> 6), k = tid & 63;
    int gn = n0 + n;
    int row = gn;
    if (mode == 1) row = (gn >> 5) * 64 + (gn & 31);
    else if (mode == 2) row = (gn >> 5) * 64 + 32 + (gn & 31);
    ushort_t v = f2bf(tile[k * 65 + n]);
    dst[(size_t)row * ldd + k0 + k] = v;
    if (mode == 3 && k0 >= 512) dst2[(size_t)gn * 2560 + 2048 + (k0 - 512) + k] = v;
  }
}

DI void norm_store_row(const float (&v)[16], float* Xrow, ushort_t* XNrow, const float* w, int lane, bool valid) {
  float ss = 0.f;
#pragma unroll
  for (int i = 0; i < 16; ++i) ss += v[i] * v[i];
  ss = wave_sum(ss);
  const float rstd = rsqrtf(ss * (1.f / 1024.f) + EPS);
#pragma unroll
  for (int j = 0; j < 4; ++j) {
    const int c = 4 * lane + 256 * j;
    float4 wv = *(const float4*)(w + c);
    float o0 = valid ? v[4 * j] : 0.f, o1 = valid ? v[4 * j + 1] : 0.f, o2 = valid ? v[4 * j + 2] : 0.f, o3 = valid ? v[4 * j + 3] : 0.f;
    if (Xrow) *(float4*)(Xrow + c) = make_float4(o0, o1, o2, o3);
    *(uint2*)(XNrow + c) = make_uint2(pk2(o0 * rstd * wv.x, o1 * rstd * wv.y), pk2(o2 * rstd * wv.z, o3 * rstd * wv.w));
  }
}

DI void phase_prep0(const Params& P, char* smem) {
  ushort_t* W = (ushort_t*)(P.ws + O_W);
  const int tid = get_tid();
  if (blockIdx.x == 0 && tid < 64) ((int*)(P.ws + O_CTR))[tid] = 0;
  constexpr int T_IN = 704, T_UQ = 72, T_UK = 32, T_UV = 32, T_O = 256, T_G = 704, T_U = 704, T_D = 704;
  constexpr int TL = T_IN + T_UQ + T_UK + T_UV + T_O + T_G + T_U + T_D;
  for (int t = blockIdx.x; t < TL * 4; t += gridDim.x) {
    const int l = t / TL; int rm = t % TL;
    ushort_t* Wl = W + (size_t)l * E_WL;
    if (rm < T_IN) { tconv_tile(P.w_in + (size_t)l * 1024 * INW, 1024, INW, Wl + E_WT_IN, 1024, 0, nullptr, rm / 44, rm % 44, smem); continue; }
    rm -= T_IN;
    if (rm < T_UQ) { tconv_tile(P.w_uq + (size_t)l * 384 * 768, 384, 768, Wl + E_WT_UQ, 384, 0, nullptr, rm / 12, rm % 12, smem); continue; }
    rm -= T_UQ;
    if (rm < T_UK) { tconv_tile(P.w_uk + (size_t)l * 256 * 512, 256, 512, Wl + E_WT_UKV, 256, 0, nullptr, rm / 8, rm % 8, smem); continue; }
    rm -= T_UK;
    if (rm < T_UV) { tconv_tile(P.w_uv + (size_t)l * 256 * 512, 256, 512, Wl + E_WT_UKV + (size_t)512 * 256, 256, 0, nullptr, rm / 8, rm % 8, smem); continue; }
    rm -= T_UV;
    if (rm < T_O) { tconv_tile(P.w_o + (size_t)l * 1024 * 1024, 1024, 1024, Wl + E_WT_O, 1024, 3, Wl + E_WT_OS, rm / 16, rm % 16, smem); continue; }
    rm -= T_O;
    if (rm < T_G) { tconv_tile(P.w_gate + (size_t)l * 1024 * DFF, 1024, DFF, Wl + E_WT_GU, 1024, 1, nullptr, rm / 44, rm % 44, smem); continue; }
    rm -= T_G;
    if (rm < T_U) { tconv_tile(P.w_up + (size_t)l * 1024 * DFF, 1024, DFF, Wl + E_WT_GU, 1024, 2, nullptr, rm / 44, rm % 44, smem); continue; }
    rm -= T_U;
    tconv_tile(P.w_down + (size_t)l * DFF * 1024, DFF, 1024, Wl + E_WT_DOWN, DFF, 0, nullptr, rm / 16, rm % 16, smem);
  }
  const int gt = blockIdx.x * 256 + tid, gs = gridDim.x * 256;
  for (int l = 0; l < 4; ++l) {
    ushort_t* Wl = W + (size_t)l * E_WL;
    for (int i = gt; i < 384 * 768; i += gs) Wl[E_WUQ_BF + i] = f2bf(P.w_uq[(size_t)l * 384 * 768 + i]);
    for (int i = gt; i < 256 * 512; i += gs) { Wl[E_WUK_BF + i] = f2bf(P.w_uk[(size_t)l * 256 * 512 + i]); Wl[E_WUV_BF + i] = f2bf(P.w_uv[(size_t)l * 256 * 512 + i]); }
  }
  float* X = (float*)(P.ws + O_X);
  ushort_t* XN = (ushort_t*)(P.ws + O_XN);
  const int lane = tid & 63, gw = blockIdx.x * 4 + (tid >> 6), nw = gridDim.x * 4;
  for (int row = gw; row < MTOT; row += nw) {
    const bool valid = row_valid(row);
    const float* src = nullptr;
    if (valid) {
      if (row >= SOFF) src = P.x_sample + (size_t)(row - SOFF) * 1024;
      else if (row < POFF + 16) src = P.meta + (size_t)(row - POFF) * 1024;
      else src = P.x_prompt + (size_t)(row - POFF - 16) * 1024;
    }
    float v[16];
#pragma unroll
    for (int j = 0; j < 4; ++j) {
      float4 t = valid ? *(const float4*)(src + 4 * lane + 256 * j) : make_float4(0.f, 0.f, 0.f, 0.f);
      v[4 * j] = t.x; v[4 * j + 1] = t.y; v[4 * j + 2] = t.z; v[4 * j + 3] = t.w;
    }
    norm_store_row(v, X + (size_t)row * 1024, XN + (size_t)row * 1024, P.pre_mix, lane, valid);
  }
}

DI void phase_prep1(const Params& P, char* smem) {
  ushort_t* W = (ushort_t*)(P.ws + O_W);
  for (int t = blockIdx.x; t < 4 * 176; t += gridDim.x) {
    const int l = t / 176; int rm = t % 176;
    ushort_t* Wl = W + (size_t)l * E_WL;
    if (rm < 48) {
      const int hd = rm / 6, mt = (rm % 6) / 3, nt = rm % 3;
      gemm_tile(Wl + E_WUK_BF + hd * 64, 512, Wl + E_WUQ_BF + hd * 96, 768, 64, mt * 128, nt * 128, smem,
                EpiBF16{Wl + E_WABS + (size_t)hd * 256 * 384, 384, 1.f});
    } else {
      rm -= 48;
      const int hd = rm / 16, mt = (rm % 16) / 2, nt = rm % 2;
      gemm_tile(Wl + E_WT_O + hd * 64, 1024, Wl + E_WUV_BF + hd * 64, 512, 64, mt * 128, nt * 128, smem,
                EpiBF16{Wl + E_WT_OS + hd * 256, 2560, 1.f});
    }
  }
}

DI float bflo(unsigned u) { return __uint_as_float(u << 16); }
DI float bfhi(unsigned u) { return __uint_as_float(u & 0xffff0000u); }
DI unsigned ld32(const ushort_t* p) { return *(const unsigned*)p; }
DI void phase_rowpass(const Params& P, int l) {
  const ushort_t* __restrict__ PROJ = (const ushort_t*)(P.ws + O_PROJ);
  ushort_t* CQN = (ushort_t*)(P.ws + O_CQN); ushort_t* CKV = (ushort_t*)(P.ws + O_CKV); ushort_t* KPE = (ushort_t*)(P.ws + O_KPE);
  ushort_t* KF = (ushort_t*)(P.ws + O_KF);
  float* GQ = (float*)(P.ws + O_GQ); float* GK = (float*)(P.ws + O_GK); float* GV = (float*)(P.ws + O_GV);
  float* GB = (float*)(P.ws + O_GB); float* GG = (float*)(P.ws + O_GG);
  const int tid = get_tid(), lane = tid & 63, gw = blockIdx.x * 4 + (tid >> 6), nw = gridDim.x * 4;
  const float* cw = P.conv_w + (size_t)l * 4 * 1536;
  float2 w[12][4];
#pragma unroll
  for (int s = 0; s < 12; ++s)
#pragma unroll
    for (int k = 0; k < 4; ++k) w[s][k] = *(const float2*)(cw + k * 1536 + 128 * s + 2 * lane);
  float2 qn[3], kn[2];
#pragma unroll
  for (int j = 0; j < 3; ++j) qn[j] = *(const float2*)(P.q_norm + l * 384 + 2 * lane + 128 * j);
#pragma unroll
  for (int j = 0; j < 2; ++j) kn[j] = *(const float2*)(P.kv_norm + l * 256 + 2 * lane + 128 * j);
  for (int row = gw; row < MTOT; row += nw) {
    const ushort_t* pr = PROJ + (size_t)row * INP;
    const bool isP = row < SOFF, valid = row_valid(row);
    const int tok = row - POFF, sb = (row - SOFF) >> 4, st = (row - SOFF) & 15;
    const float pos = row_pos(row);
    unsigned t0[12], t1[12], t2[12], t3[12];
    if (valid) {
      const ushort_t* px = pr + OFF_QKV + 2 * lane;
#pragma unroll
      for (int s = 0; s < 12; ++s) t0[s] = ld32(px + 128 * s);
      if (isP) {
#pragma unroll
        for (int s = 0; s < 12; ++s) { t1[s] = ld32(px - INP + 128 * s); t2[s] = ld32(px - 2 * INP + 128 * s); t3[s] = ld32(px - 3 * INP + 128 * s); }
      } else {
        const float* cs = P.state_conv + ((size_t)l * 32 + sb) * 3 * 1536 + 2 * lane;
#pragma unroll
        for (int s = 0; s < 12; ++s) {
          if (st >= 1) t1[s] = ld32(px - INP + 128 * s); else { const float2 f = *(const float2*)(cs + (size_t)(2 + st) * 1536 + 128 * s); t1[s] = pk2(f.x, f.y); }
          if (st >= 2) t2[s] = ld32(px - 2 * INP + 128 * s); else { const float2 f = *(const float2*)(cs + (size_t)(1 + st) * 1536 + 128 * s); t2[s] = pk2(f.x, f.y); }
          if (st >= 3) t3[s] = ld32(px - 3 * INP + 128 * s); else { const float2 f = *(const float2*)(cs + (size_t)(st) * 1536 + 128 * s); t3[s] = pk2(f.x, f.y); }
        }
      }
    } else {
#pragma unroll
      for (int s = 0; s < 12; ++s) { t0[s] = 0u; t1[s] = 0u; t2[s] = 0u; t3[s] = 0u; }
    }
    unsigned cq[3], ck[2];
#pragma unroll
    for (int j = 0; j < 3; ++j) cq[j] = ld32(pr + 2 * lane + 128 * j);
#pragma unroll
    for (int j = 0; j < 2; ++j) ck[j] = ld32(pr + OFF_KV + 2 * lane + 128 * j);
    const float xr = bf2f(pr[OFF_PE + (lane & 31)]);
    const float bbv = bf2f(pr[OFF_B + (lane & 3)]), aav = bf2f(pr[OFF_A + (lane & 3)]);
    {
      float ss = 0.f;
#pragma unroll
      for (int j = 0; j < 3; ++j) { const float a = bflo(cq[j]), b = bfhi(cq[j]); ss += a * a + b * b; }
      ss = wave_sum(ss);
      const float rstd = rsqrtf(ss * (1.f / 384.f) + EPS);
#pragma unroll
      for (int j = 0; j < 3; ++j)
        *(unsigned*)(CQN + (size_t)row * 384 + 2 * lane + 128 * j) = pk2(bflo(cq[j]) * rstd * qn[j].x, bfhi(cq[j]) * rstd * qn[j].y);
    }
    {
      float ss = 0.f;
#pragma unroll
      for (int j = 0; j < 2; ++j) { const float a = bflo(ck[j]), b = bfhi(ck[j]); ss += a * a + b * b; }
      ss = wave_sum(ss);
      const float rstd = rsqrtf(ss * (1.f / 256.f) + EPS);
      float* olat = nullptr;
      if (valid) olat = isP ? P.out + OUT_PLAT + ((size_t)l * LTOK + tok) * 256 : P.out + OUT_SLAT + (((size_t)l * 32 + sb) * 16 + st) * 256;
#pragma unroll
      for (int j = 0; j < 2; ++j) {
        const float o0 = bflo(ck[j]) * rstd * kn[j].x, o1 = bfhi(ck[j]) * rstd * kn[j].y;
        *(unsigned*)(CKV + (size_t)row * 256 + 2 * lane + 128 * j) = pk2(o0, o1);
        if (valid) *(float2*)(olat + 2 * lane + 128 * j) = make_float2(o0, o1);
      }
    }
    {
      const float pt = __shfl_xor(xr, 16, 64);
      float sn, cs; sincosf(pos * rope_inv(lane & 15), &sn, &cs);
      const float o = ((lane & 31) < 16) ? (xr * cs - pt * sn) : (pt * sn + xr * cs);
      if (lane < 32) {
        const ushort_t ob = f2bf(o);
        KPE[(size_t)row * 32 + lane] = ob;
        if (valid) {
          if (isP) P.out[OUT_PPE + ((size_t)l * LTOK + tok) * 32 + lane] = o;
          else P.out[OUT_SPE + (((size_t)l * 32 + sb) * 16 + st) * 32 + lane] = o;
        }
        if (isP) {
#pragma unroll
          for (int hh = 0; hh < 8; ++hh) KF[(size_t)row * 768 + hh * 96 + 64 + lane] = ob;
        }
      }
    }
    {
      float* cso = nullptr;
      if (valid) {
        if (isP) { if (row >= PEND - 3) cso = P.out + OUT_PCONV + ((size_t)l * 3 + (row - (PEND - 3))) * 1536; }
        else if (st >= 13) cso = P.out + OUT_SCONV + (((size_t)l * 32 + sb) * 3 + (st - 13)) * 1536;
      }
#pragma unroll
      for (int s = 0; s < 12; ++s) {
        const float x0a = bflo(t0[s]), x0b = bfhi(t0[s]);
        if (cso) *(float2*)(cso + 128 * s + 2 * lane) = make_float2(x0a, x0b);
        const float ya = w[s][3].x * x0a + w[s][2].x * bflo(t1[s]) + w[s][1].x * bflo(t2[s]) + w[s][0].x * bflo(t3[s]);
        const float yb = w[s][3].y * x0b + w[s][2].y * bfhi(t1[s]) + w[s][1].y * bfhi(t2[s]) + w[s][0].y * bfhi(t3[s]);
        const float a = siluf(ya), b = siluf(yb);
        if (s < 8) {
          const float ss = wave_sum(a * a + b * b);
          float sc = rsqrtf(ss + EPS);
          if (s < 4) sc *= 0.08838834764831845f;
          float* dst = (s < 4 ? GQ : GK) + (size_t)row * 512 + (s & 3) * 128 + 2 * lane;
          *(float2*)dst = make_float2(a * sc, b * sc);
        } else {
          *(float2*)(GV + (size_t)row * 512 + (s - 8) * 128 + 2 * lane) = make_float2(a, b);
        }
      }
    }
    if (lane < 4) {
      float beta = 0.f, g = 0.f;
      if (valid) {
        const float aa = aav + P.dt_bias[l * 4 + lane];
        beta = 1.f / (1.f + expf(-bbv));
        const float sp = aa > 20.f ? aa : log1pf(expf(aa));
        g = -expf(P.a_log[l * 4 + lane]) * sp;
      }
      GB[(size_t)row * 4 + lane] = beta; GG[(size_t)row * 4 + lane] = g;
    }
  }
}

DI void gdn_prep(const Params& P, int item, char* smem) {
  const float* GQ = (const float*)(P.ws + O_GQ); const float* GK = (const float*)(P.ws + O_GK); const float* GV = (const float*)(P.ws + O_GV);
  const float* GB = (const float*)(P.ws + O_GB); const float* GG = (const float*)(P.ws + O_GG);
  float* UT = (float*)(P.ws + O_UT) + (size_t)item * 8192;
  ushort_t* WN = (ushort_t*)(P.ws + O_WN) + (size_t)item * 8192;
  ushort_t* QG = (ushort_t*)(P.ws + O_QG) + (size_t)item * 8192;
  ushort_t* AN = (ushort_t*)(P.ws + O_AN) + (size_t)item * 16384;
  float* BN = (float*)(P.ws + O_BN) + (size_t)item * 16384;
  ushort_t* WTs = (ushort_t*)smem;
  ushort_t* UTs = WTs + 128 * 72;
  ushort_t* KDTs = (ushort_t*)(smem + 53248);
  ushort_t* QKM = (ushort_t*)(P.ws + O_QKM) + (size_t)item * 4096;
  float* GL = (float*)(P.ws + O_GL);
  ushort_t* Ks = (ushort_t*)smem;
  ushort_t* Qs = Ks + 64 * 136;
  float* Ms = (float*)(smem + 34816);
  float* gcs = (float*)(smem + 52224);
  float* bts = gcs + 64;
  float* egs = bts + 64;
  const int tid = get_tid(), lane = tid & 63, wave = tid >> 6, r = lane & 31, h = lane >> 5;
  const int n = item >> 2, hd = item & 3, row0 = 64 * n;
  __syncthreads();
  if (wave == 0) {
    float x = GG[(size_t)(row0 + lane) * 4 + hd];
    const float bt = GB[(size_t)(row0 + lane) * 4 + hd];
#pragma unroll
    for (int d = 1; d < 64; d <<= 1) { float y = __shfl_up(x, d, 64); if (lane >= d) x += y; }
    gcs[lane] = x; bts[lane] = bt; egs[lane] = __expf(x);
    if (lane == 63) GL[item] = __expf(x);
  }
#pragma unroll
  for (int i = 0; i < 8; ++i) {
    const int idx = tid + 256 * i, row = idx >> 5, c4 = (idx & 31) * 4;
    const float4 kv = *(const float4*)(GK + (size_t)(row0 + row) * 512 + hd * 128 + c4);
    const float4 qv = *(const float4*)(GQ + (size_t)(row0 + row) * 512 + hd * 128 + c4);
    *(uint2*)(Ks + row * 136 + c4) = make_uint2(pk2(kv.x, kv.y), pk2(kv.z, kv.w));
    *(uint2*)(Qs + row * 136 + c4) = make_uint2(pk2(qv.x, qv.y), pk2(qv.z, qv.w));
  }
  __syncthreads();
  {
    const int bi = wave >> 1, bj = wave & 1;
    f32x16 kk = zero16(), qk = zero16();
#pragma unroll
    for (int s = 0; s < 8; ++s) {
      const bf16x8 bfr = *(const bf16x8*)(Ks + (32 * bj + r) * 136 + 16 * s + 8 * h);
      const bf16x8 ak = *(const bf16x8*)(Ks + (32 * bi + r) * 136 + 16 * s + 8 * h);
      const bf16x8 aq = *(const bf16x8*)(Qs + (32 * bi + r) * 136 + 16 * s + 8 * h);
      kk = MFMA(ak, bfr, kk); qk = MFMA(aq, bfr, qk);
    }
    const int j = 32 * bj + r;
    const float gcj = gcs[j];
#pragma unroll
    for (int rg = 0; rg < 16; ++rg) {
      const int i = 32 * bi + crow(rg, h);
      const float dec = (j <= i) ? __expf(gcs[i] - gcj) : 0.f;
      Ms[j * 68 + i] = (j < i) ? bts[i] * kk[rg] * dec : 0.f;
      QKM[i * 64 + j] = f2bf(qk[rg] * dec);
    }
  }
#pragma unroll
  for (int i = 0; i < 8; ++i) {
    const int idx = tid + 256 * i, row = idx >> 5, c4 = (idx & 31) * 4;
    const float4 qv = *(const float4*)(GQ + (size_t)(row0 + row) * 512 + hd * 128 + c4);
    const float e = egs[row];
    *(uint2*)(QG + row * 128 + c4) = make_uint2(pk2(qv.x * e, qv.y * e), pk2(qv.z * e, qv.w * e));
  }
  {
    const int dk = tid & 127, ch = tid >> 7;
    const float gl = gcs[63];
    unsigned pkd[16];
#pragma unroll
    for (int cc = 0; cc < 16; ++cc) {
      const int c0 = 32 * ch + 2 * cc;
      const float a = GK[(size_t)(row0 + c0) * 512 + hd * 128 + dk] * __expf(gl - gcs[c0]);
      const float b = GK[(size_t)(row0 + c0 + 1) * 512 + hd * 128 + dk] * __expf(gl - gcs[c0 + 1]);
      pkd[cc] = pk2(a, b);
    }
#pragma unroll
    for (int q4 = 0; q4 < 4; ++q4)
      *(uint4*)(KDTs + dk * 72 + 32 * ch + 8 * q4) = make_uint4(pkd[4 * q4], pkd[4 * q4 + 1], pkd[4 * q4 + 2], pkd[4 * q4 + 3]);
  }
  __syncthreads();
  {
    const int col = tid & 127;
    const bool isW = tid >= 128;
    float x[64];
    const float* rsrc = (isW ? GK : GV) + (size_t)row0 * 512 + hd * 128 + col;
#pragma unroll
    for (int c = 0; c < 64; ++c) x[c] = rsrc[(size_t)c * 512];
#pragma unroll
    for (int c = 0; c < 64; ++c) x[c] *= bts[c] * (isW ? egs[c] : 1.f);
#pragma unroll
    for (int j = 0; j < 63; ++j) {
      float4 mc[16];
#pragma unroll
      for (int q4 = ((j + 1) >> 2); q4 < 16; ++q4) mc[q4] = *(const float4*)(Ms + j * 68 + 4 * q4);
      __builtin_amdgcn_sched_barrier(0);
      const float xj = x[j];
#pragma unroll
      for (int q4 = ((j + 1) >> 2); q4 < 16; ++q4) {
        const int i4 = 4 * q4;
        if (i4 + 0 > j) x[i4 + 0] -= mc[q4].x * xj;
        if (i4 + 1 > j) x[i4 + 1] -= mc[q4].y * xj;
        if (i4 + 2 > j) x[i4 + 2] -= mc[q4].z * xj;
        if (i4 + 3 > j) x[i4 + 3] -= mc[q4].w * xj;
      }
      __builtin_amdgcn_sched_barrier(0);
    }
    __syncthreads();
    if (!isW) {
#pragma unroll
      for (int c = 0; c < 64; c += 4) *(float4*)(UT + col * 64 + c) = make_float4(x[c], x[c + 1], x[c + 2], x[c + 3]);
#pragma unroll
      for (int c = 0; c < 64; c += 8)
        *(uint4*)(UTs + col * 72 + c) = make_uint4(pk2(x[c], x[c + 1]), pk2(x[c + 2], x[c + 3]), pk2(x[c + 4], x[c + 5]), pk2(x[c + 6], x[c + 7]));
    } else {
#pragma unroll
      for (int c = 0; c < 64; ++c) WN[c * 128 + col] = f2bf(-x[c]);
#pragma unroll
      for (int c = 0; c < 64; c += 8)
        *(uint4*)(WTs + col * 72 + c) = make_uint4(pk2(-x[c], -x[c + 1]), pk2(-x[c + 2], -x[c + 3]), pk2(-x[c + 4], -x[c + 5]), pk2(-x[c + 6], -x[c + 7]));
    }
  }
  __syncthreads();
  {
    const int bi = wave;
    const float gl = __expf(gcs[63]);
    bf16x8 kf[4];
#pragma unroll
    for (int sx = 0; sx < 4; ++sx) kf[sx] = *(const bf16x8*)(KDTs + (32 * bi + r) * 72 + 16 * sx + 8 * h);
#pragma unroll
    for (int bj = 0; bj < 4; ++bj) {
      f32x16 ab = zero16(), aa = zero16();
#pragma unroll
      for (int sx = 0; sx < 4; ++sx) {
        ab = MFMA(kf[sx], *(const bf16x8*)(UTs + (32 * bj + r) * 72 + 16 * sx + 8 * h), ab);
        aa = MFMA(*(const bf16x8*)(WTs + (32 * bj + r) * 72 + 16 * sx + 8 * h), kf[sx], aa);
      }
#pragma unroll
      for (int g = 0; g < 4; ++g) {
        *(float4*)(BN + (((bi * 4 + bj) * 4 + g) * 64 + lane) * 4) = make_float4(ab[4 * g], ab[4 * g + 1], ab[4 * g + 2], ab[4 * g + 3]);
        float a0 = aa[4 * g], a1 = aa[4 * g + 1], a2 = aa[4 * g + 2], a3 = aa[4 * g + 3];
        if (bi == bj) {
          const int jb = 8 * g + 4 * h;
          if (jb == r) a0 += gl;
          if (jb + 1 == r) a1 += gl;
          if (jb + 2 == r) a2 += gl;
          if (jb + 3 == r) a3 += gl;
        }
        *(uint2*)(AN + (32 * bi + r) * 128 + 32 * bj + 8 * g + 4 * h) = make_uint2(pk2(a0, a1), pk2(a2, a3));
      }
    }
  }
}

DI void gdn_sample(const Params& P, int l, int item, char* smem) {
  const float* GQ = (const float*)(P.ws + O_GQ); const float* GK = (const float*)(P.ws + O_GK); const float* GV = (const float*)(P.ws + O_GV);
  const float* GB = (const float*)(P.ws + O_GB); const float* GG = (const float*)(P.ws + O_GG);
  float* OG = (float*)(P.ws + O_OG);
  float* ks = (float*)smem;
  float* qs = ks + 2048;
  float* vs = qs + 2048;
  float* egb = vs + 2048;
  float* red = egb + 32;
  float* red2 = red + 256;
  const int tid = get_tid(), dv = tid & 127, half = tid >> 7;
  const int b = item >> 2, hd = item & 3, row0 = SOFF + 16 * b;
  __syncthreads();
#pragma unroll
  for (int i = 0; i < 8; ++i) {
    const int idx = tid + 256 * i, t = idx >> 7, c = idx & 127;
    ks[idx] = GK[(size_t)(row0 + t) * 512 + hd * 128 + c];
    qs[idx] = GQ[(size_t)(row0 + t) * 512 + hd * 128 + c];
    vs[idx] = GV[(size_t)(row0 + t) * 512 + hd * 128 + c];
  }
  if (tid < 16) { egb[2 * tid] = expf(GG[(size_t)(row0 + tid) * 4 + hd]); egb[2 * tid + 1] = GB[(size_t)(row0 + tid) * 4 + hd]; }
  const size_t sbase = ((((size_t)l * 32 + b) * 4 + hd) * 128 + 64 * half) * 128 + dv;
  float S[64];
#pragma unroll
  for (int i = 0; i < 64; ++i) S[i] = P.state_gdn[sbase + (size_t)i * 128];
  __syncthreads();
  for (int t = 0; t < 16; ++t) {
    const float eg = egb[2 * t], bt = egb[2 * t + 1];
    const float* kt = ks + t * 128 + 64 * half;
    const float* qt = qs + t * 128 + 64 * half;
    float acc = 0.f;
#pragma unroll
    for (int i = 0; i < 64; ++i) { S[i] *= eg; acc += kt[i] * S[i]; }
    red[half * 128 + dv] = acc;
    __syncthreads();
    const float kS = red[dv] + red[128 + dv];
    const float d = bt * (vs[t * 128 + dv] - kS);
    float acc2 = 0.f;
#pragma unroll
    for (int i = 0; i < 64; ++i) { S[i] += kt[i] * d; acc2 += qt[i] * S[i]; }
    red2[half * 128 + dv] = acc2;
    __syncthreads();
    if (half == 0) OG[(size_t)(row0 + t) * 512 + hd * 128 + dv] = red2[dv] + red2[128 + dv];
  }
#pragma unroll
  for (int i = 0; i < 64; ++i) P.out[OUT_SGDN + sbase + (size_t)i * 128] = S[i];
}

DI void gdn_scan(const Params& P, int l, int item, char* smem) {
  const ushort_t* ANg = (const ushort_t*)(P.ws + O_AN);
  const float* BNg = (const float*)(P.ws + O_BN);
  u32x4* SPK = (u32x4*)(P.ws + O_SPK);
  ushort_t* ST = (ushort_t*)smem;
  const int tid = get_tid(), lane = tid & 63, b = tid >> 6, r = lane & 31, h = lane >> 5;
  const int hd = item >> 2, dvs = item & 3;
  __syncthreads();
  for (int i = tid; i < 32 * 136 / 2; i += 256) ((unsigned*)ST)[i] = 0u;
  {
    const u32x4 z = {0u, 0u, 0u, 0u};
    SPK[((((size_t)(0 * 4 + hd) * 4 + dvs) * 4 + b) * 2 + 0) * 64 + lane] = z;
    SPK[((((size_t)(0 * 4 + hd) * 4 + dvs) * 4 + b) * 2 + 1) * 64 + lane] = z;
  }
  bf16x8 Ac[8]; f32x16 Bc;
  {
    const int it = hd;
#pragma unroll
    for (int sx = 0; sx < 8; ++sx) Ac[sx] = *(const bf16x8*)(ANg + (size_t)it * 16384 + (32 * b + r) * 128 + 16 * sx + 8 * h);
#pragma unroll
    for (int g = 0; g < 4; ++g) {
      const float4 t = *(const float4*)(BNg + (size_t)it * 16384 + (((b * 4 + dvs) * 4 + g) * 64 + lane) * 4);
      Bc[4 * g] = t.x; Bc[4 * g + 1] = t.y; Bc[4 * g + 2] = t.z; Bc[4 * g + 3] = t.w;
    }
  }
  f32x16 acc = zero16();
  for (int n = 0; n < NCH; ++n) {
    const int cur = n & 1;
    bf16x8 An[8]; f32x16 Bn;
    {
      const int it = (n + 1 < NCH ? n + 1 : n) * 4 + hd;
#pragma unroll
      for (int sx = 0; sx < 8; ++sx) An[sx] = *(const bf16x8*)(ANg + (size_t)it * 16384 + (32 * b + r) * 128 + 16 * sx + 8 * h);
#pragma unroll
      for (int g = 0; g < 4; ++g) {
        const float4 t = *(const float4*)(BNg + (size_t)it * 16384 + (((b * 4 + dvs) * 4 + g) * 64 + lane) * 4);
        Bn[4 * g] = t.x; Bn[4 * g + 1] = t.y; Bn[4 * g + 2] = t.z; Bn[4 * g + 3] = t.w;
      }
    }
    __syncthreads();
    const ushort_t* Sc = ST + cur * (32 * 136);
    f32x16 a0 = Bc, a1 = zero16();
#pragma unroll
    for (int sx = 0; sx < 8; sx += 2) {
      a0 = MFMA(Ac[sx], *(const bf16x8*)(Sc + r * 136 + 16 * sx + 8 * h), a0);
      a1 = MFMA(Ac[sx + 1], *(const bf16x8*)(Sc + r * 136 + 16 * (sx + 1) + 8 * h), a1);
    }
#pragma unroll
    for (int i = 0; i < 16; ++i) acc[i] = a0[i] + a1[i];
    const u32x4 p0 = __builtin_bit_cast(u32x4, pack8<0>(acc));
    const u32x4 p1 = __builtin_bit_cast(u32x4, pack8<1>(acc));
    ushort_t* Sn = ST + (cur ^ 1) * (32 * 136) + r * 136 + 32 * b + 4 * h;
    *(uint2*)(Sn) = make_uint2(p0[0], p0[1]);
    *(uint2*)(Sn + 8) = make_uint2(p0[2], p0[3]);
    *(uint2*)(Sn + 16) = make_uint2(p1[0], p1[1]);
    *(uint2*)(Sn + 24) = make_uint2(p1[2], p1[3]);
    if (n + 1 < NCH) {
      SPK[((((size_t)((n + 1) * 4 + hd) * 4 + dvs) * 4 + b) * 2 + 0) * 64 + lane] = p0;
      SPK[((((size_t)((n + 1) * 4 + hd) * 4 + dvs) * 4 + b) * 2 + 1) * 64 + lane] = p1;
    }
#pragma unroll
    for (int sx = 0; sx < 8; ++sx) Ac[sx] = An[sx];
    Bc = Bn;
  }
#pragma unroll
  for (int i = 0; i < 16; ++i)
    P.out[OUT_PGDN + (((size_t)l * 4 + hd) * 128 + 32 * b + crow(i, h)) * 128 + 32 * dvs + r] = acc[i];
}

DI void gdn_out(const Params& P, int l, int item, char* smem) {
  const float* UTg = (const float*)(P.ws + O_UT);
  const ushort_t* WNg = (const ushort_t*)(P.ws + O_WN); const ushort_t* QGg = (const ushort_t*)(P.ws + O_QG);
  const ushort_t* QKMg = (const ushort_t*)(P.ws + O_QKM);
  const u32x4* SPK = (const u32x4*)(P.ws + O_SPK);
  const ushort_t* PROJ = (const ushort_t*)(P.ws + O_PROJ);
  ushort_t* MIX = (ushort_t*)(P.ws + O_MIX);
  ushort_t* WNs = (ushort_t*)smem;
  ushort_t* QGs = WNs + 64 * 136;
  ushort_t* QKs = QGs + 64 * 136;
  float* Os = (float*)smem;
  const int tid = get_tid(), lane = tid & 63, wave = tid >> 6, r = lane & 31, h = lane >> 5;
  const int n = item >> 2, hd = item & 3, dv0 = 32 * wave;
  __syncthreads();
  {
    const ushort_t* wsrc = WNg + (size_t)item * 8192; const ushort_t* qsrc = QGg + (size_t)item * 8192;
    const ushort_t* msrc = QKMg + (size_t)item * 4096;
#pragma unroll
    for (int i = 0; i < 4; ++i) {
      const int c = tid + 256 * i;
      *(u32x4*)(WNs + (c >> 4) * 136 + (c & 15) * 8) = *(const u32x4*)(wsrc + c * 8);
      *(u32x4*)(QGs + (c >> 4) * 136 + (c & 15) * 8) = *(const u32x4*)(qsrc + c * 8);
    }
#pragma unroll
    for (int i = 0; i < 2; ++i) {
      const int c = tid + 256 * i;
      *(u32x4*)(QKs + (c >> 3) * 72 + (c & 7) * 8) = *(const u32x4*)(msrc + c * 8);
    }
  }
  f32x16 vn[2];
#pragma unroll
  for (int cb = 0; cb < 2; ++cb)
#pragma unroll
    for (int g = 0; g < 4; ++g) {
      const float4 t = *(const float4*)(UTg + (size_t)item * 8192 + (dv0 + r) * 64 + 32 * cb + 8 * g + 4 * h);
      vn[cb][4 * g] = t.x; vn[cb][4 * g + 1] = t.y; vn[cb][4 * g + 2] = t.z; vn[cb][4 * g + 3] = t.w;
    }
  bf16x8 Sp[4][2];
#pragma unroll
  for (int b = 0; b < 4; ++b)
#pragma unroll
    for (int sx = 0; sx < 2; ++sx) Sp[b][sx] = __builtin_bit_cast(bf16x8, SPK[((((size_t)item * 4 + wave) * 4 + b) * 2 + sx) * 64 + lane]);
  __syncthreads();
#pragma unroll
  for (int cb = 0; cb < 2; ++cb)
#pragma unroll
    for (int b = 0; b < 4; ++b)
#pragma unroll
      for (int sx = 0; sx < 2; ++sx) vn[cb] = MFMA(fragP(WNs + (32 * cb + r) * 136 + 32 * b + 16 * sx, h), Sp[b][sx], vn[cb]);
  bf16x8 Vp[2][2];
  Vp[0][0] = pack8<0>(vn[0]); Vp[0][1] = pack8<1>(vn[0]); Vp[1][0] = pack8<0>(vn[1]); Vp[1][1] = pack8<1>(vn[1]);
  f32x16 o[2];
#pragma unroll
  for (int cb = 0; cb < 2; ++cb) {
    o[cb] = zero16();
#pragma unroll
    for (int b = 0; b < 4; ++b)
#pragma unroll
      for (int sx = 0; sx < 2; ++sx) o[cb] = MFMA(fragP(QGs + (32 * cb + r) * 136 + 32 * b + 16 * sx, h), Sp[b][sx], o[cb]);
#pragma unroll
    for (int cb2 = 0; cb2 <= cb; ++cb2)
#pragma unroll
      for (int sx = 0; sx < 2; ++sx) o[cb] = MFMA(fragP(QKs + (32 * cb + r) * 72 + 32 * cb2 + 16 * sx, h), Vp[cb2][sx], o[cb]);
  }
  __syncthreads();
#pragma unroll
  for (int cb = 0; cb < 2; ++cb)
#pragma unroll
    for (int i = 0; i < 16; ++i) Os[(32 * cb + crow(i, h)) * 132 + dv0 + r] = o[cb][i];
  __syncthreads();
  const float gw0 = P.gdn_norm[l * 128 + lane], gw1 = P.gdn_norm[l * 128 + 64 + lane];
#pragma unroll 4
  for (int rr = 0; rr < 16; ++rr) {
    const int c = 16 * wave + rr, row = 64 * n + c;
    const float o0 = Os[c * 132 + lane], o1 = Os[c * 132 + 64 + lane];
    const float z0 = bf2f(PROJ[(size_t)row * INP + OFF_Z + hd * 128 + lane]), z1 = bf2f(PROJ[(size_t)row * INP + OFF_Z + hd * 128 + 64 + lane]);
    const float ss = wave_sum(o0 * o0 + o1 * o1);
    const float rstd = rsqrtf(ss * (1.f / 128.f) + EPS);
    MIX[(size_t)row * 1024 + 512 + hd * 128 + lane] = f2bf(o0 * rstd * gw0 * siluf(z0));
    MIX[(size_t)row * 1024 + 512 + hd * 128 + 64 + lane] = f2bf(o1 * rstd * gw1 * siluf(z1));
  }
}

template <int NDB>
DI void softmax_pv(f32x16 (&st)[2], f32x16 (&o)[NDB], float& m, float& l, f32x16& negm, bool first, const ushort_t* Vs, int vpitch, int vcol0, int lane) {
  const int h = lane >> 5, i16 = lane & 15, q = i16 >> 2, p = i16 & 3, blk = (lane >> 4) & 1;
  const ushort_t* vb = Vs + (4 * h + q) * vpitch + vcol0 + 16 * blk + 4 * p;
  s16x4 vf[2][NDB][4];
#pragma unroll
  for (int kb = 0; kb < 2; ++kb)
#pragma unroll
    for (int db = 0; db < NDB; ++db)
#pragma unroll
      for (int j = 0; j < 4; ++j) vf[kb][db][j] = vtr(vb + (32 * kb + 8 * j) * vpitch + 32 * db);
  __builtin_amdgcn_sched_barrier(0);
  float mt = st[0][0];
#pragma unroll
  for (int kb = 0; kb < 2; ++kb)
#pragma unroll
    for (int i = 0; i < 16; ++i) mt = fmaxf(mt, st[kb][i]);
  mt = swap_max(mt);
  if (__builtin_amdgcn_ballot_w64(first || (mt > 8.f)) != 0ull) {
    const float d = first ? mt : fmaxf(mt, 0.f);
    const float alpha = first ? 1.f : __builtin_amdgcn_exp2f(-d);
    m += d;
    l *= alpha;
#pragma unroll
    for (int db = 0; db < NDB; ++db)
#pragma unroll
      for (int i = 0; i < 16; ++i) o[db][i] *= alpha;
#pragma unroll
    for (int kb = 0; kb < 2; ++kb)
#pragma unroll
      for (int i = 0; i < 16; ++i) st[kb][i] -= d;
    const float nm = -m;
#pragma unroll
    for (int i = 0; i < 16; ++i) negm[i] = nm;
  }
  float ls = 0.f;
#pragma unroll
  for (int kb = 0; kb < 2; ++kb)
#pragma unroll
    for (int i = 0; i < 16; ++i) { const float pv = __builtin_amdgcn_exp2f(st[kb][i]); st[kb][i] = pv; ls += pv; }
  l += ls;
  __builtin_amdgcn_s_setprio(1);
#pragma unroll
  for (int kb = 0; kb < 2; ++kb) {
    const bf16x8 p0 = pack8<0>(st[kb]);
    const bf16x8 p1 = pack8<1>(st[kb]);
#pragma unroll
    for (int db = 0; db < NDB; ++db) {
      o[db] = MFMA(cat8(vf[kb][db][0], vf[kb][db][1]), p0, o[db]);
      o[db] = MFMA(cat8(vf[kb][db][2], vf[kb][db][3]), p1, o[db]);
    }
  }
  __builtin_amdgcn_s_setprio(0);
}

template <int NDB>
DI void softmax_pv_simple(f32x16 (&st)[2], f32x16 (&o)[NDB], float& m, float& l, const ushort_t* Vs, int vpitch, int vcol0, int lane) {
  const int h = lane >> 5, i16 = lane & 15, q = i16 >> 2, p = i16 & 3, blk = (lane >> 4) & 1;
  float mt = st[0][0];
#pragma unroll
  for (int kb = 0; kb < 2; ++kb)
#pragma unroll
    for (int i = 0; i < 16; ++i) mt = fmaxf(mt, st[kb][i]);
  mt = swap_max(mt);
  const float mn = fmaxf(m, mt);
  const float alpha = __builtin_amdgcn_exp2f(m - mn);
  m = mn;
  float ls = 0.f;
#pragma unroll
  for (int kb = 0; kb < 2; ++kb)
#pragma unroll
    for (int i = 0; i < 16; ++i) { const float pv = __builtin_amdgcn_exp2f(st[kb][i] - mn); st[kb][i] = pv; ls += pv; }
  l = l * alpha + ls;
#pragma unroll
  for (int db = 0; db < NDB; ++db)
#pragma unroll
    for (int i = 0; i < 16; ++i) o[db][i] *= alpha;
  const ushort_t* vb = Vs + (4 * h + q) * vpitch + vcol0 + 16 * blk + 4 * p;
#pragma unroll
  for (int kb = 0; kb < 2; ++kb) {
    const bf16x8 p0 = pack8<0>(st[kb]);
    const bf16x8 p1 = pack8<1>(st[kb]);
#pragma unroll
    for (int db = 0; db < NDB; ++db) {
      const ushort_t* v0 = vb + (32 * kb) * vpitch + 32 * db;
      o[db] = MFMA(cat8(vtr(v0), vtr(v0 + 8 * vpitch)), p0, o[db]);
      o[db] = MFMA(cat8(vtr(v0 + 16 * vpitch), vtr(v0 + 24 * vpitch)), p1, o[db]);
    }
  }
}

DI void attn_prompt(const Params& P, int qt, int head, char* smem) {
  const ushort_t* QF = (const ushort_t*)(P.ws + O_QF); const ushort_t* KF = (const ushort_t*)(P.ws + O_KF);
  const ushort_t* VV = (const ushort_t*)(P.ws + O_VV); ushort_t* MIX = (ushort_t*)(P.ws + O_MIX);
  constexpr int KP = 104, VP = 72;
  ushort_t* Kb = (ushort_t*)smem;
  ushort_t* Vb = Kb + 2 * 64 * KP;
  const int tid = get_tid(), lane = tid & 63, wave = tid >> 6, r = lane & 31, h = lane >> 5;
  const int qrow = 128 * qt + 32 * wave + r;
  const int cq = 2 * qt + (wave >> 1);
  const int ntile = 2 * qt + 2;
  bf16x8 qf[6];
#pragma unroll
  for (int s = 0; s < 6; ++s) qf[s] = *(const bf16x8*)(QF + (size_t)qrow * 768 + head * 96 + 16 * s + 8 * h);
  f32x16 o[2]; o[0] = zero16(); o[1] = zero16();
  float m = 0.f, l = 0.f;
  f32x16 negm = zero16();
  u32x4 rk0, rk1, rk2, rv0, rv1;
  u32x4 sk0, sk1, sk2, sv0, sv1;
  const int kr0 = tid / 12, kc0 = tid % 12, kr1 = (tid + 256) / 12, kc1 = (tid + 256) % 12, kr2 = (tid + 512) / 12, kc2 = (tid + 512) % 12;
  const int vr0 = tid >> 3, vc0 = tid & 7, vr1 = (tid + 256) >> 3;
  const ushort_t* kg0 = KF + (size_t)kr0 * 768 + head * 96 + kc0 * 8;
  const ushort_t* kg1 = KF + (size_t)kr1 * 768 + head * 96 + kc1 * 8;
  const ushort_t* kg2 = KF + (size_t)kr2 * 768 + head * 96 + kc2 * 8;
  const ushort_t* vg0 = VV + (size_t)vr0 * 512 + head * 64 + vc0 * 8;
  const ushort_t* vg1 = VV + (size_t)vr1 * 512 + head * 64 + vc0 * 8;
#define ATT_GLOAD0(kt) { const size_t ko = (size_t)(kt) * 64 * 768, vo = (size_t)(kt) * 64 * 512; \
    rk0 = *(const u32x4*)(kg0 + ko); rk1 = *(const u32x4*)(kg1 + ko); rk2 = *(const u32x4*)(kg2 + ko); rv0 = *(const u32x4*)(vg0 + vo); rv1 = *(const u32x4*)(vg1 + vo); }
#define ATT_GLOAD1(kt) { const size_t ko = (size_t)(kt) * 64 * 768, vo = (size_t)(kt) * 64 * 512; \
    sk0 = *(const u32x4*)(kg0 + ko); sk1 = *(const u32x4*)(kg1 + ko); sk2 = *(const u32x4*)(kg2 + ko); sv0 = *(const u32x4*)(vg0 + vo); sv1 = *(const u32x4*)(vg1 + vo); }
#define ATT_LSTORE0(buf) { ushort_t* kd = Kb + (buf) * 64 * KP; ushort_t* vd = Vb + (buf) * 64 * VP; \
    *(u32x4*)(kd + kr0 * KP + kc0 * 8) = rk0; *(u32x4*)(kd + kr1 * KP + kc1 * 8) = rk1; *(u32x4*)(kd + kr2 * KP + kc2 * 8) = rk2; \
    *(u32x4*)(vd + vr0 * VP + vc0 * 8) = rv0; *(u32x4*)(vd + vr1 * VP + vc0 * 8) = rv1; }
#define ATT_LSTORE1(buf) { ushort_t* kd = Kb + (buf) * 64 * KP; ushort_t* vd = Vb + (buf) * 64 * VP; \
    *(u32x4*)(kd + kr0 * KP + kc0 * 8) = sk0; *(u32x4*)(kd + kr1 * KP + kc1 * 8) = sk1; *(u32x4*)(kd + kr2 * KP + kc2 * 8) = sk2; \
    *(u32x4*)(vd + vr0 * VP + vc0 * 8) = sv0; *(u32x4*)(vd + vr1 * VP + vc0 * 8) = sv1; }
#define ATT_COMPUTE(kt, buf) if ((kt) <= cq) { \
      const ushort_t* Ks = Kb + (buf) * 64 * KP; \
      f32x16 st[2]; st[0] = negm; st[1] = negm; \
      bf16x8 kf[12]; \
      _Pragma("unroll") for (int s = 0; s < 6; ++s) { \
        _Pragma("unroll") for (int kb = 0; kb < 2; ++kb) kf[2 * s + kb] = *(const bf16x8*)(Ks + (32 * kb + r) * KP + 16 * s + 8 * h); } \
      __builtin_amdgcn_sched_barrier(0); \
      __builtin_amdgcn_s_setprio(1); \
      _Pragma("unroll") for (int s = 0; s < 6; ++s) { \
        _Pragma("unroll") for (int kb = 0; kb < 2; ++kb) st[kb] = MFMA(kf[2 * s + kb], qf[s], st[kb]); } \
      __builtin_amdgcn_s_setprio(0); \
      if ((kt) == 0) { \
        _Pragma("unroll") for (int kb = 0; kb < 2; ++kb) \
          _Pragma("unroll") for (int i = 0; i < 16; ++i) if (32 * kb + crow(i, h) < POFF) st[kb][i] = -1e30f; } \
      softmax_pv<2>(st, o, m, l, negm, (kt) == 0, Vb + (buf) * 64 * VP, VP, 0, lane); }
  __syncthreads();
  ATT_GLOAD0(0);
  ATT_GLOAD1(1);
  ATT_LSTORE0(0);
  const int lastt = ntile - 1;
  ATT_GLOAD0(min(2, lastt));
  __syncthreads();
  for (int kt = 0; kt < ntile; kt += 2) {
    ATT_COMPUTE(kt, 0);
    ATT_LSTORE1(1);
    ATT_GLOAD1(min(kt + 3, lastt));
    __syncthreads();
    ATT_COMPUTE(kt + 1, 1);
    ATT_LSTORE0(0);
    ATT_GLOAD0(min(kt + 4, lastt));
    __syncthreads();
  }
#undef ATT_GLOAD0
#undef ATT_GLOAD1
#undef ATT_LSTORE0
#undef ATT_LSTORE1
#undef ATT_COMPUTE
  const float inv = 1.f / swap_sum(l);
#pragma unroll
  for (int db = 0; db < 2; ++db)
#pragma unroll
    for (int g = 0; g < 4; ++g)
      *(uint2*)(MIX + (size_t)qrow * 1024 + head * 64 + 32 * db + 8 * g + 4 * h) =
          make_uint2(pk2(o[db][4 * g] * inv, o[db][4 * g + 1] * inv), pk2(o[db][4 * g + 2] * inv, o[db][4 * g + 3] * inv));
}

DI void attn_sample(const Params& P, int l, int b, int sp, int hg, char* smem) {
  const ushort_t* QF = (const ushort_t*)(P.ws + O_QF); const ushort_t* QL = (const ushort_t*)(P.ws + O_QL);
  const ushort_t* CKV = (const ushort_t*)(P.ws + O_CKV); const ushort_t* KPE = (const ushort_t*)(P.ws + O_KPE);
  float* PO = (float*)(P.ws + O_PO); float* PML = (float*)(P.ws + O_PML);
  constexpr int KP = 296;
  ushort_t* Qs = (ushort_t*)smem;
  ushort_t* Kt = Qs + 64 * KP;
  const int tid = get_tid(), lane = tid & 63, wave = tid >> 6, r = lane & 31, h = lane >> 5;
  const int qb = wave & 1, dvh = wave >> 1;
  __syncthreads();
#pragma unroll
  for (int i = 0; i < 9; ++i) {
    const int c = tid + 256 * i, q = c / 36, cc = c % 36;
    const int hh = q >> 4, tok = q & 15, head = 4 * hg + hh, srow = 16 * b + tok;
    uint4 v;
    if (cc < 32) v = *(const uint4*)(QL + (size_t)srow * 2048 + head * 256 + cc * 8);
    else v = *(const uint4*)(QF + (size_t)(SOFF + srow) * 768 + head * 96 + 64 + (cc - 32) * 8);
    *(uint4*)(Qs + q * KP + cc * 8) = v;
  }
  f32x16 o[4]; o[0] = zero16(); o[1] = zero16(); o[2] = zero16(); o[3] = zero16();
  float m = -1e30f, lsum = 0.f;
  const int nt = (sp == 7) ? 9 : 8;
  const float* clat = P.cache_lat + (((size_t)l * 32 + b) * PAST + (size_t)sp * 512) * 256;
  const float* cpe = P.cache_pe + (((size_t)l * 32 + b) * PAST + (size_t)sp * 512) * 32;
  for (int ti = 0; ti < nt; ++ti) {
    __syncthreads();
    if (ti < 8) {
      const float* lat = clat + (size_t)ti * 64 * 256;
#pragma unroll
      for (int bt = 0; bt < 4; ++bt) {
        float4 t[4];
#pragma unroll
        for (int i = 0; i < 4; ++i) t[i] = *(const float4*)(lat + (size_t)(tid + 256 * (4 * bt + i)) * 4);
#pragma unroll
        for (int i = 0; i < 4; ++i) {
          const int c = tid + 256 * (4 * bt + i), row = c >> 6, c4 = (c & 63) * 4;
          *(uint2*)(Kt + row * KP + c4) = make_uint2(pk2(t[i].x, t[i].y), pk2(t[i].z, t[i].w));
        }
      }
      const float* pe = cpe + (size_t)ti * 64 * 32;
#pragma unroll
      for (int i = 0; i < 2; ++i) {
        const int c = tid + 256 * i, row = c >> 3, c4 = (c & 7) * 4;
        const float4 t = *(const float4*)(pe + (size_t)c * 4);
        *(uint2*)(Kt + row * KP + 256 + c4) = make_uint2(pk2(t.x, t.y), pk2(t.z, t.w));
      }
    } else {
#pragma unroll
      for (int i = 0; i < 9; ++i) {
        const int c = tid + 256 * i, row = c / 36, cc = c % 36;
        uint4 v = make_uint4(0u, 0u, 0u, 0u);
        if (row < 16) {
          if (cc < 32) v = *(const uint4*)(CKV + (size_t)(SOFF + 16 * b + row) * 256 + cc * 8);
          else v = *(const uint4*)(KPE + (size_t)(SOFF + 16 * b + row) * 32 + (cc - 32) * 8);
        }
        *(uint4*)(Kt + row * KP + cc * 8) = v;
      }
    }
    __syncthreads();
    f32x16 st[2]; st[0] = zero16(); st[1] = zero16();
#pragma unroll
    for (int s = 0; s < 18; ++s) {
      const bf16x8 qv = *(const bf16x8*)(Qs + (32 * qb + r) * KP + 16 * s + 8 * h);
#pragma unroll
      for (int kb = 0; kb < 2; ++kb) st[kb] = MFMA(*(const bf16x8*)(Kt + (32 * kb + r) * KP + 16 * s + 8 * h), qv, st[kb]);
    }
    if (ti == 8) {
#pragma unroll
      for (int kb = 0; kb < 2; ++kb)
#pragma unroll
        for (int i = 0; i < 16; ++i) if (32 * kb + crow(i, h) >= 16) st[kb][i] = -1e30f;
    }
    softmax_pv_simple<4>(st, o, m, lsum, Kt, KP, 128 * dvh, lane);
  }
  const float lt = swap_sum(lsum);
  const int gq = 64 * hg + 32 * qb + r;
  const size_t pbase = ((size_t)(b * 8 + sp) * 128 + gq);
  if (dvh == 0 && h == 0) { PML[pbase * 2] = m; PML[pbase * 2 + 1] = lt; }
#pragma unroll
  for (int db = 0; db < 4; ++db)
#pragma unroll
    for (int g = 0; g < 4; ++g)
      *(float4*)(PO + pbase * 256 + 128 * dvh + 32 * db + 8 * g + 4 * h) = make_float4(o[db][4 * g], o[db][4 * g + 1], o[db][4 * g + 2], o[db][4 * g + 3]);
}


DI bool tile_swz(int t, int MT, int NT, int& mt, int& nt) {
  const int G = gridDim.x, b = blockIdx.x;
  int u = t;
  if ((G & 7) == 0) u = (t / G) * G + (b & 7) * (G >> 3) + (b >> 3);
  if (u >= MT * NT) return false;
  const int full = (NT >> 3) * MT * 8;
  if (u < full) { const int g = u / (MT * 8), rem = u % (MT * 8); mt = rem >> 3; nt = g * 8 + (rem & 7); }
  else { const int rem = u - full, w = NT & 7; mt = rem / w; nt = (NT >> 3) * 8 + rem % w; }
  return true;
}
DI int round_up_grid(int n) { const int G = gridDim.x; return ((n + G - 1) / G) * G; }

DI void phase_g1(const Params& P, int l, char* smem) {
  const ushort_t* Wl = (const ushort_t*)(P.ws + O_W) + (size_t)l * E_WL;
  for (int t = blockIdx.x; t < round_up_grid(133 * 11); t += gridDim.x) {
    int mt, nt; if (!tile_swz(t, 133, 11, mt, nt)) continue;
    gemm_tile_w((const ushort_t*)(P.ws + O_XN), 1024, Wl + E_WT_IN, 1024, 1024, mt * 128, nt * 256, smem, EpiBF16{(ushort_t*)(P.ws + O_PROJ), INP, 1.f});
  }
}

DI void phase_mid(const Params& P, int l, char* smem, int flags) {
  const ushort_t* Wl = (const ushort_t*)(P.ws + O_W) + (size_t)l * E_WL;
  const ushort_t* CQN = (const ushort_t*)(P.ws + O_CQN);
  constexpr int N_G2 = 133 * 6, N_G2S = 4 * 16, N_G3 = 129 * 8, N_PREP = NITEM, N_GS = 128;
  constexpr int TOT = N_G2 + N_G2S + N_G3 + N_PREP + N_GS;
  for (int t0 = blockIdx.x; t0 < TOT; t0 += gridDim.x) {
    int t = t0;
    if (t < N_PREP) { if (flags == 0 || flags == 4) gdn_prep(P, t, smem); continue; }
    t -= N_PREP;
    if (t < N_GS) { if (flags == 0 || flags == 5) gdn_sample(P, l, t, smem); continue; }
    if (!(flags == 0 || flags == 6)) continue;
    t -= N_GS;
    if (t < N_G3) { gemm_tile((const ushort_t*)(P.ws + O_CKV), 256, Wl + E_WT_UKV, 256, 256, (t / 8) * 128, (t % 8) * 128, smem, EpiKV{(ushort_t*)(P.ws + O_KF), (ushort_t*)(P.ws + O_VV)}); continue; }
    t -= N_G3;
    if (t < N_G2) { gemm_tile(CQN, 384, Wl + E_WT_UQ, 384, 384, (t / 6) * 128, (t % 6) * 128, smem, EpiQ{(ushort_t*)(P.ws + O_QF)}); continue; }
    t -= N_G2;
    gemm_tile(CQN, 384, Wl + E_WABS, 384, 384, SOFF + (t / 16) * 128, (t % 16) * 128, smem, EpiBF16{(ushort_t*)(P.ws + O_QL) - (size_t)SOFF * 2048, 2048, QSCALE});
  }
}

DI void phase_mix(const Params& P, int l, char* smem, int flags) {
  int* ctr = (int*)(P.ws + O_CTR) + l * 16;
  volatile int* slot = (volatile int*)(smem + 75776);
  const int myq = (int)(xcc_id_early() & 7u);
  if (threadIdx.x == 0) slot[1] = 0;
  while (true) {
    __syncthreads();
    if (threadIdx.x == 0) {
      int stg = slot[1], code = -1;
      while (stg < 10) {
        if (stg == 0) { const int t = atomicAdd(&ctr[0], 1); if (t < 16) { code = t; break; } stg = 1; }
        else if (stg == 2) { const int t = atomicAdd(&ctr[9], 1); if (t < 512) { code = 16 + 1032 + t; break; } stg = 3; }
        else { const int q = (stg == 1) ? myq : ((myq + stg - 2) & 7); const int t = atomicAdd(&ctr[1 + q], 1); if (t < 129) { code = 16 + (128 - t) * 8 + q; break; } ++stg; }
      }
      slot[1] = stg; slot[0] = code;
    }
    __syncthreads();
    int t = slot[0];
    if (t < 0) break;
    if (t < 16) { if (flags == 0 || flags == 1) gdn_scan(P, l, t, smem); continue; }
    t -= 16;
    if (t < 1032) { if (flags == 0 || flags == 2) attn_prompt(P, t >> 3, t & 7, smem); continue; }
    t -= 1032;
    if (flags == 0 || flags == 3) attn_sample(P, l, t >> 4, (t >> 1) & 7, t & 1, smem);
  }
}

DI void phase_gate(const Params& P, int l, char* smem) {
  const float* OG = (const float*)(P.ws + O_OG); const ushort_t* PROJ = (const ushort_t*)(P.ws + O_PROJ);
  ushort_t* MIX = (ushort_t*)(P.ws + O_MIX); ushort_t* MIXS = (ushort_t*)(P.ws + O_MIXS);
  const float* PO = (const float*)(P.ws + O_PO); const float* PML = (const float*)(P.ws + O_PML);
  const int tid = get_tid(), lane = tid & 63, gw = blockIdx.x * 4 + (tid >> 6), nw = gridDim.x * 4;
  for (int t = blockIdx.x; t < NITEM; t += gridDim.x) gdn_out(P, l, t, smem);
  for (int row = SOFF + gw; row < MTOT; row += nw) {
    const bool valid = row_valid(row);
#pragma unroll
    for (int hd = 0; hd < 4; ++hd) {
      float o0 = 0.f, o1 = 0.f, z0 = 0.f, z1 = 0.f;
      if (valid) {
        o0 = OG[(size_t)row * 512 + hd * 128 + lane]; o1 = OG[(size_t)row * 512 + hd * 128 + 64 + lane];
        z0 = bf2f(PROJ[(size_t)row * INP + OFF_Z + hd * 128 + lane]); z1 = bf2f(PROJ[(size_t)row * INP + OFF_Z + hd * 128 + 64 + lane]);
      }
      const float ss = wave_sum(o0 * o0 + o1 * o1);
      const float rstd = rsqrtf(ss * (1.f / 128.f) + EPS);
      const float v0 = o0 * rstd * P.gdn_norm[l * 128 + lane] * siluf(z0);
      const float v1 = o1 * rstd * P.gdn_norm[l * 128 + 64 + lane] * siluf(z1);
      if (row < SOFF) { MIX[(size_t)row * 1024 + 512 + hd * 128 + lane] = f2bf(v0); MIX[(size_t)row * 1024 + 512 + hd * 128 + 64 + lane] = f2bf(v1); }
      else { MIXS[(size_t)(row - SOFF) * 2560 + 2048 + hd * 128 + lane] = f2bf(v0); MIXS[(size_t)(row - SOFF) * 2560 + 2048 + hd * 128 + 64 + lane] = f2bf(v1); }
    }
  }
  for (int it = gw; it < 32 * 128; it += nw) {
    const int b = it >> 7, gq = it & 127, head = gq >> 4, tok = gq & 15;
    float ms[8], mx = -1e30f;
#pragma unroll
    for (int sp = 0; sp < 8; ++sp) { ms[sp] = PML[((size_t)(b * 8 + sp) * 128 + gq) * 2]; mx = fmaxf(mx, ms[sp]); }
    float L = 0.f; float4 acc = make_float4(0.f, 0.f, 0.f, 0.f);
#pragma unroll
    for (int sp = 0; sp < 8; ++sp) {
      const float w = __builtin_amdgcn_exp2f(ms[sp] - mx);
      L += w * PML[((size_t)(b * 8 + sp) * 128 + gq) * 2 + 1];
      const float4 t = *(const float4*)(PO + ((size_t)(b * 8 + sp) * 128 + gq) * 256 + lane * 4);
      acc.x += w * t.x; acc.y += w * t.y; acc.z += w * t.z; acc.w += w * t.w;
    }
    const float inv = 1.f / L;
    *(uint2*)(MIXS + (size_t)(16 * b + tok) * 2560 + head * 256 + lane * 4) = make_uint2(pk2(acc.x * inv, acc.y * inv), pk2(acc.z * inv, acc.w * inv));
  }
}

DI void phase_g6(const Params& P, int l, char* smem) {
  const ushort_t* Wl = (const ushort_t*)(P.ws + O_W) + (size_t)l * E_WL;
  ushort_t* OMIX = (ushort_t*)(P.ws + O_OMIX);
  for (int t = blockIdx.x; t < round_up_grid(133 * 16); t += gridDim.x) {
    int mt, n2; if (!tile_swz(t, 133, 16, mt, n2)) continue;
    const int nt = n2 >> 1, ks = n2 & 1;
    ushort_t* dst = OMIX + (size_t)ks * MTOT * 1024;
    if (mt < 129) gemm_tile((const ushort_t*)(P.ws + O_MIX) + ks * 512, 1024, Wl + E_WT_O + ks * 512, 1024, 512, mt * 128, nt * 128, smem, EpiBF16{dst, 1024, 1.f});
    else gemm_tile((const ushort_t*)(P.ws + O_MIXS) - (size_t)SOFF * 2560 + ks * 1280, 2560, Wl + E_WT_OS + ks * 1280, 2560, 1280, mt * 128, nt * 128, smem, EpiBF16{dst, 1024, 1.f});
  }
}

DI void phase_resid(const Params& P, const float* w1, const float* w2, bool final_out, bool first) {
  const ushort_t* OMIX = (const ushort_t*)(P.ws + O_OMIX);
  const float* X = (const float*)(P.ws + (first ? O_X : O_X2)); float* XO = (float*)(P.ws + (first ? O_X2 : O_X)); ushort_t* XN = (ushort_t*)(P.ws + O_XN);
  const int tid = get_tid(), lane = tid & 63, gw = blockIdx.x * 4 + (tid >> 6), nw = gridDim.x * 4;
  for (int row = gw; row < MTOT; row += nw) {
    const bool valid = row_valid(row);
    float v[16], ss = 0.f;
#pragma unroll
    for (int j = 0; j < 4; ++j) {
      const uint2 t = *(const uint2*)(OMIX + (size_t)row * 1024 + 4 * lane + 256 * j);
      const uint2 t2 = *(const uint2*)(OMIX + (size_t)MTOT * 1024 + (size_t)row * 1024 + 4 * lane + 256 * j);
      v[4 * j] = __uint_as_float(t.x << 16) + __uint_as_float(t2.x << 16); v[4 * j + 1] = __uint_as_float(t.x & 0xffff0000u) + __uint_as_float(t2.x & 0xffff0000u);
      v[4 * j + 2] = __uint_as_float(t.y << 16) + __uint_as_float(t2.y << 16); v[4 * j + 3] = __uint_as_float(t.y & 0xffff0000u) + __uint_as_float(t2.y & 0xffff0000u);
    }
#pragma unroll
    for (int i = 0; i < 16; ++i) { v[i] = valid ? v[i] : 0.f; ss += v[i] * v[i]; }
    ss = wave_sum(ss);
    const float rstd = rsqrtf(ss * (1.f / 1024.f) + EPS);
#pragma unroll
    for (int j = 0; j < 4; ++j) {
      const int c = 4 * lane + 256 * j;
      const float4 xv = *(const float4*)(X + (size_t)row * 1024 + c);
      const float4 wv = *(const float4*)(w1 + c);
      v[4 * j] = xv.x + v[4 * j] * rstd * wv.x; v[4 * j + 1] = xv.y + v[4 * j + 1] * rstd * wv.y;
      v[4 * j + 2] = xv.z + v[4 * j + 2] * rstd * wv.z; v[4 * j + 3] = xv.w + v[4 * j + 3] * rstd * wv.w;
    }
    if (final_out) {
      if (valid) {
        float* dst = nullptr;
        if (row >= SOFF) dst = P.out + OUT_YS + (size_t)(row - SOFF) * 1024;
        else if (row >= POFF + 16) dst = P.out + OUT_YP + (size_t)(row - POFF - 16) * 1024;
        if (dst) {
#pragma unroll
          for (int j = 0; j < 4; ++j) *(float4*)(dst + 4 * lane + 256 * j) = make_float4(v[4 * j], v[4 * j + 1], v[4 * j + 2], v[4 * j + 3]);
        }
      }
    } else {
      norm_store_row(v, XO + (size_t)row * 1024, XN + (size_t)row * 1024, w2, lane, valid);
    }
  }
}

DI void phase_g7(const Params& P, int l, char* smem) {
  const ushort_t* Wl = (const ushort_t*)(P.ws + O_W) + (size_t)l * E_WL;
  for (int t = blockIdx.x; t < round_up_grid(133 * 22); t += gridDim.x) {
    int mt, nt; if (!tile_swz(t, 133, 22, mt, nt)) continue;
    gemm_tile_w((const ushort_t*)(P.ws + O_XN), 1024, Wl + E_WT_GU, 1024, 1024, mt * 128, nt * 256, smem, EpiSwiGLU{(ushort_t*)(P.ws + O_ACT)});
  }
}
DI void phase_g8(const Params& P, int l, char* smem) {
  const ushort_t* Wl = (const ushort_t*)(P.ws + O_W) + (size_t)l * E_WL;
  for (int t = blockIdx.x; t < round_up_grid(133 * 16); t += gridDim.x) {
    int mt, n2; if (!tile_swz(t, 133, 16, mt, n2)) continue;
    const int nt = n2 >> 1, ks = n2 & 1;
    gemm_tile((const ushort_t*)(P.ws + O_ACT) + ks * 1408, DFF, Wl + E_WT_DOWN + ks * 1408, DFF, 1408, mt * 128, nt * 128, smem,
              EpiBF16{(ushort_t*)(P.ws + O_OMIX) + (size_t)ks * MTOT * 1024, 1024, 1.f});
  }
}

#define XB_TMO      128
#define XB_XCNT(j)  (256  + 64 * (j))
#define XB_XSUB(j)  (1280 + 64 * (j))
#define XB_XGEN(j)  (2304 + 64 * (j))
#define XB_TOP      3328
#define XB_TOPGEN   3392
#define XCD_BAR_WORDS 3456
#define XB_SPIN_CAP (1u << 22)
#define LAS __attribute__((address_space(3)))
DI unsigned xb_ld(unsigned* p) { return __hip_atomic_load(p, __ATOMIC_RELAXED, __HIP_MEMORY_SCOPE_AGENT); }
DI unsigned xb_add(unsigned* p, unsigned v) { return __hip_atomic_fetch_add(p, v, __ATOMIC_RELAXED, __HIP_MEMORY_SCOPE_AGENT); }
DI unsigned xb_xcc_id() { return (unsigned)__builtin_amdgcn_s_getreg((3 << 11) | 20) & 0xFu; }
#define XB_SPIN(cond, bar) do { unsigned _sp = 0; while (cond) { __builtin_amdgcn_s_sleep(1); \
    if ((++_sp & 255u) == 0u) { if (xb_ld(&(bar)[XB_TMO])) break; if (_sp > XB_SPIN_CAP) { atomicAdd(&(bar)[XB_TMO], 1u); break; } } } } while (0)
struct XcdBarrier { unsigned* bar; unsigned x; volatile LAS unsigned* st; };
DI XcdBarrier xcd_barrier_post(unsigned* bar, volatile LAS unsigned* st) {
  XcdBarrier b; b.bar = bar; b.x = xb_xcc_id(); b.st = st;
  if (threadIdx.x == 0) (void)xb_add(&bar[XB_XCNT(b.x)], 1u);
  return b;
}
DI void xcd_barrier_complete(unsigned* bar, unsigned x, unsigned& nloc, unsigned& nx) {
  const unsigned G = gridDim.x * gridDim.y * gridDim.z;
  unsigned sum, cnt, mine, sp = 0u;
  for (;;) {
    sum = 0u; cnt = 0u; mine = 0u;
#pragma unroll
    for (unsigned j = 0; j < 16; ++j) { const unsigned c = xb_ld(&bar[XB_XCNT(j)]); sum += c; cnt += (c > 0u) ? 1u : 0u; mine = (j == x) ? c : mine; }
    if (sum == G) break;
    __builtin_amdgcn_s_sleep(1);
    if ((++sp & 255u) == 0u) { if (xb_ld(&bar[XB_TMO])) break; if (sp > XB_SPIN_CAP) { atomicAdd(&bar[XB_TMO], 1u); break; } }
  }
  nloc = mine > 0u ? mine : 1u; nx = cnt > 0u ? cnt : 1u;
}
DI void xcd_barrier(const XcdBarrier& b) {
  asm volatile("s_waitcnt vmcnt(0)" ::: "memory");
  __syncthreads();
  if (threadIdx.x == 0) {
    unsigned* bar = b.bar;
    __builtin_amdgcn_s_waitcnt(0);
    unsigned nloc = b.st[0], nx = b.st[1];
    if (nloc == 0u) { xcd_barrier_complete(bar, b.x, nloc, nx); b.st[0] = nloc; b.st[1] = nx; }
    const unsigned old = xb_add(&bar[XB_XSUB(b.x)], 1u);
    const unsigned gen = old / nloc;
    if (old + 1u == (gen + 1u) * nloc) {
      __builtin_amdgcn_fence(__ATOMIC_RELEASE, "agent");
      asm volatile("s_waitcnt vmcnt(0)" ::: "memory");
      const unsigned og = xb_add(&bar[XB_TOP], 1u);
      const unsigned tg = og / nx;
      if (og + 1u == (tg + 1u) * nx) xb_add(&bar[XB_TOPGEN], 1u);
      else XB_SPIN(xb_ld(&bar[XB_TOPGEN]) == tg, bar);
      __builtin_amdgcn_fence(__ATOMIC_ACQUIRE, "agent");
      xb_add(&bar[XB_XGEN(b.x)], 1u);
      asm volatile("s_waitcnt vmcnt(0)" ::: "memory");
    } else {
      XB_SPIN(xb_ld(&bar[XB_XGEN(b.x)]) == gen, bar);
      __builtin_amdgcn_fence(__ATOMIC_ACQUIRE, "agent");
      asm volatile("s_waitcnt vmcnt(0)" ::: "memory");
    }
  }
  __syncthreads();
}

constexpr int NPHASE = 2 + 10 * DEPTH;

DI void run_phase(const Params& P, int ph, char* smem, int flags) {
  if (ph == 0) { phase_prep0(P, smem); return; }
  if (ph == 1) { phase_prep1(P, smem); return; }
  const int l = (ph - 2) / 10, sub = (ph - 2) % 10;
  switch (sub) {
    case 0: phase_g1(P, l, smem); break;
    case 1: phase_rowpass(P, l); break;
    case 2: phase_mid(P, l, smem, flags); break;
    case 3: phase_mix(P, l, smem, flags); break;
    case 4: phase_gate(P, l, smem); break;
    case 5: phase_g6(P, l, smem); break;
    case 6: phase_resid(P, P.post_mix + l * 1024, P.pre_ffn + l * 1024, false, true); break;
    case 7: phase_g7(P, l, smem); break;
    case 8: phase_g8(P, l, smem); break;
    default: phase_resid(P, P.post_ffn + l * 1024, P.pre_mix + (l < 3 ? l + 1 : 0) * 1024, l == 3, false); break;
  }
}

template <bool COOP>
__global__ void __launch_bounds__(256, 2) mega_kernel(Params P, int ph0, int ph1, int flags) {
  __shared__ __attribute__((aligned(16))) char smem[SMEM_BYTES];
  if (COOP) {
    __shared__ uint4 xb_words;
    if (threadIdx.x == 0) xb_words = make_uint4(0u, 0u, 0u, 0u);
    __syncthreads();
    XcdBarrier xb = xcd_barrier_post((unsigned*)(P.ws + O_BAR), (volatile LAS unsigned*)&xb_words);
    for (int ph = ph0; ph < ph1; ++ph) {
      run_phase(P, ph, smem, flags);
      if (ph + 1 < ph1) {
        if (flags == 0x7fffffff) cg::this_grid().sync();
        xcd_barrier(xb);
      }
    }
  } else {
    for (int ph = ph0; ph < ph1; ++ph) run_phase(P, ph, smem, flags);
  }
}

extern "C" void kernel_launch(void* const* d_in, const int* in_sizes, int n_in, void* d_out, int out_size, void* d_ws,
                              size_t ws_size, hipStream_t stream) {
  Params P{};
  const float** pp = (const float**)&P;
  for (int i = 0; i < 25; ++i) pp[i] = (const float*)d_in[i];
  P.out = (float*)d_out;
  P.ws = (char*)d_ws;
  if (ws_size < O_END) { fprintf(stderr, "workspace too small: %zu < %zu\n", ws_size, (size_t)O_END); return; }
#if ONE_LAUNCH
  static int grid_blocks = 0;
  if (!grid_blocks) {
    int dev = 0, cus = 0, per_cu = 0;
    hipGetDevice(&dev);
    hipDeviceGetAttribute(&cus, hipDeviceAttributeMultiprocessorCount, dev);
    hipOccupancyMaxActiveBlocksPerMultiprocessor(&per_cu, mega_kernel<true>, 256, 0);
    if (per_cu > 2) per_cu = 2;
    grid_blocks = cus * per_cu;
  }
  hipMemsetAsync((char*)d_ws + O_BAR, 0, XCD_BAR_WORDS * 4, stream);
  int ph0 = 0, ph1 = NPHASE, flags = 0;
  void* args[] = {&P, &ph0, &ph1, &flags};
  hipError_t e = hipLaunchCooperativeKernel((void*)mega_kernel<true>, dim3(grid_blocks), dim3(256), args, 0, stream);
  if (e != hipSuccess) fprintf(stderr, "cooperative launch failed: %s (grid %d)\n", hipGetErrorString(e), grid_blocks);
#else
  for (int ph = 0; ph < NPHASE; ++ph) {
    mega_kernel<false><<<512, 256, 0, stream>>>(P, ph, ph + 1, 0);
    if ((ph >= 2 && ((PROBE_MASK >> ((ph - 2) % 10)) & 1)) || (ph < 2 && ((PROBE_MASK >> (10 + ph)) & 1))) {
      if (ph >= 2 && (ph - 2) % 10 == 3) hipMemsetAsync((char*)d_ws + O_CTR, 0, 256, stream);
      mega_kernel<false><<<512, 256, 0, stream>>>(P, ph, ph + 1, PROBE_FLAGS);
    }
  }
#endif
}
```

```cpp
#include <hip/hip_runtime.h>
#include <hip/hip_cooperative_groups.h>
#include <cstdio>
namespace cg = cooperative_groups;

#ifndef ONE_LAUNCH
#define ONE_LAUNCH 1
#endif
#ifndef PROBE_MASK
#define PROBE_MASK 0
#endif
#ifndef PROBE_FLAGS
#define PROBE_FLAGS 0
#endif

#define DI __device__ __forceinline__
typedef unsigned short ushort_t;
typedef short bf16x8 __attribute__((ext_vector_type(8)));
typedef short s16x4 __attribute__((ext_vector_type(4)));
typedef float f32x16 __attribute__((ext_vector_type(16)));
typedef float f32x2v __attribute__((ext_vector_type(2)));
typedef __bf16 bf16x2v __attribute__((ext_vector_type(2)));
typedef unsigned u32x4 __attribute__((ext_vector_type(4)));
typedef float f32x4v __attribute__((ext_vector_type(4)));
#define MFMA(a, b, c) __builtin_amdgcn_mfma_f32_32x32x16_bf16((a), (b), (c), 0, 0, 0)

constexpr int DM = 1024, LTOK = 16400, DEPTH = 4, DECB = 32, DECT = 16, PAST = 4096;
constexpr int POFF = 48, PEND = 16448, SOFF = 16512, MTOT = 17024;
constexpr int NCH = 257, NITEM = NCH * 4;
constexpr int INP = 2816, DFF = 2816;
constexpr int OFF_KV = 384, OFF_PE = 640, OFF_QKV = 672, OFF_Z = 2208, OFF_B = 2720, OFF_A = 2724, INW = 2728;
constexpr float EPS = 1e-6f;
constexpr float QSCALE = 0.10206207261596577f * 1.4426950408889634f;
constexpr int SMEM_BYTES = 75776 + 16;

constexpr size_t OUT_YP = 0;
constexpr size_t OUT_YS = OUT_YP + (size_t)16384 * 1024;
constexpr size_t OUT_PLAT = OUT_YS + (size_t)512 * 1024;
constexpr size_t OUT_PPE = OUT_PLAT + (size_t)4 * LTOK * 256;
constexpr size_t OUT_PGDN = OUT_PPE + (size_t)4 * LTOK * 32;
constexpr size_t OUT_PCONV = OUT_PGDN + (size_t)4 * 4 * 128 * 128;
constexpr size_t OUT_SLAT = OUT_PCONV + (size_t)4 * 3 * 1536;
constexpr size_t OUT_SPE = OUT_SLAT + (size_t)4 * 32 * 16 * 256;
constexpr size_t OUT_SGDN = OUT_SPE + (size_t)4 * 32 * 16 * 32;
constexpr size_t OUT_SCONV = OUT_SGDN + (size_t)4 * 32 * 4 * 128 * 128;

constexpr size_t al256(size_t x) { return (x + 255) & ~(size_t)255; }
constexpr size_t E_WT_IN = 0;
constexpr size_t E_WT_UQ = E_WT_IN + (size_t)2816 * 1024;
constexpr size_t E_WUQ_BF = E_WT_UQ + (size_t)768 * 384;
constexpr size_t E_WT_UKV = E_WUQ_BF + (size_t)384 * 768;
constexpr size_t E_WUK_BF = E_WT_UKV + (size_t)1024 * 256;
constexpr size_t E_WUV_BF = E_WUK_BF + (size_t)256 * 512;
constexpr size_t E_WABS = E_WUV_BF + (size_t)256 * 512;
constexpr size_t E_WT_O = E_WABS + (size_t)2048 * 384;
constexpr size_t E_WT_OS = E_WT_O + (size_t)1024 * 1024;
constexpr size_t E_WT_GU = E_WT_OS + (size_t)1024 * 2560;
constexpr size_t E_WT_DOWN = E_WT_GU + (size_t)5632 * 1024;
constexpr size_t E_WL = E_WT_DOWN + (size_t)1024 * 2816;

constexpr size_t O_CTR = 0;
constexpr size_t O_BAR = 1024;
constexpr size_t O_W = 16384;
constexpr size_t O_X = al256(O_W + 4 * E_WL * 2);
constexpr size_t O_XN = al256(O_X + (size_t)MTOT * 1024 * 4);
constexpr size_t O_PROJ = al256(O_XN + (size_t)MTOT * 1024 * 2);
constexpr size_t O_CQN = al256(O_PROJ + (size_t)MTOT * INP * 4);
constexpr size_t O_CKV = al256(O_CQN + (size_t)MTOT * 384 * 2);
constexpr size_t O_KPE = al256(O_CKV + (size_t)MTOT * 256 * 2);
constexpr size_t O_QF = al256(O_KPE + (size_t)MTOT * 32 * 2);
constexpr size_t O_QL = al256(O_QF + (size_t)MTOT * 768 * 2);
constexpr size_t O_KF = al256(O_QL + (size_t)512 * 2048 * 2);
constexpr size_t O_VV = al256(O_KF + (size_t)SOFF * 768 * 2);
constexpr size_t O_GQ = al256(O_VV + (size_t)SOFF * 512 * 2);
constexpr size_t O_GK = al256(O_GQ + (size_t)MTOT * 512 * 4);
constexpr size_t O_GV = al256(O_GK + (size_t)MTOT * 512 * 4);
constexpr size_t O_GB = al256(O_GV + (size_t)MTOT * 512 * 4);
constexpr size_t O_GG = al256(O_GB + (size_t)MTOT * 4 * 4);
constexpr size_t O_UT = al256(O_GG + (size_t)MTOT * 4 * 4);
constexpr size_t O_WN = al256(O_UT + (size_t)NITEM * 8192 * 4);
constexpr size_t O_QG = al256(O_WN + (size_t)NITEM * 8192 * 2);
constexpr size_t O_KDT = al256(O_QG + (size_t)NITEM * 8192 * 2);
constexpr size_t O_QKM = al256(O_KDT + (size_t)NITEM * 8192 * 2);
constexpr size_t O_GL = al256(O_QKM + (size_t)NITEM * 4096 * 2);
constexpr size_t O_OG = al256(O_GL + (size_t)NITEM * 4);
constexpr size_t O_MIX = al256(O_OG + (size_t)MTOT * 512 * 4);
constexpr size_t O_MIXS = al256(O_MIX + (size_t)MTOT * 1024 * 2);
constexpr size_t O_PO = al256(O_MIXS + (size_t)512 * 2560 * 2);
constexpr size_t O_PML = al256(O_PO + (size_t)32 * 8 * 128 * 256 * 4);
constexpr size_t O_OMIX = al256(O_PML + (size_t)32 * 8 * 128 * 2 * 4);
constexpr size_t O_ACT = al256(O_OMIX + (size_t)MTOT * 1024 * 4);
constexpr size_t O_X2 = al256(O_ACT + (size_t)MTOT * DFF * 2);
constexpr size_t O_AN = al256(O_X2 + (size_t)MTOT * 1024 * 4);
constexpr size_t O_BN = al256(O_AN + (size_t)NITEM * 16384 * 2);
constexpr size_t O_SPK = al256(O_BN + (size_t)NITEM * 16384 * 4);
constexpr size_t O_END = al256(O_SPK + (size_t)NITEM * 32768);

struct Params {
  const float *x_prompt, *x_sample, *cache_lat, *cache_pe, *state_gdn, *state_conv, *meta, *pre_mix, *w_in, *q_norm,
      *kv_norm, *w_uq, *w_uk, *w_uv, *conv_w, *a_log, *dt_bias, *gdn_norm, *w_o, *post_mix, *pre_ffn, *w_gate, *w_up,
      *w_down, *post_ffn;
  float* out;
  char* ws;
};

DI unsigned pk2(float a, float b) { f32x2v f = {a, b}; bf16x2v r = __builtin_convertvector(f, bf16x2v); return __builtin_bit_cast(unsigned, r); }
DI ushort_t f2bf(float x) { return (ushort_t)(pk2(x, 0.f) & 0xffffu); }
DI float bf2f(ushort_t u) { return __uint_as_float(((unsigned)u) << 16); }
DI int crow(int reg, int h) { return (reg & 3) + 8 * (reg >> 2) + 4 * h; }
DI f32x16 zero16() { f32x16 z;
#pragma unroll
  for (int i = 0; i < 16; ++i) z[i] = 0.f; return z; }
template <int S> DI bf16x8 pack8(const f32x16& x) {
  u32x4 p;
  p[0] = pk2(x[8 * S + 0], x[8 * S + 1]); p[1] = pk2(x[8 * S + 2], x[8 * S + 3]);
  p[2] = pk2(x[8 * S + 4], x[8 * S + 5]); p[3] = pk2(x[8 * S + 6], x[8 * S + 7]);
  return __builtin_bit_cast(bf16x8, p);
}
DI float wave_sum(float v) {
#pragma unroll
  for (int d = 32; d >= 1; d >>= 1) v += __shfl_xor(v, d, 64);
  return v;
}
DI float swap_max(float m) { auto rr = __builtin_amdgcn_permlane32_swap(__float_as_uint(m), __float_as_uint(m), false, false); return fmaxf(__uint_as_float(rr[0]), __uint_as_float(rr[1])); }
DI float swap_sum(float m) { auto rr = __builtin_amdgcn_permlane32_swap(__float_as_uint(m), __float_as_uint(m), false, false); return __uint_as_float(rr[0]) + __uint_as_float(rr[1]); }
typedef short v4i16_t __attribute__((ext_vector_type(4)));
DI s16x4 vtr(const ushort_t* p) { return __builtin_bit_cast(s16x4, __builtin_amdgcn_ds_read_tr16_b64_v4i16((__attribute__((address_space(3))) v4i16_t*)p)); }
DI bf16x8 cat8(s16x4 lo, s16x4 hi) { return __builtin_shufflevector(lo, hi, 0, 1, 2, 3, 4, 5, 6, 7); }
DI bf16x8 fragP(const ushort_t* base, int h) { s16x4 lo = *(const s16x4*)(base + 4 * h); s16x4 hi = *(const s16x4*)(base + 8 + 4 * h); return cat8(lo, hi); }
DI unsigned xcc_id_early() { return (unsigned)__builtin_amdgcn_s_getreg((3 << 11) | 20) & 0xFu; }
DI int get_tid() { int t = threadIdx.x; asm volatile("" : "+v"(t)); return t; }
DI float siluf(float x) { return x * __builtin_amdgcn_rcpf(1.f + __expf(-x)); }
DI float row_pos(int row) { return row < SOFF ? (float)(row - POFF) : (float)(16 + PAST + ((row - SOFF) & 15)); }
DI bool row_valid(int row) { return row >= SOFF || (row >= POFF && row < PEND); }
DI float rope_inv(int j) { return exp2f(-(float)j * (13.287712379549449f / 16.f)); }

constexpr int GP = 72;
template <class Epi>
DI void gemm_tile(const ushort_t* __restrict__ A, int lda, const ushort_t* __restrict__ Wt, int ldb, int K, int m0, int n0,
                  char* smem, Epi epi) {
  ushort_t* L0 = (ushort_t*)smem;
  ushort_t* L1 = L0 + 256 * GP;
  const int tid = get_tid(), lane = tid & 63, wave = tid >> 6, r = lane & 31, h = lane >> 5;
  const int wm = wave >> 1, wn = wave & 1;
  const int lrow = tid >> 3, lcol = (tid & 7) * 8;
  const ushort_t* Ag = A + (size_t)(m0 + lrow) * lda + lcol;
  const ushort_t* Bg = Wt + (size_t)(n0 + lrow) * ldb + lcol;
  const size_t a32 = (size_t)32 * lda, b32 = (size_t)32 * ldb;
  u32x4 pa0, pa1, pa2, pa3, pb0, pb1, pb2, pb3;
  u32x4 qa0, qa1, qa2, qa3, qb0, qb1, qb2, qb3;
#define G_LOAD0(kk) { pa0 = *(const u32x4*)(Ag + (kk)); pa1 = *(const u32x4*)(Ag + a32 + (kk)); pa2 = *(const u32x4*)(Ag + 2 * a32 + (kk)); pa3 = *(const u32x4*)(Ag + 3 * a32 + (kk)); \
                      pb0 = *(const u32x4*)(Bg + (kk)); pb1 = *(const u32x4*)(Bg + b32 + (kk)); pb2 = *(const u32x4*)(Bg + 2 * b32 + (kk)); pb3 = *(const u32x4*)(Bg + 3 * b32 + (kk)); }
#define G_LOAD1(kk) { qa0 = *(const u32x4*)(Ag + (kk)); qa1 = *(const u32x4*)(Ag + a32 + (kk)); qa2 = *(const u32x4*)(Ag + 2 * a32 + (kk)); qa3 = *(const u32x4*)(Ag + 3 * a32 + (kk)); \
                      qb0 = *(const u32x4*)(Bg + (kk)); qb1 = *(const u32x4*)(Bg + b32 + (kk)); qb2 = *(const u32x4*)(Bg + 2 * b32 + (kk)); qb3 = *(const u32x4*)(Bg + 3 * b32 + (kk)); }
#define L_STORE0(L) { ushort_t* la = (L) + lrow * GP + lcol; ushort_t* lb = la + 128 * GP; \
                      *(u32x4*)(la) = pa0; *(u32x4*)(la + 32 * GP) = pa1; *(u32x4*)(la + 64 * GP) = pa2; *(u32x4*)(la + 96 * GP) = pa3; \
                      *(u32x4*)(lb) = pb0; *(u32x4*)(lb + 32 * GP) = pb1; *(u32x4*)(lb + 64 * GP) = pb2; *(u32x4*)(lb + 96 * GP) = pb3; }
#define L_STORE1(L) { ushort_t* la = (L) + lrow * GP + lcol; ushort_t* lb = la + 128 * GP; \
                      *(u32x4*)(la) = qa0; *(u32x4*)(la + 32 * GP) = qa1; *(u32x4*)(la + 64 * GP) = qa2; *(u32x4*)(la + 96 * GP) = qa3; \
                      *(u32x4*)(lb) = qb0; *(u32x4*)(lb + 32 * GP) = qb1; *(u32x4*)(lb + 64 * GP) = qb2; *(u32x4*)(lb + 96 * GP) = qb3; }
#define G_COMPUTE(L) { const ushort_t* As = (L); const ushort_t* Bs = (L) + 128 * GP; \
    _Pragma("unroll") for (int ks = 0; ks < 4; ++ks) { \
      const bf16x8 af0 = *(const bf16x8*)(As + (64 * wm + r) * GP + ks * 16 + h * 8); \
      const bf16x8 af1 = *(const bf16x8*)(As + (64 * wm + 32 + r) * GP + ks * 16 + h * 8); \
      const bf16x8 bf0 = *(const bf16x8*)(Bs + (64 * wn + r) * GP + ks * 16 + h * 8); \
      const bf16x8 bf1 = *(const bf16x8*)(Bs + (64 * wn + 32 + r) * GP + ks * 16 + h * 8); \
      acc00 = MFMA(bf0, af0, acc00); acc01 = MFMA(bf1, af0, acc01); acc10 = MFMA(bf0, af1, acc10); acc11 = MFMA(bf1, af1, acc11); } }
  f32x16 acc00 = zero16(), acc01 = zero16(), acc10 = zero16(), acc11 = zero16();
  __syncthreads();
  if (K == 64) {
    G_LOAD0(0);
    L_STORE0(L0);
    __syncthreads();
    G_COMPUTE(L0);
    __syncthreads();
  } else {
    const int klast = K - 64;
    G_LOAD0(0);
    G_LOAD1(64);
    L_STORE0(L0);
    G_LOAD0(min(128, klast));
    __syncthreads();
    for (int k0 = 0; k0 < K; k0 += 128) {
      G_COMPUTE(L0);
      L_STORE1(L1);
      G_LOAD1(min(k0 + 192, klast));
      __syncthreads();
      G_COMPUTE(L1);
      L_STORE0(L0);
      G_LOAD0(min(k0 + 256, klast));
      __syncthreads();
    }
  }
#undef G_LOAD0
#undef G_LOAD1
#undef L_STORE0
#undef L_STORE1
#undef G_COMPUTE
  epi(m0 + 64 * wm + r, n0 + 64 * wn, acc00, acc01, h);
  epi(m0 + 64 * wm + 32 + r, n0 + 64 * wn, acc10, acc11, h);
}

template <class Epi>
DI void gemm_tile_w(const ushort_t* __restrict__ A, int lda, const ushort_t* __restrict__ Wt, int ldb, int K, int m0, int n0,
                    char* smem, Epi epi) {
  ushort_t* As = (ushort_t*)smem;
  ushort_t* Bs = As + 128 * GP;
  const int tid = get_tid(), lane = tid & 63, wave = tid >> 6, r = lane & 31, h = lane >> 5;
  const int wm = wave >> 1, wn = wave & 1;
  const int lrow = tid >> 3, lcol = (tid & 7) * 8;
  const ushort_t* Ag = A + (size_t)(m0 + lrow) * lda + lcol;
  const ushort_t* Bg = Wt + (size_t)(n0 + lrow) * ldb + lcol;
  const size_t a32 = (size_t)32 * lda, b32 = (size_t)32 * ldb;
  u32x4 ra[4], rb[8];
#pragma unroll
  for (int i = 0; i < 4; ++i) ra[i] = *(const u32x4*)(Ag + i * a32);
#pragma unroll
  for (int i = 0; i < 8; ++i) rb[i] = *(const u32x4*)(Bg + i * b32);
  f32x16 acc[2][4];
#pragma unroll
  for (int mi = 0; mi < 2; ++mi)
#pragma unroll
    for (int ni = 0; ni < 4; ++ni) acc[mi][ni] = zero16();
  for (int k0 = 0; k0 < K; k0 += 64) {
    __syncthreads();
#pragma unroll
    for (int i = 0; i < 4; ++i) *(u32x4*)(As + (lrow + 32 * i) * GP + lcol) = ra[i];
#pragma unroll
    for (int i = 0; i < 8; ++i) *(u32x4*)(Bs + (lrow + 32 * i) * GP + lcol) = rb[i];
    __syncthreads();
    if (k0 + 64 < K) {
#pragma unroll
      for (int i = 0; i < 4; ++i) ra[i] = *(const u32x4*)(Ag + i * a32 + k0 + 64);
#pragma unroll
      for (int i = 0; i < 8; ++i) rb[i] = *(const u32x4*)(Bg + i * b32 + k0 + 64);
    }
#pragma unroll
    for (int ks = 0; ks < 4; ++ks) {
      bf16x8 af[2], bfv[4];
#pragma unroll
      for (int mi = 0; mi < 2; ++mi) af[mi] = *(const bf16x8*)(As + (64 * wm + 32 * mi + r) * GP + ks * 16 + h * 8);
#pragma unroll
      for (int ni = 0; ni < 4; ++ni) bfv[ni] = *(const bf16x8*)(Bs + (128 * wn + 32 * ni + r) * GP + ks * 16 + h * 8);
#pragma unroll
      for (int mi = 0; mi < 2; ++mi)
#pragma unroll
        for (int ni = 0; ni < 4; ++ni) acc[mi][ni] = MFMA(bfv[ni], af[mi], acc[mi][ni]);
    }
  }
#pragma unroll
  for (int mi = 0; mi < 2; ++mi) {
    epi(m0 + 64 * wm + 32 * mi + r, n0 + 128 * wn, acc[mi][0], acc[mi][1], h);
    epi(m0 + 64 * wm + 32 * mi + r, n0 + 128 * wn + 64, acc[mi][2], acc[mi][3], h);
  }
}

struct EpiF32 {
  float* C; int ldc;
  DI void operator()(int m, int nb, const f32x16& a0, const f32x16& a1, int h) const {
#pragma unroll
    for (int g = 0; g < 4; ++g) {
      *(float4*)(C + (size_t)m * ldc + nb + 8 * g + 4 * h) = make_float4(a0[4 * g], a0[4 * g + 1], a0[4 * g + 2], a0[4 * g + 3]);
      *(float4*)(C + (size_t)m * ldc + nb + 32 + 8 * g + 4 * h) = make_float4(a1[4 * g], a1[4 * g + 1], a1[4 * g + 2], a1[4 * g + 3]);
    }
  }
};
struct EpiBF16 {
  ushort_t* C; int ldc; float scale;
  DI void operator()(int m, int nb, const f32x16& a0, const f32x16& a1, int h) const {
#pragma unroll
    for (int g = 0; g < 4; ++g) {
      *(uint2*)(C + (size_t)m * ldc + nb + 8 * g + 4 * h) = make_uint2(pk2(a0[4 * g] * scale, a0[4 * g + 1] * scale), pk2(a0[4 * g + 2] * scale, a0[4 * g + 3] * scale));
      *(uint2*)(C + (size_t)m * ldc + nb + 32 + 8 * g + 4 * h) = make_uint2(pk2(a1[4 * g] * scale, a1[4 * g + 1] * scale), pk2(a1[4 * g + 2] * scale, a1[4 * g + 3] * scale));
    }
  }
};
struct EpiQ {
  ushort_t* QF;
  DI void one(int m, int nb, f32x16 a, int h) const {
    if ((nb % 96) == 64) {
      const float pos = row_pos(m);
#pragma unroll
      for (int i = 0; i < 8; ++i) {
        const int j = crow(i, h);
        float sn, cs; sincosf(pos * rope_inv(j), &sn, &cs);
        const float x1 = a[i], x2 = a[i + 8];
        a[i] = x1 * cs - x2 * sn; a[i + 8] = x1 * sn + x2 * cs;
      }
    }
#pragma unroll
    for (int g = 0; g < 4; ++g)
      *(uint2*)(QF + (size_t)m * 768 + nb + 8 * g + 4 * h) = make_uint2(pk2(a[4 * g] * QSCALE, a[4 * g + 1] * QSCALE), pk2(a[4 * g + 2] * QSCALE, a[4 * g + 3] * QSCALE));
  }
  DI void operator()(int m, int nb, const f32x16& a0, const f32x16& a1, int h) const { one(m, nb, a0, h); one(m, nb + 32, a1, h); }
};
struct EpiKV {
  ushort_t* KF; ushort_t* VV;
  DI void one(int m, int nb, const f32x16& a, int h) const {
#pragma unroll
    for (int g = 0; g < 4; ++g) {
      const int n = nb + 8 * g + 4 * h;
      uint2 v = make_uint2(pk2(a[4 * g], a[4 * g + 1]), pk2(a[4 * g + 2], a[4 * g + 3]));
      if (n < 512) *(uint2*)(KF + (size_t)m * 768 + (n >> 6) * 96 + (n & 63)) = v;
      else *(uint2*)(VV + (size_t)m * 512 + (n - 512)) = v;
    }
  }
  DI void operator()(int m, int nb, const f32x16& a0, const f32x16& a1, int h) const { one(m, nb, a0, h); one(m, nb + 32, a1, h); }
};
struct EpiSwiGLU {
  ushort_t* ACT;
  DI void operator()(int m, int nb, const f32x16& a0, const f32x16& a1, int h) const {
    const int cb = nb >> 1;
#pragma unroll
    for (int g = 0; g < 4; ++g) {
      float v0 = siluf(a0[4 * g]) * a1[4 * g], v1 = siluf(a0[4 * g + 1]) * a1[4 * g + 1];
      float v2 = siluf(a0[4 * g + 2]) * a1[4 * g + 2], v3 = siluf(a0[4 * g + 3]) * a1[4 * g + 3];
      *(uint2*)(ACT + (size_t)m * DFF + cb + 8 * g + 4 * h) = make_uint2(pk2(v0, v1), pk2(v2, v3));
    }
  }
};

DI void tconv_tile(const float* __restrict__ src, int K, int N, ushort_t* dst, int ldd, int mode, ushort_t* dst2, int kt, int nt, char* smem) {
  float* tile = (float*)smem;
  const int tid = get_tid();
  const int k0 = kt * 64, n0 = nt * 64;
  __syncthreads();
#pragma unroll
  for (int it = 0; it < 16; ++it) {
    int k = it * 4 + (tid >> 6), n = tid & 63;
    float v = (n0 + n < N) ? src[(size_t)(k0 + k) * N + n0 + n] : 0.f;
    tile[k * 65 + n] = v;
  }
  __syncthreads();
#pragma unroll
  for (int it = 0; it < 16; ++it) {
    int n = it * 4 + (tid >> 6), k = tid & 63;
    int gn = n0 + n;
    int row = gn;
    if (mode == 1) row = (gn >> 5) * 64 + (gn & 31);
    else if (mode == 2) row = (gn >> 5) * 64 + 32 + (gn & 31);
    ushort_t v = f2bf(tile[k * 65 + n]);
    dst[(size_t)row * ldd + k0 + k] = v;
    if (mode == 3 && k0 >= 512) dst2[(size_t)gn * 2560 + 2048 + (k0 - 512) + k] = v;
  }
}

DI void norm_store_row(const float (&v)[16], float* Xrow, ushort_t* XNrow, const float* w, int lane, bool valid) {
  float ss = 0.f;
#pragma unroll
  for (int i = 0; i < 16; ++i) ss += v[i] * v[i];
  ss = wave_sum(ss);
  const float rstd = rsqrtf(ss * (1.f / 1024.f) + EPS);
#pragma unroll
  for (int j = 0; j < 4; ++j) {
    const int c = 4 * lane + 256 * j;
    float4 wv = *(const float4*)(w + c);
    float o0 = valid ? v[4 * j] : 0.f, o1 = valid ? v[4 * j + 1] : 0.f, o2 = valid ? v[4 * j + 2] : 0.f, o3 = valid ? v[4 * j + 3] : 0.f;
    if (Xrow) *(float4*)(Xrow + c) = make_float4(o0, o1, o2, o3);
    *(uint2*)(XNrow + c) = make_uint2(pk2(o0 * rstd * wv.x, o1 * rstd * wv.y), pk2(o2 * rstd * wv.z, o3 * rstd * wv.w));
  }
}

DI void phase_prep0(const Params& P, char* smem) {
  ushort_t* W = (ushort_t*)(P.ws + O_W);
  const int tid = get_tid();
  if (blockIdx.x == 0 && tid < 64) ((int*)(P.ws + O_CTR))[tid] = 0;
  constexpr int T_IN = 704, T_UQ = 72, T_UK = 32, T_UV = 32, T_O = 256, T_G = 704, T_U = 704, T_D = 704;
  constexpr int TL = T_IN + T_UQ + T_UK + T_UV + T_O + T_G + T_U + T_D;
  for (int t = blockIdx.x; t < TL * 4; t += gridDim.x) {
    const int l = t / TL; int rm = t % TL;
    ushort_t* Wl = W + (size_t)l * E_WL;
    if (rm < T_IN) { tconv_tile(P.w_in + (size_t)l * 1024 * INW, 1024, INW, Wl + E_WT_IN, 1024, 0, nullptr, rm / 44, rm % 44, smem); continue; }
    rm -= T_IN;
    if (rm < T_UQ) { tconv_tile(P.w_uq + (size_t)l * 384 * 768, 384, 768, Wl + E_WT_UQ, 384, 0, nullptr, rm / 12, rm % 12, smem); continue; }
    rm -= T_UQ;
    if (rm < T_UK) { tconv_tile(P.w_uk + (size_t)l * 256 * 512, 256, 512, Wl + E_WT_UKV, 256, 0, nullptr, rm / 8, rm % 8, smem); continue; }
    rm -= T_UK;
    if (rm < T_UV) { tconv_tile(P.w_uv + (size_t)l * 256 * 512, 256, 512, Wl + E_WT_UKV + (size_t)512 * 256, 256, 0, nullptr, rm / 8, rm % 8, smem); continue; }
    rm -= T_UV;
    if (rm < T_O) { tconv_tile(P.w_o + (size_t)l * 1024 * 1024, 1024, 1024, Wl + E_WT_O, 1024, 3, Wl + E_WT_OS, rm / 16, rm % 16, smem); continue; }
    rm -= T_O;
    if (rm < T_G) { tconv_tile(P.w_gate + (size_t)l * 1024 * DFF, 1024, DFF, Wl + E_WT_GU, 1024, 1, nullptr, rm / 44, rm % 44, smem); continue; }
    rm -= T_G;
    if (rm < T_U) { tconv_tile(P.w_up + (size_t)l * 1024 * DFF, 1024, DFF, Wl + E_WT_GU, 1024, 2, nullptr, rm / 44, rm % 44, smem); continue; }
    rm -= T_U;
    tconv_tile(P.w_down + (size_t)l * DFF * 1024, DFF, 1024, Wl + E_WT_DOWN, DFF, 0, nullptr, rm / 16, rm % 16, smem);
  }
  const int gt = blockIdx.x * 256 + tid, gs = gridDim.x * 256;
  for (int l = 0; l < 4; ++l) {
    ushort_t* Wl = W + (size_t)l * E_WL;
    for (int i = gt; i < 384 * 768; i += gs) Wl[E_WUQ_BF + i] = f2bf(P.w_uq[(size_t)l * 384 * 768 + i]);
    for (int i = gt; i < 256 * 512; i += gs) { Wl[E_WUK_BF + i] = f2bf(P.w_uk[(size_t)l * 256 * 512 + i]); Wl[E_WUV_BF + i] = f2bf(P.w_uv[(size_t)l * 256 * 512 + i]); }
  }
  float* X = (float*)(P.ws + O_X);
  ushort_t* XN = (ushort_t*)(P.ws + O_XN);
  const int lane = tid & 63, gw = blockIdx.x * 4 + (tid >> 6), nw = gridDim.x * 4;
  for (int row = gw; row < MTOT; row += nw) {
    const bool valid = row_valid(row);
    const float* src = nullptr;
    if (valid) {
      if (row >= SOFF) src = P.x_sample + (size_t)(row - SOFF) * 1024;
      else if (row < POFF + 16) src = P.meta + (size_t)(row - POFF) * 1024;
      else src = P.x_prompt + (size_t)(row - POFF - 16) * 1024;
    }
    float v[16];
#pragma unroll
    for (int j = 0; j < 4; ++j) {
      float4 t = valid ? *(const float4*)(src + 4 * lane + 256 * j) : make_float4(0.f, 0.f, 0.f, 0.f);
      v[4 * j] = t.x; v[4 * j + 1] = t.y; v[4 * j + 2] = t.z; v[4 * j + 3] = t.w;
    }
    norm_store_row(v, X + (size_t)row * 1024, XN + (size_t)row * 1024, P.pre_mix, lane, valid);
  }
}

DI void phase_prep1(const Params& P, char* smem) {
  ushort_t* W = (ushort_t*)(P.ws + O_W);
  for (int t = blockIdx.x; t < 4 * 176; t += gridDim.x) {
    const int l = t / 176; int rm = t % 176;
    ushort_t* Wl = W + (size_t)l * E_WL;
    if (rm < 48) {
      const int hd = rm / 6, mt = (rm % 6) / 3, nt = rm % 3;
      gemm_tile(Wl + E_WUK_BF + hd * 64, 512, Wl + E_WUQ_BF + hd * 96, 768, 64, mt * 128, nt * 128, smem,
                EpiBF16{Wl + E_WABS + (size_t)hd * 256 * 384, 384, 1.f});
    } else {
      rm -= 48;
      const int hd = rm / 16, mt = (rm % 16) / 2, nt = rm % 2;
      gemm_tile(Wl + E_WT_O + hd * 64, 1024, Wl + E_WUV_BF + hd * 64, 512, 64, mt * 128, nt * 128, smem,
                EpiBF16{Wl + E_WT_OS + hd * 256, 2560, 1.f});
    }
  }
}

DI float bflo(unsigned u) { return __uint_as_float(u << 16); }
DI float bfhi(unsigned u) { return __uint_as_float(u & 0xffff0000u); }
DI unsigned ld32(const ushort_t* p) { return *(const unsigned*)p; }
DI void phase_rowpass(const Params& P, int l) {
  const ushort_t* __restrict__ PROJ = (const ushort_t*)(P.ws + O_PROJ);
  ushort_t* CQN = (ushort_t*)(P.ws + O_CQN); ushort_t* CKV = (ushort_t*)(P.ws + O_CKV); ushort_t* KPE = (ushort_t*)(P.ws + O_KPE);
  ushort_t* KF = (ushort_t*)(P.ws + O_KF);
  float* GQ = (float*)(P.ws + O_GQ); float* GK = (float*)(P.ws + O_GK); float* GV = (float*)(P.ws + O_GV);
  float* GB = (float*)(P.ws + O_GB); float* GG = (float*)(P.ws + O_GG);
  const int tid = get_tid(), lane = tid & 63, gw = blockIdx.x * 4 + (tid >> 6), nw = gridDim.x * 4;
  const float* cw = P.conv_w + (size_t)l * 4 * 1536;
  float2 w[12][4];
#pragma unroll
  for (int s = 0; s < 12; ++s)
#pragma unroll
    for (int k = 0; k < 4; ++k) w[s][k] = *(const float2*)(cw + k * 1536 + 128 * s + 2 * lane);
  float2 qn[3], kn[2];
#pragma unroll
  for (int j = 0; j < 3; ++j) qn[j] = *(const float2*)(P.q_norm + l * 384 + 2 * lane + 128 * j);
#pragma unroll
  for (int j = 0; j < 2; ++j) kn[j] = *(const float2*)(P.kv_norm + l * 256 + 2 * lane + 128 * j);
  for (int row = gw; row < MTOT; row += nw) {
    const ushort_t* pr = PROJ + (size_t)row * INP;
    const bool isP = row < SOFF, valid = row_valid(row);
    const int tok = row - POFF, sb = (row - SOFF) >> 4, st = (row - SOFF) & 15;
    const float pos = row_pos(row);
    unsigned t0[12], t1[12], t2[12], t3[12];
    if (valid) {
      const ushort_t* px = pr + OFF_QKV + 2 * lane;
#pragma unroll
      for (int s = 0; s < 12; ++s) t0[s] = ld32(px + 128 * s);
      if (isP) {
#pragma unroll
        for (int s = 0; s < 12; ++s) { t1[s] = ld32(px - INP + 128 * s); t2[s] = ld32(px - 2 * INP + 128 * s); t3[s] = ld32(px - 3 * INP + 128 * s); }
      } else {
        const float* cs = P.state_conv + ((size_t)l * 32 + sb) * 3 * 1536 + 2 * lane;
#pragma unroll
        for (int s = 0; s < 12; ++s) {
          if (st >= 1) t1[s] = ld32(px - INP + 128 * s); else { const float2 f = *(const float2*)(cs + (size_t)(2 + st) * 1536 + 128 * s); t1[s] = pk2(f.x, f.y); }
          if (st >= 2) t2[s] = ld32(px - 2 * INP + 128 * s); else { const float2 f = *(const float2*)(cs + (size_t)(1 + st) * 1536 + 128 * s); t2[s] = pk2(f.x, f.y); }
          if (st >= 3) t3[s] = ld32(px - 3 * INP + 128 * s); else { const float2 f = *(const float2*)(cs + (size_t)(st) * 1536 + 128 * s); t3[s] = pk2(f.x, f.y); }
        }
      }
    } else {
#pragma unroll
      for (int s = 0; s < 12; ++s) { t0[s] = 0u; t1[s] = 0u; t2[s] = 0u; t3[s] = 0u; }
    }
    unsigned cq[3], ck[2];
#pragma unroll
    for (int j = 0; j < 3; ++j) cq[j] = ld32(pr + 2 * lane + 128 * j);
#pragma unroll
    for (int j = 0; j < 2; ++j) ck[j] = ld32(pr + OFF_KV + 2 * lane + 128 * j);
    const float xr = bf2f(pr[OFF_PE + (lane & 31)]);
    const float bbv = bf2f(pr[OFF_B + (lane & 3)]), aav = bf2f(pr[OFF_A + (lane & 3)]);
    {
      float ss = 0.f;
#pragma unroll
      for (int j = 0; j < 3; ++j) { const float a = bflo(cq[j]), b = bfhi(cq[j]); ss += a * a + b * b; }
      ss = wave_sum(ss);
      const float rstd = rsqrtf(ss * (1.f / 384.f) + EPS);
#pragma unroll
      for (int j = 0; j < 3; ++j)
        *(unsigned*)(CQN + (size_t)row * 384 + 2 * lane + 128 * j) = pk2(bflo(cq[j]) * rstd * qn[j].x, bfhi(cq[j]) * rstd * qn[j].y);
    }
    {
      float ss = 0.f;
#pragma unroll
      for (int j = 0; j < 2; ++j) { const float a = bflo(ck[j]), b = bfhi(ck[j]); ss += a * a + b * b; }
      ss = wave_sum(ss);
      const float rstd = rsqrtf(ss * (1.f / 256.f) + EPS);
      float* olat = nullptr;
      if (valid) olat = isP ? P.out + OUT_PLAT + ((size_t)l * LTOK + tok) * 256 : P.out + OUT_SLAT + (((size_t)l * 32 + sb) * 16 + st) * 256;
#pragma unroll
      for (int j = 0; j < 2; ++j) {
        const float o0 = bflo(ck[j]) * rstd * kn[j].x, o1 = bfhi(ck[j]) * rstd * kn[j].y;
        *(unsigned*)(CKV + (size_t)row * 256 + 2 * lane + 128 * j) = pk2(o0, o1);
        if (valid) *(float2*)(olat + 2 * lane + 128 * j) = make_float2(o0, o1);
      }
    }
    {
      const float pt = __shfl_xor(xr, 16, 64);
      float sn, cs; sincosf(pos * rope_inv(lane & 15), &sn, &cs);
      const float o = ((lane & 31) < 16) ? (xr * cs - pt * sn) : (pt * sn + xr * cs);
      if (lane < 32) {
        const ushort_t ob = f2bf(o);
        KPE[(size_t)row * 32 + lane] = ob;
        if (valid) {
          if (isP) P.out[OUT_PPE + ((size_t)l * LTOK + tok) * 32 + lane] = o;
          else P.out[OUT_SPE + (((size_t)l * 32 + sb) * 16 + st) * 32 + lane] = o;
        }
        if (isP) {
#pragma unroll
          for (int hh = 0; hh < 8; ++hh) KF[(size_t)row * 768 + hh * 96 + 64 + lane] = ob;
        }
      }
    }
    {
      float* cso = nullptr;
      if (valid) {
        if (isP) { if (row >= PEND - 3) cso = P.out + OUT_PCONV + ((size_t)l * 3 + (row - (PEND - 3))) * 1536; }
        else if (st >= 13) cso = P.out + OUT_SCONV + (((size_t)l * 32 + sb) * 3 + (st - 13)) * 1536;
      }
#pragma unroll
      for (int s = 0; s < 12; ++s) {
        const float x0a = bflo(t0[s]), x0b = bfhi(t0[s]);
        if (cso) *(float2*)(cso + 128 * s + 2 * lane) = make_float2(x0a, x0b);
        const float ya = w[s][3].x * x0a + w[s][2].x * bflo(t1[s]) + w[s][1].x * bflo(t2[s]) + w[s][0].x * bflo(t3[s]);
        const float yb = w[s][3].y * x0b + w[s][2].y * bfhi(t1[s]) + w[s][1].y * bfhi(t2[s]) + w[s][0].y * bfhi(t3[s]);
        const float a = siluf(ya), b = siluf(yb);
        if (s < 8) {
          const float ss = wave_sum(a * a + b * b);
          float sc = rsqrtf(ss + EPS);
          if (s < 4) sc *= 0.08838834764831845f;
          float* dst = (s < 4 ? GQ : GK) + (size_t)row * 512 + (s & 3) * 128 + 2 * lane;
          *(float2*)dst = make_float2(a * sc, b * sc);
        } else {
          *(float2*)(GV + (size_t)row * 512 + (s - 8) * 128 + 2 * lane) = make_float2(a, b);
        }
      }
    }
    if (lane < 4) {
      float beta = 0.f, g = 0.f;
      if (valid) {
        const float aa = aav + P.dt_bias[l * 4 + lane];
        beta = 1.f / (1.f + expf(-bbv));
        const float sp = aa > 20.f ? aa : log1pf(expf(aa));
        g = -expf(P.a_log[l * 4 + lane]) * sp;
      }
      GB[(size_t)row * 4 + lane] = beta; GG[(size_t)row * 4 + lane] = g;
    }
  }
}

DI void gdn_prep(const Params& P, int item, char* smem) {
  const float* GQ = (const float*)(P.ws + O_GQ); const float* GK = (const float*)(P.ws + O_GK); const float* GV = (const float*)(P.ws + O_GV);
  const float* GB = (const float*)(P.ws + O_GB); const float* GG = (const float*)(P.ws + O_GG);
  float* UT = (float*)(P.ws + O_UT) + (size_t)item * 8192;
  ushort_t* WN = (ushort_t*)(P.ws + O_WN) + (size_t)item * 8192;
  ushort_t* QG = (ushort_t*)(P.ws + O_QG) + (size_t)item * 8192;
  ushort_t* AN = (ushort_t*)(P.ws + O_AN) + (size_t)item * 16384;
  float* BN = (float*)(P.ws + O_BN) + (size_t)item * 16384;
  ushort_t* WTs = (ushort_t*)smem;
  ushort_t* UTs = WTs + 128 * 72;
  ushort_t* KDTs = (ushort_t*)(smem + 53248);
  ushort_t* QKM = (ushort_t*)(P.ws + O_QKM) + (size_t)item * 4096;
  float* GL = (float*)(P.ws + O_GL);
  ushort_t* Ks = (ushort_t*)smem;
  ushort_t* Qs = Ks + 64 * 136;
  float* Ms = (float*)(smem + 34816);
  float* gcs = (float*)(smem + 52224);
  float* bts = gcs + 64;
  float* egs = bts + 64;
  const int tid = get_tid(), lane = tid & 63, wave = tid >> 6, r = lane & 31, h = lane >> 5;
  const int n = item >> 2, hd = item & 3, row0 = 64 * n;
  __syncthreads();
  if (wave == 0) {
    float x = GG[(size_t)(row0 + lane) * 4 + hd];
    const float bt = GB[(size_t)(row0 + lane) * 4 + hd];
#pragma unroll
    for (int d = 1; d < 64; d <<= 1) { float y = __shfl_up(x, d, 64); if (lane >= d) x += y; }
    gcs[lane] = x; bts[lane] = bt; egs[lane] = __expf(x);
    if (lane == 63) GL[item] = __expf(x);
  }
#pragma unroll
  for (int i = 0; i < 8; ++i) {
    const int idx = tid + 256 * i, row = idx >> 5, c4 = (idx & 31) * 4;
    const float4 kv = *(const float4*)(GK + (size_t)(row0 + row) * 512 + hd * 128 + c4);
    const float4 qv = *(const float4*)(GQ + (size_t)(row0 + row) * 512 + hd * 128 + c4);
    *(uint2*)(Ks + row * 136 + c4) = make_uint2(pk2(kv.x, kv.y), pk2(kv.z, kv.w));
    *(uint2*)(Qs + row * 136 + c4) = make_uint2(pk2(qv.x, qv.y), pk2(qv.z, qv.w));
  }
  __syncthreads();
  {
    const int bi = wave >> 1, bj = wave & 1;
    f32x16 kk = zero16(), qk = zero16();
#pragma unroll
    for (int s = 0; s < 8; ++s) {
      const bf16x8 bfr = *(const bf16x8*)(Ks + (32 * bj + r) * 136 + 16 * s + 8 * h);
      const bf16x8 ak = *(const bf16x8*)(Ks + (32 * bi + r) * 136 + 16 * s + 8 * h);
      const bf16x8 aq = *(const bf16x8*)(Qs + (32 * bi + r) * 136 + 16 * s + 8 * h);
      kk = MFMA(ak, bfr, kk); qk = MFMA(aq, bfr, qk);
    }
    const int j = 32 * bj + r;
    const float gcj = gcs[j];
#pragma unroll
    for (int rg = 0; rg < 16; ++rg) {
      const int i = 32 * bi + crow(rg, h);
      const float dec = (j <= i) ? __expf(gcs[i] - gcj) : 0.f;
      Ms[j * 68 + i] = (j < i) ? bts[i] * kk[rg] * dec : 0.f;
      QKM[i * 64 + j] = f2bf(qk[rg] * dec);
    }
  }
#pragma unroll
  for (int i = 0; i < 8; ++i) {
    const int idx = tid + 256 * i, row = idx >> 5, c4 = (idx & 31) * 4;
    const float4 qv = *(const float4*)(GQ + (size_t)(row0 + row) * 512 + hd * 128 + c4);
    const float e = egs[row];
    *(uint2*)(QG + row * 128 + c4) = make_uint2(pk2(qv.x * e, qv.y * e), pk2(qv.z * e, qv.w * e));
  }
  {
    const int dk = tid & 127, ch = tid >> 7;
    const float gl = gcs[63];
    unsigned pkd[16];
#pragma unroll
    for (int cc = 0; cc < 16; ++cc) {
      const int c0 = 32 * ch + 2 * cc;
      const float a = GK[(size_t)(row0 + c0) * 512 + hd * 128 + dk] * __expf(gl - gcs[c0]);
      const float b = GK[(size_t)(row0 + c0 + 1) * 512 + hd * 128 + dk] * __expf(gl - gcs[c0 + 1]);
      pkd[cc] = pk2(a, b);
    }
#pragma unroll
    for (int q4 = 0; q4 < 4; ++q4)
      *(uint4*)(KDTs + dk * 72 + 32 * ch + 8 * q4) = make_uint4(pkd[4 * q4], pkd[4 * q4 + 1], pkd[4 * q4 + 2], pkd[4 * q4 + 3]);
  }
  __syncthreads();
  {
    const int col = tid & 127;
    const bool isW = tid >= 128;
    float x[64];
    const float* rsrc = (isW ? GK : GV) + (size_t)row0 * 512 + hd * 128 + col;
#pragma unroll
    for (int c = 0; c < 64; ++c) x[c] = rsrc[(size_t)c * 512];
#pragma unroll
    for (int c = 0; c < 64; ++c) x[c] *= bts[c] * (isW ? egs[c] : 1.f);
#pragma unroll
    for (int j = 0; j < 63; ++j) {
      f32x4v mc[16];
#pragma unroll
      for (int q4 = ((j + 1) >> 2); q4 < 16; ++q4) mc[q4] = *(const f32x4v*)(Ms + j * 68 + 4 * q4);
      __builtin_amdgcn_sched_barrier(0);
      const float xj = x[j];
#pragma unroll
      for (int q4 = ((j + 1) >> 2); q4 < 16; ++q4) {
        const int i4 = 4 * q4;
        if (i4 + 0 > j) x[i4 + 0] -= mc[q4].x * xj;
        if (i4 + 1 > j) x[i4 + 1] -= mc[q4].y * xj;
        if (i4 + 2 > j) x[i4 + 2] -= mc[q4].z * xj;
        if (i4 + 3 > j) x[i4 + 3] -= mc[q4].w * xj;
      }
      __builtin_amdgcn_sched_barrier(0);
    }
    __syncthreads();
    if (!isW) {
#pragma unroll
      for (int c = 0; c < 64; c += 4) *(float4*)(UT + col * 64 + c) = make_float4(x[c], x[c + 1], x[c + 2], x[c + 3]);
#pragma unroll
      for (int c = 0; c < 64; c += 8)
        *(uint4*)(UTs + col * 72 + c) = make_uint4(pk2(x[c], x[c + 1]), pk2(x[c + 2], x[c + 3]), pk2(x[c + 4], x[c + 5]), pk2(x[c + 6], x[c + 7]));
    } else {
#pragma unroll
      for (int c = 0; c < 64; ++c) WN[c * 128 + col] = f2bf(-x[c]);
#pragma unroll
      for (int c = 0; c < 64; c += 8)
        *(uint4*)(WTs + col * 72 + c) = make_uint4(pk2(-x[c], -x[c + 1]), pk2(-x[c + 2], -x[c + 3]), pk2(-x[c + 4], -x[c + 5]), pk2(-x[c + 6], -x[c + 7]));
    }
  }
  __syncthreads();
  {
    const int bi = wave;
    const float gl = __expf(gcs[63]);
    bf16x8 kf[4];
#pragma unroll
    for (int sx = 0; sx < 4; ++sx) kf[sx] = *(const bf16x8*)(KDTs + (32 * bi + r) * 72 + 16 * sx + 8 * h);
#pragma unroll
    for (int bj = 0; bj < 4; ++bj) {
      f32x16 ab = zero16(), aa = zero16();
#pragma unroll
      for (int sx = 0; sx < 4; ++sx) {
        ab = MFMA(kf[sx], *(const bf16x8*)(UTs + (32 * bj + r) * 72 + 16 * sx + 8 * h), ab);
        aa = MFMA(*(const bf16x8*)(WTs + (32 * bj + r) * 72 + 16 * sx + 8 * h), kf[sx], aa);
      }
#pragma unroll
      for (int g = 0; g < 4; ++g) {
        *(float4*)(BN + (((bi * 4 + bj) * 4 + g) * 64 + lane) * 4) = make_float4(ab[4 * g], ab[4 * g + 1], ab[4 * g + 2], ab[4 * g + 3]);
        float a0 = aa[4 * g], a1 = aa[4 * g + 1], a2 = aa[4 * g + 2], a3 = aa[4 * g + 3];
        if (bi == bj) {
          const int jb = 8 * g + 4 * h;
          if (jb == r) a0 += gl;
          if (jb + 1 == r) a1 += gl;
          if (jb + 2 == r) a2 += gl;
          if (jb + 3 == r) a3 += gl;
        }
        *(uint2*)(AN + (32 * bi + r) * 128 + 32 * bj + 8 * g + 4 * h) = make_uint2(pk2(a0, a1), pk2(a2, a3));
      }
    }
  }
}

DI void gdn_sample(const Params& P, int l, int item, char* smem) {
  const float* GQ = (const float*)(P.ws + O_GQ); const float* GK = (const float*)(P.ws + O_GK); const float* GV = (const float*)(P.ws + O_GV);
  const float* GB = (const float*)(P.ws + O_GB); const float* GG = (const float*)(P.ws + O_GG);
  float* OG = (float*)(P.ws + O_OG);
  float* ks = (float*)smem;
  float* qs = ks + 2048;
  float* vs = qs + 2048;
  float* egb = vs + 2048;
  float* red = egb + 32;
  float* red2 = red + 256;
  const int tid = get_tid(), dv = tid & 127, half = tid >> 7;
  const int b = item >> 2, hd = item & 3, row0 = SOFF + 16 * b;
  __syncthreads();
#pragma unroll
  for (int i = 0; i < 8; ++i) {
    const int idx = tid + 256 * i, t = idx >> 7, c = idx & 127;
    ks[idx] = GK[(size_t)(row0 + t) * 512 + hd * 128 + c];
    qs[idx] = GQ[(size_t)(row0 + t) * 512 + hd * 128 + c];
    vs[idx] = GV[(size_t)(row0 + t) * 512 + hd * 128 + c];
  }
  if (tid < 16) { egb[2 * tid] = expf(GG[(size_t)(row0 + tid) * 4 + hd]); egb[2 * tid + 1] = GB[(size_t)(row0 + tid) * 4 + hd]; }
  const size_t sbase = ((((size_t)l * 32 + b) * 4 + hd) * 128 + 64 * half) * 128 + dv;
  float S[64];
#pragma unroll
  for (int i = 0; i < 64; ++i) S[i] = P.state_gdn[sbase + (size_t)i * 128];
  __syncthreads();
  for (int t = 0; t < 16; ++t) {
    const float eg = egb[2 * t], bt = egb[2 * t + 1];
    const f32x4v* kt4 = (const f32x4v*)(ks + t * 128 + 64 * half);
    const f32x4v* qt4 = (const f32x4v*)(qs + t * 128 + 64 * half);
    f32x4v kv[16];
#pragma unroll
    for (int i4 = 0; i4 < 16; ++i4) kv[i4] = kt4[i4];
    float a0 = 0.f, a1 = 0.f, a2 = 0.f, a3 = 0.f;
#pragma unroll
    for (int i4 = 0; i4 < 16; ++i4) {
      S[4 * i4] *= eg; S[4 * i4 + 1] *= eg; S[4 * i4 + 2] *= eg; S[4 * i4 + 3] *= eg;
      a0 += kv[i4].x * S[4 * i4]; a1 += kv[i4].y * S[4 * i4 + 1]; a2 += kv[i4].z * S[4 * i4 + 2]; a3 += kv[i4].w * S[4 * i4 + 3];
    }
    red[half * 128 + dv] = (a0 + a1) + (a2 + a3);
    __syncthreads();
    const float kS = red[dv] + red[128 + dv];
    const float d = bt * (vs[t * 128 + dv] - kS);
    float b0 = 0.f, b1 = 0.f, b2 = 0.f, b3 = 0.f;
#pragma unroll
    for (int i4 = 0; i4 < 16; ++i4) {
      const f32x4v qv = qt4[i4];
      S[4 * i4] += kv[i4].x * d; S[4 * i4 + 1] += kv[i4].y * d; S[4 * i4 + 2] += kv[i4].z * d; S[4 * i4 + 3] += kv[i4].w * d;
      b0 += qv.x * S[4 * i4]; b1 += qv.y * S[4 * i4 + 1]; b2 += qv.z * S[4 * i4 + 2]; b3 += qv.w * S[4 * i4 + 3];
    }
    red2[half * 128 + dv] = (b0 + b1) + (b2 + b3);
    __syncthreads();
    if (half == 0) OG[(size_t)(row0 + t) * 512 + hd * 128 + dv] = red2[dv] + red2[128 + dv];
  }
#pragma unroll
  for (int i = 0; i < 64; ++i) P.out[OUT_SGDN + sbase + (size_t)i * 128] = S[i];
}

DI void gdn_scan(const Params& P, int l, int item, char* smem) {
  const ushort_t* ANg = (const ushort_t*)(P.ws + O_AN);
  const float* BNg = (const float*)(P.ws + O_BN);
  u32x4* SPK = (u32x4*)(P.ws + O_SPK);
  ushort_t* ST = (ushort_t*)smem;
  const int tid = get_tid(), lane = tid & 63, b = tid >> 6, r = lane & 31, h = lane >> 5;
  const int hd = item >> 2, dvs = item & 3;
  __syncthreads();
  for (int i = tid; i < 32 * 136 / 2; i += 256) ((unsigned*)ST)[i] = 0u;
  {
    const u32x4 z = {0u, 0u, 0u, 0u};
    SPK[((((size_t)(0 * 4 + hd) * 4 + dvs) * 4 + b) * 2 + 0) * 64 + lane] = z;
    SPK[((((size_t)(0 * 4 + hd) * 4 + dvs) * 4 + b) * 2 + 1) * 64 + lane] = z;
  }
  bf16x8 Ac[8]; f32x16 Bc;
  {
    const int it = hd;
#pragma unroll
    for (int sx = 0; sx < 8; ++sx) Ac[sx] = *(const bf16x8*)(ANg + (size_t)it * 16384 + (32 * b + r) * 128 + 16 * sx + 8 * h);
#pragma unroll
    for (int g = 0; g < 4; ++g) {
      const float4 t = *(const float4*)(BNg + (size_t)it * 16384 + (((b * 4 + dvs) * 4 + g) * 64 + lane) * 4);
      Bc[4 * g] = t.x; Bc[4 * g + 1] = t.y; Bc[4 * g + 2] = t.z; Bc[4 * g + 3] = t.w;
    }
  }
  f32x16 acc = zero16();
  for (int n = 0; n < NCH; ++n) {
    const int cur = n & 1;
    bf16x8 An[8]; f32x16 Bn;
    {
      const int it = (n + 1 < NCH ? n + 1 : n) * 4 + hd;
#pragma unroll
      for (int sx = 0; sx < 8; ++sx) An[sx] = *(const bf16x8*)(ANg + (size_t)it * 16384 + (32 * b + r) * 128 + 16 * sx + 8 * h);
#pragma unroll
      for (int g = 0; g < 4; ++g) {
        const float4 t = *(const float4*)(BNg + (size_t)it * 16384 + (((b * 4 + dvs) * 4 + g) * 64 + lane) * 4);
        Bn[4 * g] = t.x; Bn[4 * g + 1] = t.y; Bn[4 * g + 2] = t.z; Bn[4 * g + 3] = t.w;
      }
    }
    __syncthreads();
    const ushort_t* Sc = ST + cur * (32 * 136);
    f32x16 a0 = Bc, a1 = zero16();
#pragma unroll
    for (int sx = 0; sx < 8; sx += 2) {
      a0 = MFMA(Ac[sx], *(const bf16x8*)(Sc + r * 136 + 16 * sx + 8 * h), a0);
      a1 = MFMA(Ac[sx + 1], *(const bf16x8*)(Sc + r * 136 + 16 * (sx + 1) + 8 * h), a1);
    }
#pragma unroll
    for (int i = 0; i < 16; ++i) acc[i] = a0[i] + a1[i];
    const u32x4 p0 = __builtin_bit_cast(u32x4, pack8<0>(acc));
    const u32x4 p1 = __builtin_bit_cast(u32x4, pack8<1>(acc));
    ushort_t* Sn = ST + (cur ^ 1) * (32 * 136) + r * 136 + 32 * b + 4 * h;
    *(uint2*)(Sn) = make_uint2(p0[0], p0[1]);
    *(uint2*)(Sn + 8) = make_uint2(p0[2], p0[3]);
    *(uint2*)(Sn + 16) = make_uint2(p1[0], p1[1]);
    *(uint2*)(Sn + 24) = make_uint2(p1[2], p1[3]);
    if (n + 1 < NCH) {
      SPK[((((size_t)((n + 1) * 4 + hd) * 4 + dvs) * 4 + b) * 2 + 0) * 64 + lane] = p0;
      SPK[((((size_t)((n + 1) * 4 + hd) * 4 + dvs) * 4 + b) * 2 + 1) * 64 + lane] = p1;
    }
#pragma unroll
    for (int sx = 0; sx < 8; ++sx) Ac[sx] = An[sx];
    Bc = Bn;
  }
#pragma unroll
  for (int i = 0; i < 16; ++i)
    P.out[OUT_PGDN + (((size_t)l * 4 + hd) * 128 + 32 * b + crow(i, h)) * 128 + 32 * dvs + r] = acc[i];
}

DI void gdn_out(const Params& P, int l, int item, char* smem) {
  const float* UTg = (const float*)(P.ws + O_UT);
  const ushort_t* WNg = (const ushort_t*)(P.ws + O_WN); const ushort_t* QGg = (const ushort_t*)(P.ws + O_QG);
  const ushort_t* QKMg = (const ushort_t*)(P.ws + O_QKM);
  const u32x4* SPK = (const u32x4*)(P.ws + O_SPK);
  const ushort_t* PROJ = (const ushort_t*)(P.ws + O_PROJ);
  ushort_t* MIX = (ushort_t*)(P.ws + O_MIX);
  ushort_t* WNs = (ushort_t*)smem;
  ushort_t* QGs = WNs + 64 * 136;
  ushort_t* QKs = QGs + 64 * 136;
  float* Os = (float*)smem;
  const int tid = get_tid(), lane = tid & 63, wave = tid >> 6, r = lane & 31, h = lane >> 5;
  const int n = item >> 2, hd = item & 3, dv0 = 32 * wave;
  __syncthreads();
  {
    const ushort_t* wsrc = WNg + (size_t)item * 8192; const ushort_t* qsrc = QGg + (size_t)item * 8192;
    const ushort_t* msrc = QKMg + (size_t)item * 4096;
#pragma unroll
    for (int i = 0; i < 4; ++i) {
      const int c = tid + 256 * i;
      *(u32x4*)(WNs + (c >> 4) * 136 + (c & 15) * 8) = *(const u32x4*)(wsrc + c * 8);
      *(u32x4*)(QGs + (c >> 4) * 136 + (c & 15) * 8) = *(const u32x4*)(qsrc + c * 8);
    }
#pragma unroll
    for (int i = 0; i < 2; ++i) {
      const int c = tid + 256 * i;
      *(u32x4*)(QKs + (c >> 3) * 72 + (c & 7) * 8) = *(const u32x4*)(msrc + c * 8);
    }
  }
  f32x16 vn[2];
#pragma unroll
  for (int cb = 0; cb < 2; ++cb)
#pragma unroll
    for (int g = 0; g < 4; ++g) {
      const float4 t = *(const float4*)(UTg + (size_t)item * 8192 + (dv0 + r) * 64 + 32 * cb + 8 * g + 4 * h);
      vn[cb][4 * g] = t.x; vn[cb][4 * g + 1] = t.y; vn[cb][4 * g + 2] = t.z; vn[cb][4 * g + 3] = t.w;
    }
  bf16x8 Sp[4][2];
#pragma unroll
  for (int b = 0; b < 4; ++b)
#pragma unroll
    for (int sx = 0; sx < 2; ++sx) Sp[b][sx] = __builtin_bit_cast(bf16x8, SPK[((((size_t)item * 4 + wave) * 4 + b) * 2 + sx) * 64 + lane]);
  __syncthreads();
#pragma unroll
  for (int cb = 0; cb < 2; ++cb)
#pragma unroll
    for (int b = 0; b < 4; ++b)
#pragma unroll
      for (int sx = 0; sx < 2; ++sx) vn[cb] = MFMA(fragP(WNs + (32 * cb + r) * 136 + 32 * b + 16 * sx, h), Sp[b][sx], vn[cb]);
  bf16x8 Vp[2][2];
  Vp[0][0] = pack8<0>(vn[0]); Vp[0][1] = pack8<1>(vn[0]); Vp[1][0] = pack8<0>(vn[1]); Vp[1][1] = pack8<1>(vn[1]);
  f32x16 o[2];
#pragma unroll
  for (int cb = 0; cb < 2; ++cb) {
    o[cb] = zero16();
#pragma unroll
    for (int b = 0; b < 4; ++b)
#pragma unroll
      for (int sx = 0; sx < 2; ++sx) o[cb] = MFMA(fragP(QGs + (32 * cb + r) * 136 + 32 * b + 16 * sx, h), Sp[b][sx], o[cb]);
#pragma unroll
    for (int cb2 = 0; cb2 <= cb; ++cb2)
#pragma unroll
      for (int sx = 0; sx < 2; ++sx) o[cb] = MFMA(fragP(QKs + (32 * cb + r) * 72 + 32 * cb2 + 16 * sx, h), Vp[cb2][sx], o[cb]);
  }
  __syncthreads();
#pragma unroll
  for (int cb = 0; cb < 2; ++cb)
#pragma unroll
    for (int i = 0; i < 16; ++i) Os[(32 * cb + crow(i, h)) * 132 + dv0 + r] = o[cb][i];
  __syncthreads();
  const float gw0 = P.gdn_norm[l * 128 + lane], gw1 = P.gdn_norm[l * 128 + 64 + lane];
#pragma unroll 4
  for (int rr = 0; rr < 16; ++rr) {
    const int c = 16 * wave + rr, row = 64 * n + c;
    const float o0 = Os[c * 132 + lane], o1 = Os[c * 132 + 64 + lane];
    const float z0 = bf2f(PROJ[(size_t)row * INP + OFF_Z + hd * 128 + lane]), z1 = bf2f(PROJ[(size_t)row * INP + OFF_Z + hd * 128 + 64 + lane]);
    const float ss = wave_sum(o0 * o0 + o1 * o1);
    const float rstd = rsqrtf(ss * (1.f / 128.f) + EPS);
    MIX[(size_t)row * 1024 + 512 + hd * 128 + lane] = f2bf(o0 * rstd * gw0 * siluf(z0));
    MIX[(size_t)row * 1024 + 512 + hd * 128 + 64 + lane] = f2bf(o1 * rstd * gw1 * siluf(z1));
  }
}

template <int NDB>
DI void softmax_pv(f32x16 (&st)[2], f32x16 (&o)[NDB], float& m, float& l, f32x16& negm, bool first, const ushort_t* Vs, int vpitch, int vcol0, int lane) {
  const int h = lane >> 5, i16 = lane & 15, q = i16 >> 2, p = i16 & 3, blk = (lane >> 4) & 1;
  const ushort_t* vb = Vs + (4 * h + q) * vpitch + vcol0 + 16 * blk + 4 * p;
  s16x4 vf[2][NDB][4];
#pragma unroll
  for (int kb = 0; kb < 2; ++kb)
#pragma unroll
    for (int db = 0; db < NDB; ++db)
#pragma unroll
      for (int j = 0; j < 4; ++j) vf[kb][db][j] = vtr(vb + (32 * kb + 8 * j) * vpitch + 32 * db);
  __builtin_amdgcn_sched_barrier(0);
  float mt = st[0][0];
#pragma unroll
  for (int kb = 0; kb < 2; ++kb)
#pragma unroll
    for (int i = 0; i < 16; ++i) mt = fmaxf(mt, st[kb][i]);
  mt = swap_max(mt);
  if (__builtin_amdgcn_ballot_w64(first || (mt > 8.f)) != 0ull) {
    const float d = first ? mt : fmaxf(mt, 0.f);
    const float alpha = first ? 1.f : __builtin_amdgcn_exp2f(-d);
    m += d;
    l *= alpha;
#pragma unroll
    for (int db = 0; db < NDB; ++db)
#pragma unroll
      for (int i = 0; i < 16; ++i) o[db][i] *= alpha;
#pragma unroll
    for (int kb = 0; kb < 2; ++kb)
#pragma unroll
      for (int i = 0; i < 16; ++i) st[kb][i] -= d;
    const float nm = -m;
#pragma unroll
    for (int i = 0; i < 16; ++i) negm[i] = nm;
  }
  float ls = 0.f;
#pragma unroll
  for (int kb = 0; kb < 2; ++kb)
#pragma unroll
    for (int i = 0; i < 16; ++i) { const float pv = __builtin_amdgcn_exp2f(st[kb][i]); st[kb][i] = pv; ls += pv; }
  l += ls;
  __builtin_amdgcn_s_setprio(1);
#pragma unroll
  for (int kb = 0; kb < 2; ++kb) {
    const bf16x8 p0 = pack8<0>(st[kb]);
    const bf16x8 p1 = pack8<1>(st[kb]);
#pragma unroll
    for (int db = 0; db < NDB; ++db) {
      o[db] = MFMA(cat8(vf[kb][db][0], vf[kb][db][1]), p0, o[db]);
      o[db] = MFMA(cat8(vf[kb][db][2], vf[kb][db][3]), p1, o[db]);
    }
  }
  __builtin_amdgcn_s_setprio(0);
}

template <int NDB>
DI void softmax_pv_simple(f32x16 (&st)[2], f32x16 (&o)[NDB], float& m, float& l, const ushort_t* Vs, int vpitch, int vcol0, int lane) {
  const int h = lane >> 5, i16 = lane & 15, q = i16 >> 2, p = i16 & 3, blk = (lane >> 4) & 1;
  float mt = st[0][0];
#pragma unroll
  for (int kb = 0; kb < 2; ++kb)
#pragma unroll
    for (int i = 0; i < 16; ++i) mt = fmaxf(mt, st[kb][i]);
  mt = swap_max(mt);
  const float mn = fmaxf(m, mt);
  const float alpha = __builtin_amdgcn_exp2f(m - mn);
  m = mn;
  float ls = 0.f;
#pragma unroll
  for (int kb = 0; kb < 2; ++kb)
#pragma unroll
    for (int i = 0; i < 16; ++i) { const float pv = __builtin_amdgcn_exp2f(st[kb][i] - mn); st[kb][i] = pv; ls += pv; }
  l = l * alpha + ls;
#pragma unroll
  for (int db = 0; db < NDB; ++db)
#pragma unroll
    for (int i = 0; i < 16; ++i) o[db][i] *= alpha;
  const ushort_t* vb = Vs + (4 * h + q) * vpitch + vcol0 + 16 * blk + 4 * p;
#pragma unroll
  for (int kb = 0; kb < 2; ++kb) {
    const bf16x8 p0 = pack8<0>(st[kb]);
    const bf16x8 p1 = pack8<1>(st[kb]);
#pragma unroll
    for (int db = 0; db < NDB; ++db) {
      const ushort_t* v0 = vb + (32 * kb) * vpitch + 32 * db;
      o[db] = MFMA(cat8(vtr(v0), vtr(v0 + 8 * vpitch)), p0, o[db]);
      o[db] = MFMA(cat8(vtr(v0 + 16 * vpitch), vtr(v0 + 24 * vpitch)), p1, o[db]);
    }
  }
}

DI void attn_prompt(const Params& P, int qt, int head, char* smem) {
  const ushort_t* QF = (const ushort_t*)(P.ws + O_QF); const ushort_t* KF = (const ushort_t*)(P.ws + O_KF);
  const ushort_t* VV = (const ushort_t*)(P.ws + O_VV); ushort_t* MIX = (ushort_t*)(P.ws + O_MIX);
  constexpr int KP = 104, VP = 72;
  ushort_t* Kb = (ushort_t*)smem;
  ushort_t* Vb = Kb + 2 * 64 * KP;
  const int tid = get_tid(), lane = tid & 63, wave = tid >> 6, r = lane & 31, h = lane >> 5;
  const int qrow = 128 * qt + 32 * wave + r;
  const int cq = 2 * qt + (wave >> 1);
  const int ntile = 2 * qt + 2;
  bf16x8 qf[6];
#pragma unroll
  for (int s = 0; s < 6; ++s) qf[s] = *(const bf16x8*)(QF + (size_t)qrow * 768 + head * 96 + 16 * s + 8 * h);
  f32x16 o[2]; o[0] = zero16(); o[1] = zero16();
  float m = 0.f, l = 0.f;
  f32x16 negm = zero16();
  u32x4 rk0, rk1, rk2, rv0, rv1;
  u32x4 sk0, sk1, sk2, sv0, sv1;
  const int kr0 = tid / 12, kc0 = tid % 12, kr1 = (tid + 256) / 12, kc1 = (tid + 256) % 12, kr2 = (tid + 512) / 12, kc2 = (tid + 512) % 12;
  const int vr0 = tid >> 3, vc0 = tid & 7, vr1 = (tid + 256) >> 3;
  const ushort_t* kg0 = KF + (size_t)kr0 * 768 + head * 96 + kc0 * 8;
  const ushort_t* kg1 = KF + (size_t)kr1 * 768 + head * 96 + kc1 * 8;
  const ushort_t* kg2 = KF + (size_t)kr2 * 768 + head * 96 + kc2 * 8;
  const ushort_t* vg0 = VV + (size_t)vr0 * 512 + head * 64 + vc0 * 8;
  const ushort_t* vg1 = VV + (size_t)vr1 * 512 + head * 64 + vc0 * 8;
#define ATT_GLOAD0(kt) { const size_t ko = (size_t)(kt) * 64 * 768, vo = (size_t)(kt) * 64 * 512; \
    rk0 = *(const u32x4*)(kg0 + ko); rk1 = *(const u32x4*)(kg1 + ko); rk2 = *(const u32x4*)(kg2 + ko); rv0 = *(const u32x4*)(vg0 + vo); rv1 = *(const u32x4*)(vg1 + vo); }
#define ATT_GLOAD1(kt) { const size_t ko = (size_t)(kt) * 64 * 768, vo = (size_t)(kt) * 64 * 512; \
    sk0 = *(const u32x4*)(kg0 + ko); sk1 = *(const u32x4*)(kg1 + ko); sk2 = *(const u32x4*)(kg2 + ko); sv0 = *(const u32x4*)(vg0 + vo); sv1 = *(const u32x4*)(vg1 + vo); }
#define ATT_LSTORE0(buf) { ushort_t* kd = Kb + (buf) * 64 * KP; ushort_t* vd = Vb + (buf) * 64 * VP; \
    *(u32x4*)(kd + kr0 * KP + kc0 * 8) = rk0; *(u32x4*)(kd + kr1 * KP + kc1 * 8) = rk1; *(u32x4*)(kd + kr2 * KP + kc2 * 8) = rk2; \
    *(u32x4*)(vd + vr0 * VP + vc0 * 8) = rv0; *(u32x4*)(vd + vr1 * VP + vc0 * 8) = rv1; }
#define ATT_LSTORE1(buf) { ushort_t* kd = Kb + (buf) * 64 * KP; ushort_t* vd = Vb + (buf) * 64 * VP; \
    *(u32x4*)(kd + kr0 * KP + kc0 * 8) = sk0; *(u32x4*)(kd + kr1 * KP + kc1 * 8) = sk1; *(u32x4*)(kd + kr2 * KP + kc2 * 8) = sk2; \
    *(u32x4*)(vd + vr0 * VP + vc0 * 8) = sv0; *(u32x4*)(vd + vr1 * VP + vc0 * 8) = sv1; }
#define ATT_COMPUTE(kt, buf) if ((kt) <= cq) { \
      const ushort_t* Ks = Kb + (buf) * 64 * KP; \
      f32x16 st[2]; st[0] = negm; st[1] = negm; \
      bf16x8 kf[12]; \
      _Pragma("unroll") for (int s = 0; s < 6; ++s) { \
        _Pragma("unroll") for (int kb = 0; kb < 2; ++kb) kf[2 * s + kb] = *(const bf16x8*)(Ks + (32 * kb + r) * KP + 16 * s + 8 * h); } \
      __builtin_amdgcn_sched_barrier(0); \
      __builtin_amdgcn_s_setprio(1); \
      _Pragma("unroll") for (int s = 0; s < 6; ++s) { \
        _Pragma("unroll") for (int kb = 0; kb < 2; ++kb) st[kb] = MFMA(kf[2 * s + kb], qf[s], st[kb]); } \
      __builtin_amdgcn_s_setprio(0); \
      if ((kt) == 0) { \
        _Pragma("unroll") for (int kb = 0; kb < 2; ++kb) \
          _Pragma("unroll") for (int i = 0; i < 16; ++i) if (32 * kb + crow(i, h) < POFF) st[kb][i] = -1e30f; } \
      softmax_pv<2>(st, o, m, l, negm, (kt) == 0, Vb + (buf) * 64 * VP, VP, 0, lane); }
  __syncthreads();
  ATT_GLOAD0(0);
  ATT_GLOAD1(1);
  ATT_LSTORE0(0);
  const int lastt = ntile - 1;
  ATT_GLOAD0(min(2, lastt));
  __syncthreads();
  for (int kt = 0; kt < ntile; kt += 2) {
    ATT_COMPUTE(kt, 0);
    ATT_LSTORE1(1);
    ATT_GLOAD1(min(kt + 3, lastt));
    __syncthreads();
    ATT_COMPUTE(kt + 1, 1);
    ATT_LSTORE0(0);
    ATT_GLOAD0(min(kt + 4, lastt));
    __syncthreads();
  }
#undef ATT_GLOAD0
#undef ATT_GLOAD1
#undef ATT_LSTORE0
#undef ATT_LSTORE1
#undef ATT_COMPUTE
  const float inv = 1.f / swap_sum(l);
#pragma unroll
  for (int db = 0; db < 2; ++db)
#pragma unroll
    for (int g = 0; g < 4; ++g)
      *(uint2*)(MIX + (size_t)qrow * 1024 + head * 64 + 32 * db + 8 * g + 4 * h) =
          make_uint2(pk2(o[db][4 * g] * inv, o[db][4 * g + 1] * inv), pk2(o[db][4 * g + 2] * inv, o[db][4 * g + 3] * inv));
}

DI void attn_sample(const Params& P, int l, int b, int sp, int hg, char* smem) {
  const ushort_t* QF = (const ushort_t*)(P.ws + O_QF); const ushort_t* QL = (const ushort_t*)(P.ws + O_QL);
  const ushort_t* CKV = (const ushort_t*)(P.ws + O_CKV); const ushort_t* KPE = (const ushort_t*)(P.ws + O_KPE);
  float* PO = (float*)(P.ws + O_PO); float* PML = (float*)(P.ws + O_PML);
  constexpr int KP = 296;
  ushort_t* Qs = (ushort_t*)smem;
  ushort_t* Kt = Qs + 64 * KP;
  const int tid = get_tid(), lane = tid & 63, wave = tid >> 6, r = lane & 31, h = lane >> 5;
  const int qb = wave & 1, dvh = wave >> 1;
  __syncthreads();
#pragma unroll
  for (int i = 0; i < 9; ++i) {
    const int c = tid + 256 * i, q = c / 36, cc = c % 36;
    const int hh = q >> 4, tok = q & 15, head = 4 * hg + hh, srow = 16 * b + tok;
    uint4 v;
    if (cc < 32) v = *(const uint4*)(QL + (size_t)srow * 2048 + head * 256 + cc * 8);
    else v = *(const uint4*)(QF + (size_t)(SOFF + srow) * 768 + head * 96 + 64 + (cc - 32) * 8);
    *(uint4*)(Qs + q * KP + cc * 8) = v;
  }
  f32x16 o[4]; o[0] = zero16(); o[1] = zero16(); o[2] = zero16(); o[3] = zero16();
  float m = -1e30f, lsum = 0.f;
  const int nt = (sp == 7) ? 9 : 8;
  const float* clat = P.cache_lat + (((size_t)l * 32 + b) * PAST + (size_t)sp * 512) * 256;
  const float* cpe = P.cache_pe + (((size_t)l * 32 + b) * PAST + (size_t)sp * 512) * 32;
  for (int ti = 0; ti < nt; ++ti) {
    __syncthreads();
    if (ti < 8) {
      const float* lat = clat + (size_t)ti * 64 * 256;
#pragma unroll
      for (int bt = 0; bt < 4; ++bt) {
        float4 t[4];
#pragma unroll
        for (int i = 0; i < 4; ++i) t[i] = *(const float4*)(lat + (size_t)(tid + 256 * (4 * bt + i)) * 4);
#pragma unroll
        for (int i = 0; i < 4; ++i) {
          const int c = tid + 256 * (4 * bt + i), row = c >> 6, c4 = (c & 63) * 4;
          *(uint2*)(Kt + row * KP + c4) = make_uint2(pk2(t[i].x, t[i].y), pk2(t[i].z, t[i].w));
        }
      }
      const float* pe = cpe + (size_t)ti * 64 * 32;
#pragma unroll
      for (int i = 0; i < 2; ++i) {
        const int c = tid + 256 * i, row = c >> 3, c4 = (c & 7) * 4;
        const float4 t = *(const float4*)(pe + (size_t)c * 4);
        *(uint2*)(Kt + row * KP + 256 + c4) = make_uint2(pk2(t.x, t.y), pk2(t.z, t.w));
      }
    } else {
#pragma unroll
      for (int i = 0; i < 9; ++i) {
        const int c = tid + 256 * i, row = c / 36, cc = c % 36;
        uint4 v = make_uint4(0u, 0u, 0u, 0u);
        if (row < 16) {
          if (cc < 32) v = *(const uint4*)(CKV + (size_t)(SOFF + 16 * b + row) * 256 + cc * 8);
          else v = *(const uint4*)(KPE + (size_t)(SOFF + 16 * b + row) * 32 + (cc - 32) * 8);
        }
        *(uint4*)(Kt + row * KP + cc * 8) = v;
      }
    }
    __syncthreads();
    f32x16 st[2]; st[0] = zero16(); st[1] = zero16();
#pragma unroll
    for (int s = 0; s < 18; ++s) {
      const bf16x8 qv = *(const bf16x8*)(Qs + (32 * qb + r) * KP + 16 * s + 8 * h);
#pragma unroll
      for (int kb = 0; kb < 2; ++kb) st[kb] = MFMA(*(const bf16x8*)(Kt + (32 * kb + r) * KP + 16 * s + 8 * h), qv, st[kb]);
    }
    if (ti == 8) {
#pragma unroll
      for (int kb = 0; kb < 2; ++kb)
#pragma unroll
        for (int i = 0; i < 16; ++i) if (32 * kb + crow(i, h) >= 16) st[kb][i] = -1e30f;
    }
    softmax_pv_simple<4>(st, o, m, lsum, Kt, KP, 128 * dvh, lane);
  }
  const float lt = swap_sum(lsum);
  const int gq = 64 * hg + 32 * qb + r;
  const size_t pbase = ((size_t)(b * 8 + sp) * 128 + gq);
  if (dvh == 0 && h == 0) { PML[pbase * 2] = m; PML[pbase * 2 + 1] = lt; }
#pragma unroll
  for (int db = 0; db < 4; ++db)
#pragma unroll
    for (int g = 0; g < 4; ++g)
      *(float4*)(PO + pbase * 256 + 128 * dvh + 32 * db + 8 * g + 4 * h) = make_float4(o[db][4 * g], o[db][4 * g + 1], o[db][4 * g + 2], o[db][4 * g + 3]);
}


DI bool tile_swz(int t, int MT, int NT, int& mt, int& nt) {
  const int G = gridDim.x, b = blockIdx.x;
  int u = t;
  if ((G & 7) == 0) u = (t / G) * G + (b & 7) * (G >> 3) + (b >> 3);
  if (u >= MT * NT) return false;
  const int full = (NT >> 3) * MT * 8;
  if (u < full) { const int g = u / (MT * 8), rem = u % (MT * 8); mt = rem >> 3; nt = g * 8 + (rem & 7); }
  else { const int rem = u - full, w = NT & 7; mt = rem / w; nt = (NT >> 3) * 8 + rem % w; }
  return true;
}
DI int round_up_grid(int n) { const int G = gridDim.x; return ((n + G - 1) / G) * G; }

DI void phase_g1(const Params& P, int l, char* smem) {
  const ushort_t* Wl = (const ushort_t*)(P.ws + O_W) + (size_t)l * E_WL;
  for (int t = blockIdx.x; t < round_up_grid(133 * 11); t += gridDim.x) {
    int mt, nt; if (!tile_swz(t, 133, 11, mt, nt)) continue;
    gemm_tile_w((const ushort_t*)(P.ws + O_XN), 1024, Wl + E_WT_IN, 1024, 1024, mt * 128, nt * 256, smem, EpiBF16{(ushort_t*)(P.ws + O_PROJ), INP, 1.f});
  }
}

DI void phase_mid(const Params& P, int l, char* smem, int flags) {
  const ushort_t* Wl = (const ushort_t*)(P.ws + O_W) + (size_t)l * E_WL;
  const ushort_t* CQN = (const ushort_t*)(P.ws + O_CQN);
  constexpr int N_G2 = 133 * 6, N_G2S = 4 * 16, N_G3 = 129 * 8, N_PREP = NITEM, N_GS = 128;
  constexpr int TOT = N_G2 + N_G2S + N_G3 + N_PREP + N_GS;
  for (int t0 = blockIdx.x; t0 < TOT; t0 += gridDim.x) {
    int t = t0;
    if (t < N_GS) { if (flags == 0 || flags == 5) gdn_sample(P, l, t, smem); continue; }
    t -= N_GS;
    if (t < N_PREP) { if (flags == 0 || flags == 4) gdn_prep(P, t, smem); continue; }
    if (!(flags == 0 || flags == 6)) continue;
    t -= N_PREP;
    if (t < N_G3) { gemm_tile((const ushort_t*)(P.ws + O_CKV), 256, Wl + E_WT_UKV, 256, 256, (t / 8) * 128, (t % 8) * 128, smem, EpiKV{(ushort_t*)(P.ws + O_KF), (ushort_t*)(P.ws + O_VV)}); continue; }
    t -= N_G3;
    if (t < N_G2) { gemm_tile(CQN, 384, Wl + E_WT_UQ, 384, 384, (t / 6) * 128, (t % 6) * 128, smem, EpiQ{(ushort_t*)(P.ws + O_QF)}); continue; }
    t -= N_G2;
    gemm_tile(CQN, 384, Wl + E_WABS, 384, 384, SOFF + (t / 16) * 128, (t % 16) * 128, smem, EpiBF16{(ushort_t*)(P.ws + O_QL) - (size_t)SOFF * 2048, 2048, QSCALE});
  }
}

DI void phase_mix(const Params& P, int l, char* smem, int flags) {
  int* ctr = (int*)(P.ws + O_CTR) + l * 16;
  volatile int* slot = (volatile int*)(smem + 75776);
  const int myq = (int)(xcc_id_early() & 7u);
  if (threadIdx.x == 0) slot[1] = 0;
  while (true) {
    __syncthreads();
    if (threadIdx.x == 0) {
      int stg = slot[1], code = -1;
      while (stg < 10) {
        if (stg == 0) { const int t = atomicAdd(&ctr[0], 1); if (t < 16) { code = t; break; } stg = 1; }
        else if (stg == 2) { const int t = atomicAdd(&ctr[9], 1); if (t < 512) { code = 16 + 1032 + t; break; } stg = 3; }
        else { const int q = (stg == 1) ? myq : ((myq + stg - 2) & 7); const int t = atomicAdd(&ctr[1 + q], 1); if (t < 129) { code = 16 + (128 - t) * 8 + q; break; } ++stg; }
      }
      slot[1] = stg; slot[0] = code;
    }
    __syncthreads();
    int t = slot[0];
    if (t < 0) break;
    if (t < 16) { if (flags == 0 || flags == 1) gdn_scan(P, l, t, smem); continue; }
    t -= 16;
    if (t < 1032) { if (flags == 0 || flags == 2) attn_prompt(P, t >> 3, t & 7, smem); continue; }
    t -= 1032;
    if (flags == 0 || flags == 3) attn_sample(P, l, t >> 4, (t >> 1) & 7, t & 1, smem);
  }
}

DI void phase_gate(const Params& P, int l, char* smem) {
  const float* OG = (const float*)(P.ws + O_OG); const ushort_t* PROJ = (const ushort_t*)(P.ws + O_PROJ);
  ushort_t* MIX = (ushort_t*)(P.ws + O_MIX); ushort_t* MIXS = (ushort_t*)(P.ws + O_MIXS);
  const float* PO = (const float*)(P.ws + O_PO); const float* PML = (const float*)(P.ws + O_PML);
  const int tid = get_tid(), lane = tid & 63, gw = blockIdx.x * 4 + (tid >> 6), nw = gridDim.x * 4;
  for (int t = blockIdx.x; t < NITEM; t += gridDim.x) gdn_out(P, l, t, smem);
  for (int row = SOFF + gw; row < MTOT; row += nw) {
    const bool valid = row_valid(row);
#pragma unroll
    for (int hd = 0; hd < 4; ++hd) {
      float o0 = 0.f, o1 = 0.f, z0 = 0.f, z1 = 0.f;
      if (valid) {
        o0 = OG[(size_t)row * 512 + hd * 128 + lane]; o1 = OG[(size_t)row * 512 + hd * 128 + 64 + lane];
        z0 = bf2f(PROJ[(size_t)row * INP + OFF_Z + hd * 128 + lane]); z1 = bf2f(PROJ[(size_t)row * INP + OFF_Z + hd * 128 + 64 + lane]);
      }
      const float ss = wave_sum(o0 * o0 + o1 * o1);
      const float rstd = rsqrtf(ss * (1.f / 128.f) + EPS);
      const float v0 = o0 * rstd * P.gdn_norm[l * 128 + lane] * siluf(z0);
      const float v1 = o1 * rstd * P.gdn_norm[l * 128 + 64 + lane] * siluf(z1);
      if (row < SOFF) { MIX[(size_t)row * 1024 + 512 + hd * 128 + lane] = f2bf(v0); MIX[(size_t)row * 1024 + 512 + hd * 128 + 64 + lane] = f2bf(v1); }
      else { MIXS[(size_t)(row - SOFF) * 2560 + 2048 + hd * 128 + lane] = f2bf(v0); MIXS[(size_t)(row - SOFF) * 2560 + 2048 + hd * 128 + 64 + lane] = f2bf(v1); }
    }
  }
  for (int it = gw; it < 32 * 128; it += nw) {
    const int b = it >> 7, gq = it & 127, head = gq >> 4, tok = gq & 15;
    float ms[8], mx = -1e30f;
#pragma unroll
    for (int sp = 0; sp < 8; ++sp) { ms[sp] = PML[((size_t)(b * 8 + sp) * 128 + gq) * 2]; mx = fmaxf(mx, ms[sp]); }
    float L = 0.f; float4 acc = make_float4(0.f, 0.f, 0.f, 0.f);
#pragma unroll
    for (int sp = 0; sp < 8; ++sp) {
      const float w = __builtin_amdgcn_exp2f(ms[sp] - mx);
      L += w * PML[((size_t)(b * 8 + sp) * 128 + gq) * 2 + 1];
      const float4 t = *(const float4*)(PO + ((size_t)(b * 8 + sp) * 128 + gq) * 256 + lane * 4);
      acc.x += w * t.x; acc.y += w * t.y; acc.z += w * t.z; acc.w += w * t.w;
    }
    const float inv = 1.f / L;
    *(uint2*)(MIXS + (size_t)(16 * b + tok) * 2560 + head * 256 + lane * 4) = make_uint2(pk2(acc.x * inv, acc.y * inv), pk2(acc.z * inv, acc.w * inv));
  }
}

DI void phase_g6(const Params& P, int l, char* smem) {
  const ushort_t* Wl = (const ushort_t*)(P.ws + O_W) + (size_t)l * E_WL;
  ushort_t* OMIX = (ushort_t*)(P.ws + O_OMIX);
  for (int t = blockIdx.x; t < round_up_grid(133 * 16); t += gridDim.x) {
    int mt, n2; if (!tile_swz(t, 133, 16, mt, n2)) continue;
    const int nt = n2 >> 1, ks = n2 & 1;
    ushort_t* dst = OMIX + (size_t)ks * MTOT * 1024;
    if (mt < 129) gemm_tile((const ushort_t*)(P.ws + O_MIX) + ks * 512, 1024, Wl + E_WT_O + ks * 512, 1024, 512, mt * 128, nt * 128, smem, EpiBF16{dst, 1024, 1.f});
    else gemm_tile((const ushort_t*)(P.ws + O_MIXS) - (size_t)SOFF * 2560 + ks * 1280, 2560, Wl + E_WT_OS + ks * 1280, 2560, 1280, mt * 128, nt * 128, smem, EpiBF16{dst, 1024, 1.f});
  }
}

DI void phase_resid(const Params& P, const float* w1, const float* w2, bool final_out, bool first) {
  const ushort_t* __restrict__ OMIX = (const ushort_t*)(P.ws + O_OMIX);
  const float* __restrict__ X = (const float*)(P.ws + (first ? O_X : O_X2)); float* XO = (float*)(P.ws + (first ? O_X2 : O_X)); ushort_t* XN = (ushort_t*)(P.ws + O_XN);
  const int tid = get_tid(), lane = tid & 63, gw = blockIdx.x * 4 + (tid >> 6), nw = gridDim.x * 4;
  f32x4v w1v[4], w2v[4];
#pragma unroll
  for (int j = 0; j < 4; ++j) { w1v[j] = *(const f32x4v*)(w1 + 4 * lane + 256 * j); w2v[j] = *(const f32x4v*)(w2 + 4 * lane + 256 * j); }
  constexpr int NR = 3;
  for (int row0 = gw; row0 < MTOT; row0 += NR * nw) {
    uint2 ta[NR][4], tb[NR][4]; f32x4v xv[NR][4];
#pragma unroll
    for (int rr = 0; rr < NR; ++rr) {
      const int row = min(row0 + rr * nw, MTOT - 1);
#pragma unroll
      for (int j = 0; j < 4; ++j) {
        ta[rr][j] = *(const uint2*)(OMIX + (size_t)row * 1024 + 4 * lane + 256 * j);
        tb[rr][j] = *(const uint2*)(OMIX + (size_t)MTOT * 1024 + (size_t)row * 1024 + 4 * lane + 256 * j);
        xv[rr][j] = *(const f32x4v*)(X + (size_t)row * 1024 + 4 * lane + 256 * j);
      }
    }
#pragma unroll
    for (int rr = 0; rr < NR; ++rr) {
      const int row = row0 + rr * nw;
      if (row >= MTOT) break;
      const bool valid = row_valid(row);
      float v[16], ss = 0.f;
#pragma unroll
      for (int j = 0; j < 4; ++j) {
        v[4 * j] = bflo(ta[rr][j].x) + bflo(tb[rr][j].x); v[4 * j + 1] = bfhi(ta[rr][j].x) + bfhi(tb[rr][j].x);
        v[4 * j + 2] = bflo(ta[rr][j].y) + bflo(tb[rr][j].y); v[4 * j + 3] = bfhi(ta[rr][j].y) + bfhi(tb[rr][j].y);
      }
#pragma unroll
      for (int i = 0; i < 16; ++i) { v[i] = valid ? v[i] : 0.f; ss += v[i] * v[i]; }
      ss = wave_sum(ss);
      const float rstd = rsqrtf(ss * (1.f / 1024.f) + EPS);
      float s2 = 0.f;
#pragma unroll
      for (int j = 0; j < 4; ++j) {
        v[4 * j] = xv[rr][j].x + v[4 * j] * rstd * w1v[j].x; v[4 * j + 1] = xv[rr][j].y + v[4 * j + 1] * rstd * w1v[j].y;
        v[4 * j + 2] = xv[rr][j].z + v[4 * j + 2] * rstd * w1v[j].z; v[4 * j + 3] = xv[rr][j].w + v[4 * j + 3] * rstd * w1v[j].w;
      }
#pragma unroll
      for (int i = 0; i < 16; ++i) { v[i] = valid ? v[i] : 0.f; s2 += v[i] * v[i]; }
      if (final_out) {
        if (valid) {
          float* dst = nullptr;
          if (row >= SOFF) dst = P.out + OUT_YS + (size_t)(row - SOFF) * 1024;
          else if (row >= POFF + 16) dst = P.out + OUT_YP + (size_t)(row - POFF - 16) * 1024;
          if (dst) {
#pragma unroll
            for (int j = 0; j < 4; ++j) *(float4*)(dst + 4 * lane + 256 * j) = make_float4(v[4 * j], v[4 * j + 1], v[4 * j + 2], v[4 * j + 3]);
          }
        }
      } else {
        s2 = wave_sum(s2);
        const float rs2 = rsqrtf(s2 * (1.f / 1024.f) + EPS);
#pragma unroll
        for (int j = 0; j < 4; ++j) {
          const int c = 4 * lane + 256 * j;
          *(float4*)(XO + (size_t)row * 1024 + c) = make_float4(v[4 * j], v[4 * j + 1], v[4 * j + 2], v[4 * j + 3]);
          *(uint2*)(XN + (size_t)row * 1024 + c) = make_uint2(pk2(v[4 * j] * rs2 * w2v[j].x, v[4 * j + 1] * rs2 * w2v[j].y), pk2(v[4 * j + 2] * rs2 * w2v[j].z, v[4 * j + 3] * rs2 * w2v[j].w));
        }
      }
    }
  }
}

DI void phase_g7(const Params& P, int l, char* smem) {
  const ushort_t* Wl = (const ushort_t*)(P.ws + O_W) + (size_t)l * E_WL;
  for (int t = blockIdx.x; t < round_up_grid(133 * 22); t += gridDim.x) {
    int mt, nt; if (!tile_swz(t, 133, 22, mt, nt)) continue;
    gemm_tile_w((const ushort_t*)(P.ws + O_XN), 1024, Wl + E_WT_GU, 1024, 1024, mt * 128, nt * 256, smem, EpiSwiGLU{(ushort_t*)(P.ws + O_ACT)});
  }
}
DI void phase_g8(const Params& P, int l, char* smem) {
  const ushort_t* Wl = (const ushort_t*)(P.ws + O_W) + (size_t)l * E_WL;
  for (int t = blockIdx.x; t < round_up_grid(133 * 16); t += gridDim.x) {
    int mt, n2; if (!tile_swz(t, 133, 16, mt, n2)) continue;
    const int nt = n2 >> 1, ks = n2 & 1;
    gemm_tile((const ushort_t*)(P.ws + O_ACT) + ks * 1408, DFF, Wl + E_WT_DOWN + ks * 1408, DFF, 1408, mt * 128, nt * 128, smem,
              EpiBF16{(ushort_t*)(P.ws + O_OMIX) + (size_t)ks * MTOT * 1024, 1024, 1.f});
  }
}

#define XB_TMO      128
#define XB_XCNT(j)  (256  + 64 * (j))
#define XB_XSUB(j)  (1280 + 64 * (j))
#define XB_XGEN(j)  (2304 + 64 * (j))
#define XB_TOP      3328
#define XB_TOPGEN   3392
#define XCD_BAR_WORDS 3456
#define XB_SPIN_CAP (1u << 22)
#define LAS __attribute__((address_space(3)))
DI unsigned xb_ld(unsigned* p) { return __hip_atomic_load(p, __ATOMIC_RELAXED, __HIP_MEMORY_SCOPE_AGENT); }
DI unsigned xb_add(unsigned* p, unsigned v) { return __hip_atomic_fetch_add(p, v, __ATOMIC_RELAXED, __HIP_MEMORY_SCOPE_AGENT); }
DI unsigned xb_xcc_id() { return (unsigned)__builtin_amdgcn_s_getreg((3 << 11) | 20) & 0xFu; }
#define XB_SPIN(cond, bar) do { unsigned _sp = 0; while (cond) { __builtin_amdgcn_s_sleep(1); \
    if ((++_sp & 255u) == 0u) { if (xb_ld(&(bar)[XB_TMO])) break; if (_sp > XB_SPIN_CAP) { atomicAdd(&(bar)[XB_TMO], 1u); break; } } } } while (0)
struct XcdBarrier { unsigned* bar; unsigned x; volatile LAS unsigned* st; };
DI XcdBarrier xcd_barrier_post(unsigned* bar, volatile LAS unsigned* st) {
  XcdBarrier b; b.bar = bar; b.x = xb_xcc_id(); b.st = st;
  if (threadIdx.x == 0) (void)xb_add(&bar[XB_XCNT(b.x)], 1u);
  return b;
}
DI void xcd_barrier_complete(unsigned* bar, unsigned x, unsigned& nloc, unsigned& nx) {
  const unsigned G = gridDim.x * gridDim.y * gridDim.z;
  unsigned sum, cnt, mine, sp = 0u;
  for (;;) {
    sum = 0u; cnt = 0u; mine = 0u;
#pragma unroll
    for (unsigned j = 0; j < 16; ++j) { const unsigned c = xb_ld(&bar[XB_XCNT(j)]); sum += c; cnt += (c > 0u) ? 1u : 0u; mine = (j == x) ? c : mine; }
    if (sum == G) break;
    __builtin_amdgcn_s_sleep(1);
    if ((++sp & 255u) == 0u) { if (xb_ld(&bar[XB_TMO])) break; if (sp > XB_SPIN_CAP) { atomicAdd(&bar[XB_TMO], 1u); break; } }
  }
  nloc = mine > 0u ? mine : 1u; nx = cnt > 0u ? cnt : 1u;
}
DI void xcd_barrier(const XcdBarrier& b) {
  asm volatile("s_waitcnt vmcnt(0)" ::: "memory");
  __syncthreads();
  if (threadIdx.x == 0) {
    unsigned* bar = b.bar;
    __builtin_amdgcn_s_waitcnt(0);
    unsigned nloc = b.st[0], nx = b.st[1];
    if (nloc == 0u) { xcd_barrier_complete(bar, b.x, nloc, nx); b.st[0] = nloc; b.st[1] = nx; }
    const unsigned old = xb_add(&bar[XB_XSUB(b.x)], 1u);
    const unsigned gen = old / nloc;
    if (old + 1u == (gen + 1u) * nloc) {
      __builtin_amdgcn_fence(__ATOMIC_RELEASE, "agent");
      asm volatile("s_waitcnt vmcnt(0)" ::: "memory");
      const unsigned og = xb_add(&bar[XB_TOP], 1u);
      const unsigned tg = og / nx;
      if (og + 1u == (tg + 1u) * nx) xb_add(&bar[XB_TOPGEN], 1u);
      else XB_SPIN(xb_ld(&bar[XB_TOPGEN]) == tg, bar);
      __builtin_amdgcn_fence(__ATOMIC_ACQUIRE, "agent");
      xb_add(&bar[XB_XGEN(b.x)], 1u);
      asm volatile("s_waitcnt vmcnt(0)" ::: "memory");
    } else {
      XB_SPIN(xb_ld(&bar[XB_XGEN(b.x)]) == gen, bar);
      __builtin_amdgcn_fence(__ATOMIC_ACQUIRE, "agent");
      asm volatile("s_waitcnt vmcnt(0)" ::: "memory");
    }
  }
  __syncthreads();
}

constexpr int NPHASE = 2 + 10 * DEPTH;

DI void run_phase(const Params& P, int ph, char* smem, int flags) {
  if (ph == 0) { phase_prep0(P, smem); return; }
  if (ph == 1) { phase_prep1(P, smem); return; }
  const int l = (ph - 2) / 10, sub = (ph - 2) % 10;
  switch (sub) {
    case 0: phase_g1(P, l, smem); break;
    case 1: phase_rowpass(P, l); break;
    case 2: phase_mid(P, l, smem, flags); break;
    case 3: phase_mix(P, l, smem, flags); break;
    case 4: phase_gate(P, l, smem); break;
    case 5: phase_g6(P, l, smem); break;
    case 6: phase_resid(P, P.post_mix + l * 1024, P.pre_ffn + l * 1024, false, true); break;
    case 7: phase_g7(P, l, smem); break;
    case 8: phase_g8(P, l, smem); break;
    default: phase_resid(P, P.post_ffn + l * 1024, P.pre_mix + (l < 3 ? l + 1 : 0) * 1024, l == 3, false); break;
  }
}

template <bool COOP>
__global__ void __launch_bounds__(256, 2) mega_kernel(Params P, int ph0, int ph1, int flags) {
  __shared__ __attribute__((aligned(16))) char smem[SMEM_BYTES];
  if (COOP) {
    __shared__ uint4 xb_words;
    if (threadIdx.x == 0) xb_words = make_uint4(0u, 0u, 0u, 0u);
    __syncthreads();
    XcdBarrier xb = xcd_barrier_post((unsigned*)(P.ws + O_BAR), (volatile LAS unsigned*)&xb_words);
    for (int ph = ph0; ph < ph1; ++ph) {
      run_phase(P, ph, smem, flags);
      if (ph + 1 < ph1) {
        if (flags == 0x7fffffff) cg::this_grid().sync();
        xcd_barrier(xb);
      }
    }
  } else {
    for (int ph = ph0; ph < ph1; ++ph) run_phase(P, ph, smem, flags);
  }
}

extern "C" void kernel_launch(void* const* d_in, const int* in_sizes, int n_in, void* d_out, int out_size, void* d_ws,
                              size_t ws_size, hipStream_t stream) {
  Params P{};
  const float** pp = (const float**)&P;
  for (int i = 0; i < 25; ++i) pp[i] = (const float*)d_in[i];
  P.out = (float*)d_out;
  P.ws = (char*)d_ws;
  if (ws_size < O_END) { fprintf(stderr, "workspace too small: %zu < %zu\n", ws_size, (size_t)O_END); return; }
#if ONE_LAUNCH
  static int grid_blocks = 0;
  if (!grid_blocks) {
    int dev = 0, cus = 0, per_cu = 0;
    hipGetDevice(&dev);
    hipDeviceGetAttribute(&cus, hipDeviceAttributeMultiprocessorCount, dev);
    hipOccupancyMaxActiveBlocksPerMultiprocessor(&per_cu, mega_kernel<true>, 256, 0);
    if (per_cu > 2) per_cu = 2;
    grid_blocks = cus * per_cu;
  }
  hipMemsetAsync((char*)d_ws + O_BAR, 0, XCD_BAR_WORDS * 4, stream);
  int ph0 = 0, ph1 = NPHASE, flags = 0;
  void* args[] = {&P, &ph0, &ph1, &flags};
  hipError_t e = hipLaunchCooperativeKernel((void*)mega_kernel<true>, dim3(grid_blocks), dim3(256), args, 0, stream);
  if (e != hipSuccess) fprintf(stderr, "cooperative launch failed: %s (grid %d)\n", hipGetErrorString(e), grid_blocks);
#else
  for (int ph = 0; ph < NPHASE; ++ph) {
    mega_kernel<false><<<512, 256, 0, stream>>>(P, ph, ph + 1, 0);
    if ((ph >= 2 && ((PROBE_MASK >> ((ph - 2) % 10)) & 1)) || (ph < 2 && ((PROBE_MASK >> (10 + ph)) & 1))) {
      if (ph >= 2 && (ph - 2) % 10 == 3) hipMemsetAsync((char*)d_ws + O_CTR, 0, 256, stream);
      mega_kernel<false><<<512, 256, 0, stream>>>(P, ph, ph + 1, PROBE_FLAGS);
    }
  }
#endif
}
```

```cpp
#include <hip/hip_runtime.h>
#include <hip/hip_cooperative_groups.h>
#include <cstdio>
namespace cg = cooperative_groups;

#ifndef ONE_LAUNCH
#define ONE_LAUNCH 1
#endif
#ifndef PROBE_MASK
#define PROBE_MASK 0
#endif
#ifndef PROBE_FLAGS
#define PROBE_FLAGS 0
#endif

#define DI __device__ __forceinline__
typedef unsigned short ushort_t;
typedef short bf16x8 __attribute__((ext_vector_type(8)));
typedef short s16x4 __attribute__((ext_vector_type(4)));
typedef float f32x16 __attribute__((ext_vector_type(16)));
typedef float f32x2v __attribute__((ext_vector_type(2)));
typedef __bf16 bf16x2v __attribute__((ext_vector_type(2)));
typedef unsigned u32x4 __attribute__((ext_vector_type(4)));
typedef float f32x4v __attribute__((ext_vector_type(4)));
#define MFMA(a, b, c) __builtin_amdgcn_mfma_f32_32x32x16_bf16((a), (b), (c), 0, 0, 0)

constexpr int DM = 1024, LTOK = 16400, DEPTH = 4, DECB = 32, DECT = 16, PAST = 4096;
constexpr int POFF = 48, PEND = 16448, SOFF = 16512, MTOT = 17024;
constexpr int NCH = 257, NITEM = NCH * 4;
constexpr int INP = 2816, DFF = 2816;
constexpr int OFF_KV = 384, OFF_PE = 640, OFF_QKV = 672, OFF_Z = 2208, OFF_B = 2720, OFF_A = 2724, INW = 2728;
constexpr float EPS = 1e-6f;
constexpr float QSCALE = 0.10206207261596577f * 1.4426950408889634f;
constexpr int SMEM_BYTES = 75776 + 16;

constexpr size_t OUT_YP = 0;
constexpr size_t OUT_YS = OUT_YP + (size_t)16384 * 1024;
constexpr size_t OUT_PLAT = OUT_YS + (size_t)512 * 1024;
constexpr size_t OUT_PPE = OUT_PLAT + (size_t)4 * LTOK * 256;
constexpr size_t OUT_PGDN = OUT_PPE + (size_t)4 * LTOK * 32;
constexpr size_t OUT_PCONV = OUT_PGDN + (size_t)4 * 4 * 128 * 128;
constexpr size_t OUT_SLAT = OUT_PCONV + (size_t)4 * 3 * 1536;
constexpr size_t OUT_SPE = OUT_SLAT + (size_t)4 * 32 * 16 * 256;
constexpr size_t OUT_SGDN = OUT_SPE + (size_t)4 * 32 * 16 * 32;
constexpr size_t OUT_SCONV = OUT_SGDN + (size_t)4 * 32 * 4 * 128 * 128;

constexpr size_t al256(size_t x) { return (x + 255) & ~(size_t)255; }
constexpr size_t E_WT_IN = 0;
constexpr size_t E_WT_UQ = E_WT_IN + (size_t)2816 * 1024;
constexpr size_t E_WUQ_BF = E_WT_UQ + (size_t)768 * 384;
constexpr size_t E_WT_UKV = E_WUQ_BF + (size_t)384 * 768;
constexpr size_t E_WUK_BF = E_WT_UKV + (size_t)1024 * 256;
constexpr size_t E_WUV_BF = E_WUK_BF + (size_t)256 * 512;
constexpr size_t E_WABS = E_WUV_BF + (size_t)256 * 512;
constexpr size_t E_WT_O = E_WABS + (size_t)2048 * 384;
constexpr size_t E_WT_OS = E_WT_O + (size_t)1024 * 1024;
constexpr size_t E_WT_GU = E_WT_OS + (size_t)1024 * 2560;
constexpr size_t E_WT_DOWN = E_WT_GU + (size_t)5632 * 1024;
constexpr size_t E_WL = E_WT_DOWN + (size_t)1024 * 2816;

constexpr size_t O_CTR = 0;
constexpr size_t O_BAR = 1024;
constexpr size_t O_W = 16384;
constexpr size_t O_X = al256(O_W + 4 * E_WL * 2);
constexpr size_t O_XN = al256(O_X + (size_t)MTOT * 1024 * 4);
constexpr size_t O_PROJ = al256(O_XN + (size_t)MTOT * 1024 * 2);
constexpr size_t O_CQN = al256(O_PROJ + (size_t)MTOT * INP * 4);
constexpr size_t O_CKV = al256(O_CQN + (size_t)MTOT * 384 * 2);
constexpr size_t O_KPE = al256(O_CKV + (size_t)MTOT * 256 * 2);
constexpr size_t O_QF = al256(O_KPE + (size_t)MTOT * 32 * 2);
constexpr size_t O_QL = al256(O_QF + (size_t)MTOT * 768 * 2);
constexpr size_t O_KF = al256(O_QL + (size_t)512 * 2048 * 2);
constexpr size_t O_VV = al256(O_KF + (size_t)SOFF * 768 * 2);
constexpr size_t O_GQ = al256(O_VV + (size_t)SOFF * 512 * 2);
constexpr size_t O_GK = al256(O_GQ + (size_t)MTOT * 512 * 4);
constexpr size_t O_GV = al256(O_GK + (size_t)MTOT * 512 * 4);
constexpr size_t O_GB = al256(O_GV + (size_t)MTOT * 512 * 4);
constexpr size_t O_GG = al256(O_GB + (size_t)MTOT * 4 * 4);
constexpr size_t O_UT = al256(O_GG + (size_t)MTOT * 4 * 4);
constexpr size_t O_WN = al256(O_UT + (size_t)NITEM * 8192 * 4);
constexpr size_t O_QG = al256(O_WN + (size_t)NITEM * 8192 * 2);
constexpr size_t O_KDT = al256(O_QG + (size_t)NITEM * 8192 * 2);
constexpr size_t O_QKM = al256(O_KDT + (size_t)NITEM * 8192 * 2);
constexpr size_t O_GL = al256(O_QKM + (size_t)NITEM * 4096 * 2);
constexpr size_t O_OG = al256(O_GL + (size_t)NITEM * 4);
constexpr size_t O_MIX = al256(O_OG + (size_t)MTOT * 512 * 4);
constexpr size_t O_MIXS = al256(O_MIX + (size_t)MTOT * 1024 * 2);
constexpr size_t O_PO = al256(O_MIXS + (size_t)512 * 2560 * 2);
constexpr size_t O_PML = al256(O_PO + (size_t)32 * 8 * 128 * 256 * 4);
constexpr size_t O_OMIX = al256(O_PML + (size_t)32 * 8 * 128 * 2 * 4);
constexpr size_t O_ACT = al256(O_OMIX + (size_t)MTOT * 1024 * 4);
constexpr size_t O_X2 = al256(O_ACT + (size_t)MTOT * DFF * 2);
constexpr size_t O_AN = al256(O_X2 + (size_t)MTOT * 1024 * 4);
constexpr size_t O_BN = al256(O_AN + (size_t)NITEM * 16384 * 2);
constexpr size_t O_SPK = al256(O_BN + (size_t)NITEM * 16384 * 4);
constexpr size_t O_END = al256(O_SPK + (size_t)NITEM * 32768);

struct Params {
  const float *x_prompt, *x_sample, *cache_lat, *cache_pe, *state_gdn, *state_conv, *meta, *pre_mix, *w_in, *q_norm,
      *kv_norm, *w_uq, *w_uk, *w_uv, *conv_w, *a_log, *dt_bias, *gdn_norm, *w_o, *post_mix, *pre_ffn, *w_gate, *w_up,
      *w_down, *post_ffn;
  float* out;
  char* ws;
};

DI unsigned pk2(float a, float b) { f32x2v f = {a, b}; bf16x2v r = __builtin_convertvector(f, bf16x2v); return __builtin_bit_cast(unsigned, r); }
DI ushort_t f2bf(float x) { return (ushort_t)(pk2(x, 0.f) & 0xffffu); }
DI float bf2f(ushort_t u) { return __uint_as_float(((unsigned)u) << 16); }
DI int crow(int reg, int h) { return (reg & 3) + 8 * (reg >> 2) + 4 * h; }
DI f32x16 zero16() { f32x16 z;
#pragma unroll
  for (int i = 0; i < 16; ++i) z[i] = 0.f; return z; }
template <int S> DI bf16x8 pack8(const f32x16& x) {
  u32x4 p;
  p[0] = pk2(x[8 * S + 0], x[8 * S + 1]); p[1] = pk2(x[8 * S + 2], x[8 * S + 3]);
  p[2] = pk2(x[8 * S + 4], x[8 * S + 5]); p[3] = pk2(x[8 * S + 6], x[8 * S + 7]);
  return __builtin_bit_cast(bf16x8, p);
}
DI float wave_sum(float v) {
#pragma unroll
  for (int d = 32; d >= 1; d >>= 1) v += __shfl_xor(v, d, 64);
  return v;
}
DI float swap_max(float m) { auto rr = __builtin_amdgcn_permlane32_swap(__float_as_uint(m), __float_as_uint(m), false, false); return fmaxf(__uint_as_float(rr[0]), __uint_as_float(rr[1])); }
DI float swap_sum(float m) { auto rr = __builtin_amdgcn_permlane32_swap(__float_as_uint(m), __float_as_uint(m), false, false); return __uint_as_float(rr[0]) + __uint_as_float(rr[1]); }
typedef short v4i16_t __attribute__((ext_vector_type(4)));
DI s16x4 vtr(const ushort_t* p) { return __builtin_bit_cast(s16x4, __builtin_amdgcn_ds_read_tr16_b64_v4i16((__attribute__((address_space(3))) v4i16_t*)p)); }
DI bf16x8 cat8(s16x4 lo, s16x4 hi) { return __builtin_shufflevector(lo, hi, 0, 1, 2, 3, 4, 5, 6, 7); }
DI bf16x8 fragP(const ushort_t* base, int h) { s16x4 lo = *(const s16x4*)(base + 4 * h); s16x4 hi = *(const s16x4*)(base + 8 + 4 * h); return cat8(lo, hi); }
DI unsigned xcc_id_early() { return (unsigned)__builtin_amdgcn_s_getreg((3 << 11) | 20) & 0xFu; }
DI int get_tid() { int t = threadIdx.x; asm volatile("" : "+v"(t)); return t; }
DI float siluf(float x) { return x * __builtin_amdgcn_rcpf(1.f + __expf(-x)); }
DI float row_pos(int row) { return row < SOFF ? (float)(row - POFF) : (float)(16 + PAST + ((row - SOFF) & 15)); }
DI bool row_valid(int row) { return row >= SOFF || (row >= POFF && row < PEND); }
DI float rope_inv(int j) { return exp2f(-(float)j * (13.287712379549449f / 16.f)); }

constexpr int GP = 72;
template <class Epi>
DI void gemm_tile(const ushort_t* __restrict__ A, int lda, const ushort_t* __restrict__ Wt, int ldb, int K, int m0, int n0,
                  char* smem, Epi epi) {
  ushort_t* L0 = (ushort_t*)smem;
  ushort_t* L1 = L0 + 256 * GP;
  const int tid = get_tid(), lane = tid & 63, wave = tid >> 6, r = lane & 31, h = lane >> 5;
  const int wm = wave >> 1, wn = wave & 1;
  const int lrow = tid >> 3, lcol = (tid & 7) * 8;
  const ushort_t* Ag = A + (size_t)(m0 + lrow) * lda + lcol;
  const ushort_t* Bg = Wt + (size_t)(n0 + lrow) * ldb + lcol;
  const size_t a32 = (size_t)32 * lda, b32 = (size_t)32 * ldb;
  u32x4 pa0, pa1, pa2, pa3, pb0, pb1, pb2, pb3;
  u32x4 qa0, qa1, qa2, qa3, qb0, qb1, qb2, qb3;
#define G_LOAD0(kk) { pa0 = *(const u32x4*)(Ag + (kk)); pa1 = *(const u32x4*)(Ag + a32 + (kk)); pa2 = *(const u32x4*)(Ag + 2 * a32 + (kk)); pa3 = *(const u32x4*)(Ag + 3 * a32 + (kk)); \
                      pb0 = *(const u32x4*)(Bg + (kk)); pb1 = *(const u32x4*)(Bg + b32 + (kk)); pb2 = *(const u32x4*)(Bg + 2 * b32 + (kk)); pb3 = *(const u32x4*)(Bg + 3 * b32 + (kk)); }
#define G_LOAD1(kk) { qa0 = *(const u32x4*)(Ag + (kk)); qa1 = *(const u32x4*)(Ag + a32 + (kk)); qa2 = *(const u32x4*)(Ag + 2 * a32 + (kk)); qa3 = *(const u32x4*)(Ag + 3 * a32 + (kk)); \
                      qb0 = *(const u32x4*)(Bg + (kk)); qb1 = *(const u32x4*)(Bg + b32 + (kk)); qb2 = *(const u32x4*)(Bg + 2 * b32 + (kk)); qb3 = *(const u32x4*)(Bg + 3 * b32 + (kk)); }
#define L_STORE0(L) { ushort_t* la = (L) + lrow * GP + lcol; ushort_t* lb = la + 128 * GP; \
                      *(u32x4*)(la) = pa0; *(u32x4*)(la + 32 * GP) = pa1; *(u32x4*)(la + 64 * GP) = pa2; *(u32x4*)(la + 96 * GP) = pa3; \
                      *(u32x4*)(lb) = pb0; *(u32x4*)(lb + 32 * GP) = pb1; *(u32x4*)(lb + 64 * GP) = pb2; *(u32x4*)(lb + 96 * GP) = pb3; }
#define L_STORE1(L) { ushort_t* la = (L) + lrow * GP + lcol; ushort_t* lb = la + 128 * GP; \
                      *(u32x4*)(la) = qa0; *(u32x4*)(la + 32 * GP) = qa1; *(u32x4*)(la + 64 * GP) = qa2; *(u32x4*)(la + 96 * GP) = qa3; \
                      *(u32x4*)(lb) = qb0; *(u32x4*)(lb + 32 * GP) = qb1; *(u32x4*)(lb + 64 * GP) = qb2; *(u32x4*)(lb + 96 * GP) = qb3; }
#define G_COMPUTE(L) { const ushort_t* As = (L); const ushort_t* Bs = (L) + 128 * GP; \
    _Pragma("unroll") for (int ks = 0; ks < 4; ++ks) { \
      const bf16x8 af0 = *(const bf16x8*)(As + (64 * wm + r) * GP + ks * 16 + h * 8); \
      const bf16x8 af1 = *(const bf16x8*)(As + (64 * wm + 32 + r) * GP + ks * 16 + h * 8); \
      const bf16x8 bf0 = *(const bf16x8*)(Bs + (64 * wn + r) * GP + ks * 16 + h * 8); \
      const bf16x8 bf1 = *(const bf16x8*)(Bs + (64 * wn + 32 + r) * GP + ks * 16 + h * 8); \
      acc00 = MFMA(bf0, af0, acc00); acc01 = MFMA(bf1, af0, acc01); acc10 = MFMA(bf0, af1, acc10); acc11 = MFMA(bf1, af1, acc11); } }
  f32x16 acc00 = zero16(), acc01 = zero16(), acc10 = zero16(), acc11 = zero16();
  __syncthreads();
  if (K == 64) {
    G_LOAD0(0);
    L_STORE0(L0);
    __syncthreads();
    G_COMPUTE(L0);
    __syncthreads();
  } else {
    const int klast = K - 64;
    G_LOAD0(0);
    G_LOAD1(64);
    L_STORE0(L0);
    G_LOAD0(min(128, klast));
    __syncthreads();
    for (int k0 = 0; k0 < K; k0 += 128) {
      G_COMPUTE(L0);
      L_STORE1(L1);
      G_LOAD1(min(k0 + 192, klast));
      __syncthreads();
      G_COMPUTE(L1);
      L_STORE0(L0);
      G_LOAD0(min(k0 + 256, klast));
      __syncthreads();
    }
  }
#undef G_LOAD0
#undef G_LOAD1
#undef L_STORE0
#undef L_STORE1
#undef G_COMPUTE
  epi(m0 + 64 * wm + r, n0 + 64 * wn, acc00, acc01, h);
  epi(m0 + 64 * wm + 32 + r, n0 + 64 * wn, acc10, acc11, h);
}

template <class Epi>
DI void gemm_tile_w(const ushort_t* __restrict__ A, int lda, const ushort_t* __restrict__ Wt, int ldb, int K, int m0, int n0,
                    char* smem, Epi epi) {
  ushort_t* As = (ushort_t*)smem;
  ushort_t* Bs = As + 128 * GP;
  const int tid = get_tid(), lane = tid & 63, wave = tid >> 6, r = lane & 31, h = lane >> 5;
  const int wm = wave >> 1, wn = wave & 1;
  const int lrow = tid >> 3, lcol = (tid & 7) * 8;
  const ushort_t* Ag = A + (size_t)(m0 + lrow) * lda + lcol;
  const ushort_t* Bg = Wt + (size_t)(n0 + lrow) * ldb + lcol;
  const size_t a32 = (size_t)32 * lda, b32 = (size_t)32 * ldb;
  u32x4 ra[4], rb[8];
#pragma unroll
  for (int i = 0; i < 4; ++i) ra[i] = *(const u32x4*)(Ag + i * a32);
#pragma unroll
  for (int i = 0; i < 8; ++i) rb[i] = *(const u32x4*)(Bg + i * b32);
  f32x16 acc[2][4];
#pragma unroll
  for (int mi = 0; mi < 2; ++mi)
#pragma unroll
    for (int ni = 0; ni < 4; ++ni) acc[mi][ni] = zero16();
  for (int k0 = 0; k0 < K; k0 += 64) {
    __syncthreads();
#pragma unroll
    for (int i = 0; i < 4; ++i) *(u32x4*)(As + (lrow + 32 * i) * GP + lcol) = ra[i];
#pragma unroll
    for (int i = 0; i < 8; ++i) *(u32x4*)(Bs + (lrow + 32 * i) * GP + lcol) = rb[i];
    __syncthreads();
    if (k0 + 64 < K) {
#pragma unroll
      for (int i = 0; i < 4; ++i) ra[i] = *(const u32x4*)(Ag + i * a32 + k0 + 64);
#pragma unroll
      for (int i = 0; i < 8; ++i) rb[i] = *(const u32x4*)(Bg + i * b32 + k0 + 64);
    }
#pragma unroll
    for (int ks = 0; ks < 4; ++ks) {
      bf16x8 af[2], bfv[4];
#pragma unroll
      for (int mi = 0; mi < 2; ++mi) af[mi] = *(const bf16x8*)(As + (64 * wm + 32 * mi + r) * GP + ks * 16 + h * 8);
#pragma unroll
      for (int ni = 0; ni < 4; ++ni) bfv[ni] = *(const bf16x8*)(Bs + (128 * wn + 32 * ni + r) * GP + ks * 16 + h * 8);
#pragma unroll
      for (int mi = 0; mi < 2; ++mi)
#pragma unroll
        for (int ni = 0; ni < 4; ++ni) acc[mi][ni] = MFMA(bfv[ni], af[mi], acc[mi][ni]);
    }
  }
#pragma unroll
  for (int mi = 0; mi < 2; ++mi) {
    epi(m0 + 64 * wm + 32 * mi + r, n0 + 128 * wn, acc[mi][0], acc[mi][1], h);
    epi(m0 + 64 * wm + 32 * mi + r, n0 + 128 * wn + 64, acc[mi][2], acc[mi][3], h);
  }
}

struct EpiF32 {
  float* C; int ldc;
  DI void operator()(int m, int nb, const f32x16& a0, const f32x16& a1, int h) const {
#pragma unroll
    for (int g = 0; g < 4; ++g) {
      *(float4*)(C + (size_t)m * ldc + nb + 8 * g + 4 * h) = make_float4(a0[4 * g], a0[4 * g + 1], a0[4 * g + 2], a0[4 * g + 3]);
      *(float4*)(C + (size_t)m * ldc + nb + 32 + 8 * g + 4 * h) = make_float4(a1[4 * g], a1[4 * g + 1], a1[4 * g + 2], a1[4 * g + 3]);
    }
  }
};
struct EpiBF16 {
  ushort_t* C; int ldc; float scale;
  DI void operator()(int m, int nb, const f32x16& a0, const f32x16& a1, int h) const {
#pragma unroll
    for (int g = 0; g < 4; ++g) {
      *(uint2*)(C + (size_t)m * ldc + nb + 8 * g + 4 * h) = make_uint2(pk2(a0[4 * g] * scale, a0[4 * g + 1] * scale), pk2(a0[4 * g + 2] * scale, a0[4 * g + 3] * scale));
      *(uint2*)(C + (size_t)m * ldc + nb + 32 + 8 * g + 4 * h) = make_uint2(pk2(a1[4 * g] * scale, a1[4 * g + 1] * scale), pk2(a1[4 * g + 2] * scale, a1[4 * g + 3] * scale));
    }
  }
};
struct EpiQ {
  ushort_t* QF;
  DI void one(int m, int nb, f32x16 a, int h) const {
    if ((nb % 96) == 64) {
      const float pos = row_pos(m);
#pragma unroll
      for (int i = 0; i < 8; ++i) {
        const int j = crow(i, h);
        float sn, cs; sincosf(pos * rope_inv(j), &sn, &cs);
        const float x1 = a[i], x2 = a[i + 8];
        a[i] = x1 * cs - x2 * sn; a[i + 8] = x1 * sn + x2 * cs;
      }
    }
#pragma unroll
    for (int g = 0; g < 4; ++g)
      *(uint2*)(QF + (size_t)m * 768 + nb + 8 * g + 4 * h) = make_uint2(pk2(a[4 * g] * QSCALE, a[4 * g + 1] * QSCALE), pk2(a[4 * g + 2] * QSCALE, a[4 * g + 3] * QSCALE));
  }
  DI void operator()(int m, int nb, const f32x16& a0, const f32x16& a1, int h) const { one(m, nb, a0, h); one(m, nb + 32, a1, h); }
};
struct EpiKV {
  ushort_t* KF; ushort_t* VV;
  DI void one(int m, int nb, const f32x16& a, int h) const {
#pragma unroll
    for (int g = 0; g < 4; ++g) {
      const int n = nb + 8 * g + 4 * h;
      uint2 v = make_uint2(pk2(a[4 * g], a[4 * g + 1]), pk2(a[4 * g + 2], a[4 * g + 3]));
      if (n < 512) *(uint2*)(KF + (size_t)m * 768 + (n >> 6) * 96 + (n & 63)) = v;
      else *(uint2*)(VV + (size_t)m * 512 + (n - 512)) = v;
    }
  }
  DI void operator()(int m, int nb, const f32x16& a0, const f32x16& a1, int h) const { one(m, nb, a0, h); one(m, nb + 32, a1, h); }
};
struct EpiSwiGLU {
  ushort_t* ACT;
  DI void operator()(int m, int nb, const f32x16& a0, const f32x16& a1, int h) const {
    const int cb = nb >> 1;
#pragma unroll
    for (int g = 0; g < 4; ++g) {
      float v0 = siluf(a0[4 * g]) * a1[4 * g], v1 = siluf(a0[4 * g + 1]) * a1[4 * g + 1];
      float v2 = siluf(a0[4 * g + 2]) * a1[4 * g + 2], v3 = siluf(a0[4 * g + 3]) * a1[4 * g + 3];
      *(uint2*)(ACT + (size_t)m * DFF + cb + 8 * g + 4 * h) = make_uint2(pk2(v0, v1), pk2(v2, v3));
    }
  }
};

DI void tconv_tile(const float* __restrict__ src, int K, int N, ushort_t* dst, int ldd, int mode, ushort_t* dst2, int kt, int nt, char* smem) {
  float* tile = (float*)smem;
  const int tid = get_tid();
  const int k0 = kt * 64, n0 = nt * 64;
  __syncthreads();
#pragma unroll
  for (int it = 0; it < 16; ++it) {
    int k = it * 4 + (tid >> 6), n = tid & 63;
    float v = (n0 + n < N) ? src[(size_t)(k0 + k) * N + n0 + n] : 0.f;
    tile[k * 65 + n] = v;
  }
  __syncthreads();
#pragma unroll
  for (int it = 0; it < 16; ++it) {
    int n = it * 4 + (tid >> 6), k = tid & 63;
    int gn = n0 + n;
    int row = gn;
    if (mode == 1) row = (gn >> 5) * 64 + (gn & 31);
    else if (mode == 2) row = (gn >> 5) * 64 + 32 + (gn & 31);
    ushort_t v = f2bf(tile[k * 65 + n]);
    dst[(size_t)row * ldd + k0 + k] = v;
    if (mode == 3 && k0 >= 512) dst2[(size_t)gn * 2560 + 2048 + (k0 - 512) + k] = v;
  }
}

DI void norm_store_row(const float (&v)[16], ushort_t* Xrow, ushort_t* XNrow, const float* w, int lane, bool valid) {
  float ss = 0.f;
#pragma unroll
  for (int i = 0; i < 16; ++i) ss += v[i] * v[i];
  ss = wave_sum(ss);
  const float rstd = rsqrtf(ss * (1.f / 1024.f) + EPS);
#pragma unroll
  for (int j = 0; j < 4; ++j) {
    const int c = 4 * lane + 256 * j;
    float4 wv = *(const float4*)(w + c);
    float o0 = valid ? v[4 * j] : 0.f, o1 = valid ? v[4 * j + 1] : 0.f, o2 = valid ? v[4 * j + 2] : 0.f, o3 = valid ? v[4 * j + 3] : 0.f;
    if (Xrow) *(uint2*)(Xrow + c) = make_uint2(pk2(o0, o1), pk2(o2, o3));
    *(uint2*)(XNrow + c) = make_uint2(pk2(o0 * rstd * wv.x, o1 * rstd * wv.y), pk2(o2 * rstd * wv.z, o3 * rstd * wv.w));
  }
}

DI void phase_prep0(const Params& P, char* smem) {
  ushort_t* W = (ushort_t*)(P.ws + O_W);
  const int tid = get_tid();
  if (blockIdx.x == 0 && tid < 64) ((int*)(P.ws + O_CTR))[tid] = 0;
  constexpr int T_IN = 704, T_UQ = 72, T_UK = 32, T_UV = 32, T_O = 256, T_G = 704, T_U = 704, T_D = 704;
  constexpr int TL = T_IN + T_UQ + T_UK + T_UV + T_O + T_G + T_U + T_D;
  for (int t = blockIdx.x; t < TL * 4; t += gridDim.x) {
    const int l = t / TL; int rm = t % TL;
    ushort_t* Wl = W + (size_t)l * E_WL;
    if (rm < T_IN) { tconv_tile(P.w_in + (size_t)l * 1024 * INW, 1024, INW, Wl + E_WT_IN, 1024, 0, nullptr, rm / 44, rm % 44, smem); continue; }
    rm -= T_IN;
    if (rm < T_UQ) { tconv_tile(P.w_uq + (size_t)l * 384 * 768, 384, 768, Wl + E_WT_UQ, 384, 0, nullptr, rm / 12, rm % 12, smem); continue; }
    rm -= T_UQ;
    if (rm < T_UK) { tconv_tile(P.w_uk + (size_t)l * 256 * 512, 256, 512, Wl + E_WT_UKV, 256, 0, nullptr, rm / 8, rm % 8, smem); continue; }
    rm -= T_UK;
    if (rm < T_UV) { tconv_tile(P.w_uv + (size_t)l * 256 * 512, 256, 512, Wl + E_WT_UKV + (size_t)512 * 256, 256, 0, nullptr, rm / 8, rm % 8, smem); continue; }
    rm -= T_UV;
    if (rm < T_O) { tconv_tile(P.w_o + (size_t)l * 1024 * 1024, 1024, 1024, Wl + E_WT_O, 1024, 3, Wl + E_WT_OS, rm / 16, rm % 16, smem); continue; }
    rm -= T_O;
    if (rm < T_G) { tconv_tile(P.w_gate + (size_t)l * 1024 * DFF, 1024, DFF, Wl + E_WT_GU, 1024, 1, nullptr, rm / 44, rm % 44, smem); continue; }
    rm -= T_G;
    if (rm < T_U) { tconv_tile(P.w_up + (size_t)l * 1024 * DFF, 1024, DFF, Wl + E_WT_GU, 1024, 2, nullptr, rm / 44, rm % 44, smem); continue; }
    rm -= T_U;
    tconv_tile(P.w_down + (size_t)l * DFF * 1024, DFF, 1024, Wl + E_WT_DOWN, DFF, 0, nullptr, rm / 16, rm % 16, smem);
  }
  const int gt = blockIdx.x * 256 + tid, gs = gridDim.x * 256;
  for (int l = 0; l < 4; ++l) {
    ushort_t* Wl = W + (size_t)l * E_WL;
    for (int i = gt; i < 384 * 768; i += gs) Wl[E_WUQ_BF + i] = f2bf(P.w_uq[(size_t)l * 384 * 768 + i]);
    for (int i = gt; i < 256 * 512; i += gs) { Wl[E_WUK_BF + i] = f2bf(P.w_uk[(size_t)l * 256 * 512 + i]); Wl[E_WUV_BF + i] = f2bf(P.w_uv[(size_t)l * 256 * 512 + i]); }
  }
  ushort_t* X = (ushort_t*)(P.ws + O_X);
  ushort_t* XN = (ushort_t*)(P.ws + O_XN);
  const int lane = tid & 63, gw = blockIdx.x * 4 + (tid >> 6), nw = gridDim.x * 4;
  for (int row = gw; row < MTOT; row += nw) {
    const bool valid = row_valid(row);
    const float* src = nullptr;
    if (valid) {
      if (row >= SOFF) src = P.x_sample + (size_t)(row - SOFF) * 1024;
      else if (row < POFF + 16) src = P.meta + (size_t)(row - POFF) * 1024;
      else src = P.x_prompt + (size_t)(row - POFF - 16) * 1024;
    }
    float v[16];
#pragma unroll
    for (int j = 0; j < 4; ++j) {
      float4 t = valid ? *(const float4*)(src + 4 * lane + 256 * j) : make_float4(0.f, 0.f, 0.f, 0.f);
      v[4 * j] = t.x; v[4 * j + 1] = t.y; v[4 * j + 2] = t.z; v[4 * j + 3] = t.w;
    }
    norm_store_row(v, X + (size_t)row * 1024, XN + (size_t)row * 1024, P.pre_mix, lane, valid);
  }
}

DI void phase_prep1(const Params& P, char* smem) {
  ushort_t* W = (ushort_t*)(P.ws + O_W);
  for (int t = blockIdx.x; t < 4 * 176; t += gridDim.x) {
    const int l = t / 176; int rm = t % 176;
    ushort_t* Wl = W + (size_t)l * E_WL;
    if (rm < 48) {
      const int hd = rm / 6, mt = (rm % 6) / 3, nt = rm % 3;
      gemm_tile(Wl + E_WUK_BF + hd * 64, 512, Wl + E_WUQ_BF + hd * 96, 768, 64, mt * 128, nt * 128, smem,
                EpiBF16{Wl + E_WABS + (size_t)hd * 256 * 384, 384, 1.f});
    } else {
      rm -= 48;
      const int hd = rm / 16, mt = (rm % 16) / 2, nt = rm % 2;
      gemm_tile(Wl + E_WT_O + hd * 64, 1024, Wl + E_WUV_BF + hd * 64, 512, 64, mt * 128, nt * 128, smem,
                EpiBF16{Wl + E_WT_OS + hd * 256, 2560, 1.f});
    }
  }
}

DI float bflo(unsigned u) { return __uint_as_float(u << 16); }
DI float bfhi(unsigned u) { return __uint_as_float(u & 0xffff0000u); }
DI unsigned ld32(const ushort_t* p) { return *(const unsigned*)p; }
DI void phase_rowpass(const Params& P, int l) {
  const ushort_t* __restrict__ PROJ = (const ushort_t*)(P.ws + O_PROJ);
  ushort_t* CQN = (ushort_t*)(P.ws + O_CQN); ushort_t* CKV = (ushort_t*)(P.ws + O_CKV); ushort_t* KPE = (ushort_t*)(P.ws + O_KPE);
  ushort_t* KF = (ushort_t*)(P.ws + O_KF);
  float* GQ = (float*)(P.ws + O_GQ); float* GK = (float*)(P.ws + O_GK); float* GV = (float*)(P.ws + O_GV);
  float* GB = (float*)(P.ws + O_GB); float* GG = (float*)(P.ws + O_GG);
  const int tid = get_tid(), lane = tid & 63, gw = blockIdx.x * 4 + (tid >> 6), nw = gridDim.x * 4;
  const float* cw = P.conv_w + (size_t)l * 4 * 1536;
  float2 w[12][4];
#pragma unroll
  for (int s = 0; s < 12; ++s)
#pragma unroll
    for (int k = 0; k < 4; ++k) w[s][k] = *(const float2*)(cw + k * 1536 + 128 * s + 2 * lane);
  float2 qn[3], kn[2];
#pragma unroll
  for (int j = 0; j < 3; ++j) qn[j] = *(const float2*)(P.q_norm + l * 384 + 2 * lane + 128 * j);
#pragma unroll
  for (int j = 0; j < 2; ++j) kn[j] = *(const float2*)(P.kv_norm + l * 256 + 2 * lane + 128 * j);
  for (int row = gw; row < MTOT; row += nw) {
    const ushort_t* pr = PROJ + (size_t)row * INP;
    const bool isP = row < SOFF, valid = row_valid(row);
    const int tok = row - POFF, sb = (row - SOFF) >> 4, st = (row - SOFF) & 15;
    const float pos = row_pos(row);
    unsigned t0[12], t1[12], t2[12], t3[12];
    if (valid) {
      const ushort_t* px = pr + OFF_QKV + 2 * lane;
#pragma unroll
      for (int s = 0; s < 12; ++s) t0[s] = ld32(px + 128 * s);
      if (isP) {
#pragma unroll
        for (int s = 0; s < 12; ++s) { t1[s] = ld32(px - INP + 128 * s); t2[s] = ld32(px - 2 * INP + 128 * s); t3[s] = ld32(px - 3 * INP + 128 * s); }
      } else {
        const float* cs = P.state_conv + ((size_t)l * 32 + sb) * 3 * 1536 + 2 * lane;
#pragma unroll
        for (int s = 0; s < 12; ++s) {
          if (st >= 1) t1[s] = ld32(px - INP + 128 * s); else { const float2 f = *(const float2*)(cs + (size_t)(2 + st) * 1536 + 128 * s); t1[s] = pk2(f.x, f.y); }
          if (st >= 2) t2[s] = ld32(px - 2 * INP + 128 * s); else { const float2 f = *(const float2*)(cs + (size_t)(1 + st) * 1536 + 128 * s); t2[s] = pk2(f.x, f.y); }
          if (st >= 3) t3[s] = ld32(px - 3 * INP + 128 * s); else { const float2 f = *(const float2*)(cs + (size_t)(st) * 1536 + 128 * s); t3[s] = pk2(f.x, f.y); }
        }
      }
    } else {
#pragma unroll
      for (int s = 0; s < 12; ++s) { t0[s] = 0u; t1[s] = 0u; t2[s] = 0u; t3[s] = 0u; }
    }
    unsigned cq[3], ck[2];
#pragma unroll
    for (int j = 0; j < 3; ++j) cq[j] = ld32(pr + 2 * lane + 128 * j);
#pragma unroll
    for (int j = 0; j < 2; ++j) ck[j] = ld32(pr + OFF_KV + 2 * lane + 128 * j);
    const float xr = bf2f(pr[OFF_PE + (lane & 31)]);
    const float bbv = bf2f(pr[OFF_B + (lane & 3)]), aav = bf2f(pr[OFF_A + (lane & 3)]);
    {
      float ss = 0.f;
#pragma unroll
      for (int j = 0; j < 3; ++j) { const float a = bflo(cq[j]), b = bfhi(cq[j]); ss += a * a + b * b; }
      ss = wave_sum(ss);
      const float rstd = rsqrtf(ss * (1.f / 384.f) + EPS);
#pragma unroll
      for (int j = 0; j < 3; ++j)
        *(unsigned*)(CQN + (size_t)row * 384 + 2 * lane + 128 * j) = pk2(bflo(cq[j]) * rstd * qn[j].x, bfhi(cq[j]) * rstd * qn[j].y);
    }
    {
      float ss = 0.f;
#pragma unroll
      for (int j = 0; j < 2; ++j) { const float a = bflo(ck[j]), b = bfhi(ck[j]); ss += a * a + b * b; }
      ss = wave_sum(ss);
      const float rstd = rsqrtf(ss * (1.f / 256.f) + EPS);
      float* olat = nullptr;
      if (valid) olat = isP ? P.out + OUT_PLAT + ((size_t)l * LTOK + tok) * 256 : P.out + OUT_SLAT + (((size_t)l * 32 + sb) * 16 + st) * 256;
#pragma unroll
      for (int j = 0; j < 2; ++j) {
        const float o0 = bflo(ck[j]) * rstd * kn[j].x, o1 = bfhi(ck[j]) * rstd * kn[j].y;
        *(unsigned*)(CKV + (size_t)row * 256 + 2 * lane + 128 * j) = pk2(o0, o1);
        if (valid) *(float2*)(olat + 2 * lane + 128 * j) = make_float2(o0, o1);
      }
    }
    {
      const float pt = __shfl_xor(xr, 16, 64);
      float sn, cs; sincosf(pos * rope_inv(lane & 15), &sn, &cs);
      const float o = ((lane & 31) < 16) ? (xr * cs - pt * sn) : (pt * sn + xr * cs);
      if (lane < 32) {
        const ushort_t ob = f2bf(o);
        KPE[(size_t)row * 32 + lane] = ob;
        if (valid) {
          if (isP) P.out[OUT_PPE + ((size_t)l * LTOK + tok) * 32 + lane] = o;
          else P.out[OUT_SPE + (((size_t)l * 32 + sb) * 16 + st) * 32 + lane] = o;
        }
        if (isP) {
#pragma unroll
          for (int hh = 0; hh < 8; ++hh) KF[(size_t)row * 768 + hh * 96 + 64 + lane] = ob;
        }
      }
    }
    {
      float* cso = nullptr;
      if (valid) {
        if (isP) { if (row >= PEND - 3) cso = P.out + OUT_PCONV + ((size_t)l * 3 + (row - (PEND - 3))) * 1536; }
        else if (st >= 13) cso = P.out + OUT_SCONV + (((size_t)l * 32 + sb) * 3 + (st - 13)) * 1536;
      }
#pragma unroll
      for (int s = 0; s < 12; ++s) {
        const float x0a = bflo(t0[s]), x0b = bfhi(t0[s]);
        if (cso) *(float2*)(cso + 128 * s + 2 * lane) = make_float2(x0a, x0b);
        const float ya = w[s][3].x * x0a + w[s][2].x * bflo(t1[s]) + w[s][1].x * bflo(t2[s]) + w[s][0].x * bflo(t3[s]);
        const float yb = w[s][3].y * x0b + w[s][2].y * bfhi(t1[s]) + w[s][1].y * bfhi(t2[s]) + w[s][0].y * bfhi(t3[s]);
        const float a = siluf(ya), b = siluf(yb);
        if (s < 8) {
          const float ss = wave_sum(a * a + b * b);
          float sc = rsqrtf(ss + EPS);
          if (s < 4) sc *= 0.08838834764831845f;
          float* dst = (s < 4 ? GQ : GK) + (size_t)row * 512 + (s & 3) * 128 + 2 * lane;
          *(float2*)dst = make_float2(a * sc, b * sc);
        } else {
          *(float2*)(GV + (size_t)row * 512 + (s - 8) * 128 + 2 * lane) = make_float2(a, b);
        }
      }
    }
    if (lane < 4) {
      float beta = 0.f, g = 0.f;
      if (valid) {
        const float aa = aav + P.dt_bias[l * 4 + lane];
        beta = 1.f / (1.f + expf(-bbv));
        const float sp = aa > 20.f ? aa : log1pf(expf(aa));
        g = -expf(P.a_log[l * 4 + lane]) * sp;
      }
      GB[(size_t)row * 4 + lane] = beta; GG[(size_t)row * 4 + lane] = g;
    }
  }
}

DI void gdn_prep(const Params& P, int item, char* smem) {
  const float* GQ = (const float*)(P.ws + O_GQ); const float* GK = (const float*)(P.ws + O_GK); const float* GV = (const float*)(P.ws + O_GV);
  const float* GB = (const float*)(P.ws + O_GB); const float* GG = (const float*)(P.ws + O_GG);
  float* UT = (float*)(P.ws + O_UT) + (size_t)item * 8192;
  ushort_t* WN = (ushort_t*)(P.ws + O_WN) + (size_t)item * 8192;
  ushort_t* QG = (ushort_t*)(P.ws + O_QG) + (size_t)item * 8192;
  ushort_t* AN = (ushort_t*)(P.ws + O_AN) + (size_t)item * 16384;
  float* BN = (float*)(P.ws + O_BN) + (size_t)item * 16384;
  ushort_t* WTs = (ushort_t*)smem;
  ushort_t* UTs = WTs + 128 * 72;
  ushort_t* KDTs = (ushort_t*)(smem + 53248);
  ushort_t* QKM = (ushort_t*)(P.ws + O_QKM) + (size_t)item * 4096;
  float* GL = (float*)(P.ws + O_GL);
  ushort_t* Ks = (ushort_t*)smem;
  ushort_t* Qs = Ks + 64 * 136;
  float* Ms = (float*)(smem + 34816);
  float* gcs = (float*)(smem + 52224);
  float* bts = gcs + 64;
  float* egs = bts + 64;
  const int tid = get_tid(), lane = tid & 63, wave = tid >> 6, r = lane & 31, h = lane >> 5;
  const int n = item >> 2, hd = item & 3, row0 = 64 * n;
  __syncthreads();
  if (wave == 0) {
    float x = GG[(size_t)(row0 + lane) * 4 + hd];
    const float bt = GB[(size_t)(row0 + lane) * 4 + hd];
#pragma unroll
    for (int d = 1; d < 64; d <<= 1) { float y = __shfl_up(x, d, 64); if (lane >= d) x += y; }
    gcs[lane] = x; bts[lane] = bt; egs[lane] = __expf(x);
    if (lane == 63) GL[item] = __expf(x);
  }
#pragma unroll
  for (int i = 0; i < 8; ++i) {
    const int idx = tid + 256 * i, row = idx >> 5, c4 = (idx & 31) * 4;
    const float4 kv = *(const float4*)(GK + (size_t)(row0 + row) * 512 + hd * 128 + c4);
    const float4 qv = *(const float4*)(GQ + (size_t)(row0 + row) * 512 + hd * 128 + c4);
    *(uint2*)(Ks + row * 136 + c4) = make_uint2(pk2(kv.x, kv.y), pk2(kv.z, kv.w));
    *(uint2*)(Qs + row * 136 + c4) = make_uint2(pk2(qv.x, qv.y), pk2(qv.z, qv.w));
  }
  __syncthreads();
  {
    const int bi = wave >> 1, bj = wave & 1;
    f32x16 kk = zero16(), qk = zero16();
#pragma unroll
    for (int s = 0; s < 8; ++s) {
      const bf16x8 bfr = *(const bf16x8*)(Ks + (32 * bj + r) * 136 + 16 * s + 8 * h);
      const bf16x8 ak = *(const bf16x8*)(Ks + (32 * bi + r) * 136 + 16 * s + 8 * h);
      const bf16x8 aq = *(const bf16x8*)(Qs + (32 * bi + r) * 136 + 16 * s + 8 * h);
      kk = MFMA(ak, bfr, kk); qk = MFMA(aq, bfr, qk);
    }
    const int j = 32 * bj + r;
    const float gcj = gcs[j];
#pragma unroll
    for (int rg = 0; rg < 16; ++rg) {
      const int i = 32 * bi + crow(rg, h);
      const float dec = (j <= i) ? __expf(gcs[i] - gcj) : 0.f;
      Ms[j * 68 + i] = (j < i) ? bts[i] * kk[rg] * dec : 0.f;
      QKM[i * 64 + j] = f2bf(qk[rg] * dec);
    }
  }
#pragma unroll
  for (int i = 0; i < 8; ++i) {
    const int idx = tid + 256 * i, row = idx >> 5, c4 = (idx & 31) * 4;
    const float4 qv = *(const float4*)(GQ + (size_t)(row0 + row) * 512 + hd * 128 + c4);
    const float e = egs[row];
    *(uint2*)(QG + row * 128 + c4) = make_uint2(pk2(qv.x * e, qv.y * e), pk2(qv.z * e, qv.w * e));
  }
  {
    const int dk = tid & 127, ch = tid >> 7;
    const float gl = gcs[63];
    unsigned pkd[16];
#pragma unroll
    for (int cc = 0; cc < 16; ++cc) {
      const int c0 = 32 * ch + 2 * cc;
      const float a = GK[(size_t)(row0 + c0) * 512 + hd * 128 + dk] * __expf(gl - gcs[c0]);
      const float b = GK[(size_t)(row0 + c0 + 1) * 512 + hd * 128 + dk] * __expf(gl - gcs[c0 + 1]);
      pkd[cc] = pk2(a, b);
    }
#pragma unroll
    for (int q4 = 0; q4 < 4; ++q4)
      *(uint4*)(KDTs + dk * 72 + 32 * ch + 8 * q4) = make_uint4(pkd[4 * q4], pkd[4 * q4 + 1], pkd[4 * q4 + 2], pkd[4 * q4 + 3]);
  }
  __syncthreads();
  {
    const int col = tid & 127;
    const bool isW = tid >= 128;
    float x[64];
    const float* rsrc = (isW ? GK : GV) + (size_t)row0 * 512 + hd * 128 + col;
#pragma unroll
    for (int c = 0; c < 64; ++c) x[c] = rsrc[(size_t)c * 512];
#pragma unroll
    for (int c = 0; c < 64; ++c) x[c] *= bts[c] * (isW ? egs[c] : 1.f);
#pragma unroll
    for (int j = 0; j < 63; ++j) {
      f32x4v mc[16];
#pragma unroll
      for (int q4 = ((j + 1) >> 2); q4 < 16; ++q4) mc[q4] = *(const f32x4v*)(Ms + j * 68 + 4 * q4);
      __builtin_amdgcn_sched_barrier(0);
      const float xj = x[j];
#pragma unroll
      for (int q4 = ((j + 1) >> 2); q4 < 16; ++q4) {
        const int i4 = 4 * q4;
        if (i4 + 0 > j) x[i4 + 0] -= mc[q4].x * xj;
        if (i4 + 1 > j) x[i4 + 1] -= mc[q4].y * xj;
        if (i4 + 2 > j) x[i4 + 2] -= mc[q4].z * xj;
        if (i4 + 3 > j) x[i4 + 3] -= mc[q4].w * xj;
      }
      __builtin_amdgcn_sched_barrier(0);
    }
    __syncthreads();
    if (!isW) {
#pragma unroll
      for (int c = 0; c < 64; c += 4) *(float4*)(UT + col * 64 + c) = make_float4(x[c], x[c + 1], x[c + 2], x[c + 3]);
#pragma unroll
      for (int c = 0; c < 64; c += 8)
        *(uint4*)(UTs + col * 72 + c) = make_uint4(pk2(x[c], x[c + 1]), pk2(x[c + 2], x[c + 3]), pk2(x[c + 4], x[c + 5]), pk2(x[c + 6], x[c + 7]));
    } else {
#pragma unroll
      for (int c = 0; c < 64; ++c) WN[c * 128 + col] = f2bf(-x[c]);
#pragma unroll
      for (int c = 0; c < 64; c += 8)
        *(uint4*)(WTs + col * 72 + c) = make_uint4(pk2(-x[c], -x[c + 1]), pk2(-x[c + 2], -x[c + 3]), pk2(-x[c + 4], -x[c + 5]), pk2(-x[c + 6], -x[c + 7]));
    }
  }
  __syncthreads();
  {
    const int bi = wave;
    const float gl = __expf(gcs[63]);
    bf16x8 kf[4];
#pragma unroll
    for (int sx = 0; sx < 4; ++sx) kf[sx] = *(const bf16x8*)(KDTs + (32 * bi + r) * 72 + 16 * sx + 8 * h);
#pragma unroll
    for (int bj = 0; bj < 4; ++bj) {
      f32x16 ab = zero16(), aa = zero16();
#pragma unroll
      for (int sx = 0; sx < 4; ++sx) {
        ab = MFMA(kf[sx], *(const bf16x8*)(UTs + (32 * bj + r) * 72 + 16 * sx + 8 * h), ab);
        aa = MFMA(*(const bf16x8*)(WTs + (32 * bj + r) * 72 + 16 * sx + 8 * h), kf[sx], aa);
      }
#pragma unroll
      for (int g = 0; g < 4; ++g) {
        *(float4*)(BN + (((bi * 4 + bj) * 4 + g) * 64 + lane) * 4) = make_float4(ab[4 * g], ab[4 * g + 1], ab[4 * g + 2], ab[4 * g + 3]);
        float a0 = aa[4 * g], a1 = aa[4 * g + 1], a2 = aa[4 * g + 2], a3 = aa[4 * g + 3];
        if (bi == bj) {
          const int jb = 8 * g + 4 * h;
          if (jb == r) a0 += gl;
          if (jb + 1 == r) a1 += gl;
          if (jb + 2 == r) a2 += gl;
          if (jb + 3 == r) a3 += gl;
        }
        *(uint2*)(AN + (32 * bi + r) * 128 + 32 * bj + 8 * g + 4 * h) = make_uint2(pk2(a0, a1), pk2(a2, a3));
      }
    }
  }
}

DI void gdn_sample(const Params& P, int l, int item, char* smem) {
  const float* GQ = (const float*)(P.ws + O_GQ); const float* GK = (const float*)(P.ws + O_GK); const float* GV = (const float*)(P.ws + O_GV);
  const float* GB = (const float*)(P.ws + O_GB); const float* GG = (const float*)(P.ws + O_GG);
  float* OG = (float*)(P.ws + O_OG);
  float* ks = (float*)smem;
  float* qs = ks + 2048;
  float* vs = qs + 2048;
  float* egb = vs + 2048;
  float* red = egb + 32;
  float* red2 = red + 256;
  const int tid = get_tid(), dv = tid & 127, half = tid >> 7;
  const int b = item >> 2, hd = item & 3, row0 = SOFF + 16 * b;
  __syncthreads();
#pragma unroll
  for (int i = 0; i < 8; ++i) {
    const int idx = tid + 256 * i, t = idx >> 7, c = idx & 127;
    ks[idx] = GK[(size_t)(row0 + t) * 512 + hd * 128 + c];
    qs[idx] = GQ[(size_t)(row0 + t) * 512 + hd * 128 + c];
    vs[idx] = GV[(size_t)(row0 + t) * 512 + hd * 128 + c];
  }
  if (tid < 16) { egb[2 * tid] = expf(GG[(size_t)(row0 + tid) * 4 + hd]); egb[2 * tid + 1] = GB[(size_t)(row0 + tid) * 4 + hd]; }
  const size_t sbase = ((((size_t)l * 32 + b) * 4 + hd) * 128 + 64 * half) * 128 + dv;
  float S[64];
#pragma unroll
  for (int i = 0; i < 64; ++i) S[i] = P.state_gdn[sbase + (size_t)i * 128];
  __syncthreads();
  for (int t = 0; t < 16; ++t) {
    const float eg = egb[2 * t], bt = egb[2 * t + 1];
    const f32x4v* kt4 = (const f32x4v*)(ks + t * 128 + 64 * half);
    const f32x4v* qt4 = (const f32x4v*)(qs + t * 128 + 64 * half);
    f32x4v kv[16];
#pragma unroll
    for (int i4 = 0; i4 < 16; ++i4) kv[i4] = kt4[i4];
    float a0 = 0.f, a1 = 0.f, a2 = 0.f, a3 = 0.f;
#pragma unroll
    for (int i4 = 0; i4 < 16; ++i4) {
      S[4 * i4] *= eg; S[4 * i4 + 1] *= eg; S[4 * i4 + 2] *= eg; S[4 * i4 + 3] *= eg;
      a0 += kv[i4].x * S[4 * i4]; a1 += kv[i4].y * S[4 * i4 + 1]; a2 += kv[i4].z * S[4 * i4 + 2]; a3 += kv[i4].w * S[4 * i4 + 3];
    }
    red[half * 128 + dv] = (a0 + a1) + (a2 + a3);
    __syncthreads();
    const float kS = red[dv] + red[128 + dv];
    const float d = bt * (vs[t * 128 + dv] - kS);
    float b0 = 0.f, b1 = 0.f, b2 = 0.f, b3 = 0.f;
#pragma unroll
    for (int i4 = 0; i4 < 16; ++i4) {
      const f32x4v qv = qt4[i4];
      S[4 * i4] += kv[i4].x * d; S[4 * i4 + 1] += kv[i4].y * d; S[4 * i4 + 2] += kv[i4].z * d; S[4 * i4 + 3] += kv[i4].w * d;
      b0 += qv.x * S[4 * i4]; b1 += qv.y * S[4 * i4 + 1]; b2 += qv.z * S[4 * i4 + 2]; b3 += qv.w * S[4 * i4 + 3];
    }
    red2[half * 128 + dv] = (b0 + b1) + (b2 + b3);
    __syncthreads();
    if (half == 0) OG[(size_t)(row0 + t) * 512 + hd * 128 + dv] = red2[dv] + red2[128 + dv];
  }
#pragma unroll
  for (int i = 0; i < 64; ++i) P.out[OUT_SGDN + sbase + (size_t)i * 128] = S[i];
}

DI void gdn_scan(const Params& P, int l, int item, char* smem) {
  const ushort_t* ANg = (const ushort_t*)(P.ws + O_AN);
  const float* BNg = (const float*)(P.ws + O_BN);
  u32x4* SPK = (u32x4*)(P.ws + O_SPK);
  ushort_t* ST = (ushort_t*)smem;
  const int tid = get_tid(), lane = tid & 63, b = tid >> 6, r = lane & 31, h = lane >> 5;
  const int hd = item >> 2, dvs = item & 3;
  __syncthreads();
  for (int i = tid; i < 32 * 136 / 2; i += 256) ((unsigned*)ST)[i] = 0u;
  {
    const u32x4 z = {0u, 0u, 0u, 0u};
    SPK[((((size_t)(0 * 4 + hd) * 4 + dvs) * 4 + b) * 2 + 0) * 64 + lane] = z;
    SPK[((((size_t)(0 * 4 + hd) * 4 + dvs) * 4 + b) * 2 + 1) * 64 + lane] = z;
  }
  bf16x8 Ac[8]; f32x16 Bc;
  {
    const int it = hd;
#pragma unroll
    for (int sx = 0; sx < 8; ++sx) Ac[sx] = *(const bf16x8*)(ANg + (size_t)it * 16384 + (32 * b + r) * 128 + 16 * sx + 8 * h);
#pragma unroll
    for (int g = 0; g < 4; ++g) {
      const float4 t = *(const float4*)(BNg + (size_t)it * 16384 + (((b * 4 + dvs) * 4 + g) * 64 + lane) * 4);
      Bc[4 * g] = t.x; Bc[4 * g + 1] = t.y; Bc[4 * g + 2] = t.z; Bc[4 * g + 3] = t.w;
    }
  }
  f32x16 acc = zero16();
  for (int n = 0; n < NCH; ++n) {
    const int cur = n & 1;
    bf16x8 An[8]; f32x16 Bn;
    {
      const int it = (n + 1 < NCH ? n + 1 : n) * 4 + hd;
#pragma unroll
      for (int sx = 0; sx < 8; ++sx) An[sx] = *(const bf16x8*)(ANg + (size_t)it * 16384 + (32 * b + r) * 128 + 16 * sx + 8 * h);
#pragma unroll
      for (int g = 0; g < 4; ++g) {
        const float4 t = *(const float4*)(BNg + (size_t)it * 16384 + (((b * 4 + dvs) * 4 + g) * 64 + lane) * 4);
        Bn[4 * g] = t.x; Bn[4 * g + 1] = t.y; Bn[4 * g + 2] = t.z; Bn[4 * g + 3] = t.w;
      }
    }
    __syncthreads();
    const ushort_t* Sc = ST + cur * (32 * 136);
    f32x16 a0 = Bc, a1 = zero16();
#pragma unroll
    for (int sx = 0; sx < 8; sx += 2) {
      a0 = MFMA(Ac[sx], *(const bf16x8*)(Sc + r * 136 + 16 * sx + 8 * h), a0);
      a1 = MFMA(Ac[sx + 1], *(const bf16x8*)(Sc + r * 136 + 16 * (sx + 1) + 8 * h), a1);
    }
#pragma unroll
    for (int i = 0; i < 16; ++i) acc[i] = a0[i] + a1[i];
    const u32x4 p0 = __builtin_bit_cast(u32x4, pack8<0>(acc));
    const u32x4 p1 = __builtin_bit_cast(u32x4, pack8<1>(acc));
    ushort_t* Sn = ST + (cur ^ 1) * (32 * 136) + r * 136 + 32 * b + 4 * h;
    *(uint2*)(Sn) = make_uint2(p0[0], p0[1]);
    *(uint2*)(Sn + 8) = make_uint2(p0[2], p0[3]);
    *(uint2*)(Sn + 16) = make_uint2(p1[0], p1[1]);
    *(uint2*)(Sn + 24) = make_uint2(p1[2], p1[3]);
    if (n + 1 < NCH) {
      SPK[((((size_t)((n + 1) * 4 + hd) * 4 + dvs) * 4 + b) * 2 + 0) * 64 + lane] = p0;
      SPK[((((size_t)((n + 1) * 4 + hd) * 4 + dvs) * 4 + b) * 2 + 1) * 64 + lane] = p1;
    }
#pragma unroll
    for (int sx = 0; sx < 8; ++sx) Ac[sx] = An[sx];
    Bc = Bn;
  }
#pragma unroll
  for (int i = 0; i < 16; ++i)
    P.out[OUT_PGDN + (((size_t)l * 4 + hd) * 128 + 32 * b + crow(i, h)) * 128 + 32 * dvs + r] = acc[i];
}

DI void gdn_out(const Params& P, int l, int item, char* smem) {
  const float* UTg = (const float*)(P.ws + O_UT);
  const ushort_t* WNg = (const ushort_t*)(P.ws + O_WN); const ushort_t* QGg = (const ushort_t*)(P.ws + O_QG);
  const ushort_t* QKMg = (const ushort_t*)(P.ws + O_QKM);
  const u32x4* SPK = (const u32x4*)(P.ws + O_SPK);
  const ushort_t* PROJ = (const ushort_t*)(P.ws + O_PROJ);
  ushort_t* MIX = (ushort_t*)(P.ws + O_MIX);
  ushort_t* WNs = (ushort_t*)smem;
  ushort_t* QGs = WNs + 64 * 136;
  ushort_t* QKs = QGs + 64 * 136;
  float* Os = (float*)smem;
  const int tid = get_tid(), lane = tid & 63, wave = tid >> 6, r = lane & 31, h = lane >> 5;
  const int n = item >> 2, hd = item & 3, dv0 = 32 * wave;
  __syncthreads();
  {
    const ushort_t* wsrc = WNg + (size_t)item * 8192; const ushort_t* qsrc = QGg + (size_t)item * 8192;
    const ushort_t* msrc = QKMg + (size_t)item * 4096;
#pragma unroll
    for (int i = 0; i < 4; ++i) {
      const int c = tid + 256 * i;
      *(u32x4*)(WNs + (c >> 4) * 136 + (c & 15) * 8) = *(const u32x4*)(wsrc + c * 8);
      *(u32x4*)(QGs + (c >> 4) * 136 + (c & 15) * 8) = *(const u32x4*)(qsrc + c * 8);
    }
#pragma unroll
    for (int i = 0; i < 2; ++i) {
      const int c = tid + 256 * i;
      *(u32x4*)(QKs + (c >> 3) * 72 + (c & 7) * 8) = *(const u32x4*)(msrc + c * 8);
    }
  }
  f32x16 vn[2];
#pragma unroll
  for (int cb = 0; cb < 2; ++cb)
#pragma unroll
    for (int g = 0; g < 4; ++g) {
      const float4 t = *(const float4*)(UTg + (size_t)item * 8192 + (dv0 + r) * 64 + 32 * cb + 8 * g + 4 * h);
      vn[cb][4 * g] = t.x; vn[cb][4 * g + 1] = t.y; vn[cb][4 * g + 2] = t.z; vn[cb][4 * g + 3] = t.w;
    }
  bf16x8 Sp[4][2];
#pragma unroll
  for (int b = 0; b < 4; ++b)
#pragma unroll
    for (int sx = 0; sx < 2; ++sx) Sp[b][sx] = __builtin_bit_cast(bf16x8, SPK[((((size_t)item * 4 + wave) * 4 + b) * 2 + sx) * 64 + lane]);
  __syncthreads();
#pragma unroll
  for (int cb = 0; cb < 2; ++cb)
#pragma unroll
    for (int b = 0; b < 4; ++b)
#pragma unroll
      for (int sx = 0; sx < 2; ++sx) vn[cb] = MFMA(fragP(WNs + (32 * cb + r) * 136 + 32 * b + 16 * sx, h), Sp[b][sx], vn[cb]);
  bf16x8 Vp[2][2];
  Vp[0][0] = pack8<0>(vn[0]); Vp[0][1] = pack8<1>(vn[0]); Vp[1][0] = pack8<0>(vn[1]); Vp[1][1] = pack8<1>(vn[1]);
  f32x16 o[2];
#pragma unroll
  for (int cb = 0; cb < 2; ++cb) {
    o[cb] = zero16();
#pragma unroll
    for (int b = 0; b < 4; ++b)
#pragma unroll
      for (int sx = 0; sx < 2; ++sx) o[cb] = MFMA(fragP(QGs + (32 * cb + r) * 136 + 32 * b + 16 * sx, h), Sp[b][sx], o[cb]);
#pragma unroll
    for (int cb2 = 0; cb2 <= cb; ++cb2)
#pragma unroll
      for (int sx = 0; sx < 2; ++sx) o[cb] = MFMA(fragP(QKs + (32 * cb + r) * 72 + 32 * cb2 + 16 * sx, h), Vp[cb2][sx], o[cb]);
  }
  __syncthreads();
#pragma unroll
  for (int cb = 0; cb < 2; ++cb)
#pragma unroll
    for (int i = 0; i < 16; ++i) Os[(32 * cb + crow(i, h)) * 132 + dv0 + r] = o[cb][i];
  __syncthreads();
  const float gw0 = P.gdn_norm[l * 128 + lane], gw1 = P.gdn_norm[l * 128 + 64 + lane];
#pragma unroll 4
  for (int rr = 0; rr < 16; ++rr) {
    const int c = 16 * wave + rr, row = 64 * n + c;
    const float o0 = Os[c * 132 + lane], o1 = Os[c * 132 + 64 + lane];
    const float z0 = bf2f(PROJ[(size_t)row * INP + OFF_Z + hd * 128 + lane]), z1 = bf2f(PROJ[(size_t)row * INP + OFF_Z + hd * 128 + 64 + lane]);
    const float ss = wave_sum(o0 * o0 + o1 * o1);
    const float rstd = rsqrtf(ss * (1.f / 128.f) + EPS);
    MIX[(size_t)row * 1024 + 512 + hd * 128 + lane] = f2bf(o0 * rstd * gw0 * siluf(z0));
    MIX[(size_t)row * 1024 + 512 + hd * 128 + 64 + lane] = f2bf(o1 * rstd * gw1 * siluf(z1));
  }
}

template <int NDB>
DI void softmax_pv(f32x16 (&st)[2], f32x16 (&o)[NDB], float& m, float& l, f32x16& negm, bool first, const ushort_t* Vs, int vpitch, int vcol0, int lane) {
  const int h = lane >> 5, i16 = lane & 15, q = i16 >> 2, p = i16 & 3, blk = (lane >> 4) & 1;
  const ushort_t* vb = Vs + (4 * h + q) * vpitch + vcol0 + 16 * blk + 4 * p;
  s16x4 vf[2][NDB][4];
#pragma unroll
  for (int kb = 0; kb < 2; ++kb)
#pragma unroll
    for (int db = 0; db < NDB; ++db)
#pragma unroll
      for (int j = 0; j < 4; ++j) vf[kb][db][j] = vtr(vb + (32 * kb + 8 * j) * vpitch + 32 * db);
  __builtin_amdgcn_sched_barrier(0);
  float mt = st[0][0];
#pragma unroll
  for (int kb = 0; kb < 2; ++kb)
#pragma unroll
    for (int i = 0; i < 16; ++i) mt = fmaxf(mt, st[kb][i]);
  mt = swap_max(mt);
  if (__builtin_amdgcn_ballot_w64(first || (mt > 8.f)) != 0ull) {
    const float d = first ? mt : fmaxf(mt, 0.f);
    const float alpha = first ? 1.f : __builtin_amdgcn_exp2f(-d);
    m += d;
    l *= alpha;
#pragma unroll
    for (int db = 0; db < NDB; ++db)
#pragma unroll
      for (int i = 0; i < 16; ++i) o[db][i] *= alpha;
#pragma unroll
    for (int kb = 0; kb < 2; ++kb)
#pragma unroll
      for (int i = 0; i < 16; ++i) st[kb][i] -= d;
    const float nm = -m;
#pragma unroll
    for (int i = 0; i < 16; ++i) negm[i] = nm;
  }
  float ls = 0.f;
#pragma unroll
  for (int kb = 0; kb < 2; ++kb)
#pragma unroll
    for (int i = 0; i < 16; ++i) { const float pv = __builtin_amdgcn_exp2f(st[kb][i]); st[kb][i] = pv; ls += pv; }
  l += ls;
  __builtin_amdgcn_s_setprio(1);
#pragma unroll
  for (int kb = 0; kb < 2; ++kb) {
    const bf16x8 p0 = pack8<0>(st[kb]);
    const bf16x8 p1 = pack8<1>(st[kb]);
#pragma unroll
    for (int db = 0; db < NDB; ++db) {
      o[db] = MFMA(cat8(vf[kb][db][0], vf[kb][db][1]), p0, o[db]);
      o[db] = MFMA(cat8(vf[kb][db][2], vf[kb][db][3]), p1, o[db]);
    }
  }
  __builtin_amdgcn_s_setprio(0);
}

template <int NDB>
DI void softmax_pv_simple(f32x16 (&st)[2], f32x16 (&o)[NDB], float& m, float& l, const ushort_t* Vs, int vpitch, int vcol0, int lane) {
  const int h = lane >> 5, i16 = lane & 15, q = i16 >> 2, p = i16 & 3, blk = (lane >> 4) & 1;
  float mt = st[0][0];
#pragma unroll
  for (int kb = 0; kb < 2; ++kb)
#pragma unroll
    for (int i = 0; i < 16; ++i) mt = fmaxf(mt, st[kb][i]);
  mt = swap_max(mt);
  const float mn = fmaxf(m, mt);
  const float alpha = __builtin_amdgcn_exp2f(m - mn);
  m = mn;
  float ls = 0.f;
#pragma unroll
  for (int kb = 0; kb < 2; ++kb)
#pragma unroll
    for (int i = 0; i < 16; ++i) { const float pv = __builtin_amdgcn_exp2f(st[kb][i] - mn); st[kb][i] = pv; ls += pv; }
  l = l * alpha + ls;
#pragma unroll
  for (int db = 0; db < NDB; ++db)
#pragma unroll
    for (int i = 0; i < 16; ++i) o[db][i] *= alpha;
  const ushort_t* vb = Vs + (4 * h + q) * vpitch + vcol0 + 16 * blk + 4 * p;
#pragma unroll
  for (int kb = 0; kb < 2; ++kb) {
    const bf16x8 p0 = pack8<0>(st[kb]);
    const bf16x8 p1 = pack8<1>(st[kb]);
#pragma unroll
    for (int db = 0; db < NDB; ++db) {
      const ushort_t* v0 = vb + (32 * kb) * vpitch + 32 * db;
      o[db] = MFMA(cat8(vtr(v0), vtr(v0 + 8 * vpitch)), p0, o[db]);
      o[db] = MFMA(cat8(vtr(v0 + 16 * vpitch), vtr(v0 + 24 * vpitch)), p1, o[db]);
    }
  }
}

DI void attn_prompt(const Params& P, int qt, int head, char* smem) {
  const ushort_t* QF = (const ushort_t*)(P.ws + O_QF); const ushort_t* KF = (const ushort_t*)(P.ws + O_KF);
  const ushort_t* VV = (const ushort_t*)(P.ws + O_VV); ushort_t* MIX = (ushort_t*)(P.ws + O_MIX);
  constexpr int KP = 104, VP = 72;
  ushort_t* Kb = (ushort_t*)smem;
  ushort_t* Vb = Kb + 2 * 64 * KP;
  const int tid = get_tid(), lane = tid & 63, wave = tid >> 6, r = lane & 31, h = lane >> 5;
  const int qrow = 128 * qt + 32 * wave + r;
  const int cq = 2 * qt + (wave >> 1);
  const int ntile = 2 * qt + 2;
  bf16x8 qf[6];
#pragma unroll
  for (int s = 0; s < 6; ++s) qf[s] = *(const bf16x8*)(QF + (size_t)qrow * 768 + head * 96 + 16 * s + 8 * h);
  f32x16 o[2]; o[0] = zero16(); o[1] = zero16();
  float m = 0.f, l = 0.f;
  f32x16 negm = zero16();
  u32x4 rk0, rk1, rk2, rv0, rv1;
  u32x4 sk0, sk1, sk2, sv0, sv1;
  const int kr0 = tid / 12, kc0 = tid % 12, kr1 = (tid + 256) / 12, kc1 = (tid + 256) % 12, kr2 = (tid + 512) / 12, kc2 = (tid + 512) % 12;
  const int vr0 = tid >> 3, vc0 = tid & 7, vr1 = (tid + 256) >> 3;
  const ushort_t* kg0 = KF + (size_t)kr0 * 768 + head * 96 + kc0 * 8;
  const ushort_t* kg1 = KF + (size_t)kr1 * 768 + head * 96 + kc1 * 8;
  const ushort_t* kg2 = KF + (size_t)kr2 * 768 + head * 96 + kc2 * 8;
  const ushort_t* vg0 = VV + (size_t)vr0 * 512 + head * 64 + vc0 * 8;
  const ushort_t* vg1 = VV + (size_t)vr1 * 512 + head * 64 + vc0 * 8;
#define ATT_GLOAD0(kt) { const size_t ko = (size_t)(kt) * 64 * 768, vo = (size_t)(kt) * 64 * 512; \
    rk0 = *(const u32x4*)(kg0 + ko); rk1 = *(const u32x4*)(kg1 + ko); rk2 = *(const u32x4*)(kg2 + ko); rv0 = *(const u32x4*)(vg0 + vo); rv1 = *(const u32x4*)(vg1 + vo); }
#define ATT_GLOAD1(kt) { const size_t ko = (size_t)(kt) * 64 * 768, vo = (size_t)(kt) * 64 * 512; \
    sk0 = *(const u32x4*)(kg0 + ko); sk1 = *(const u32x4*)(kg1 + ko); sk2 = *(const u32x4*)(kg2 + ko); sv0 = *(const u32x4*)(vg0 + vo); sv1 = *(const u32x4*)(vg1 + vo); }
#define ATT_LSTORE0(buf) { ushort_t* kd = Kb + (buf) * 64 * KP; ushort_t* vd = Vb + (buf) * 64 * VP; \
    *(u32x4*)(kd + kr0 * KP + kc0 * 8) = rk0; *(u32x4*)(kd + kr1 * KP + kc1 * 8) = rk1; *(u32x4*)(kd + kr2 * KP + kc2 * 8) = rk2; \
    *(u32x4*)(vd + vr0 * VP + vc0 * 8) = rv0; *(u32x4*)(vd + vr1 * VP + vc0 * 8) = rv1; }
#define ATT_LSTORE1(buf) { ushort_t* kd = Kb + (buf) * 64 * KP; ushort_t* vd = Vb + (buf) * 64 * VP; \
    *(u32x4*)(kd + kr0 * KP + kc0 * 8) = sk0; *(u32x4*)(kd + kr1 * KP + kc1 * 8) = sk1; *(u32x4*)(kd + kr2 * KP + kc2 * 8) = sk2; \
    *(u32x4*)(vd + vr0 * VP + vc0 * 8) = sv0; *(u32x4*)(vd + vr1 * VP + vc0 * 8) = sv1; }
#define ATT_COMPUTE(kt, buf) if ((kt) <= cq) { \
      const ushort_t* Ks = Kb + (buf) * 64 * KP; \
      f32x16 st[2]; st[0] = negm; st[1] = negm; \
      bf16x8 kf[12]; \
      _Pragma("unroll") for (int s = 0; s < 6; ++s) { \
        _Pragma("unroll") for (int kb = 0; kb < 2; ++kb) kf[2 * s + kb] = *(const bf16x8*)(Ks + (32 * kb + r) * KP + 16 * s + 8 * h); } \
      __builtin_amdgcn_sched_barrier(0); \
      __builtin_amdgcn_s_setprio(1); \
      _Pragma("unroll") for (int s = 0; s < 6; ++s) { \
        _Pragma("unroll") for (int kb = 0; kb < 2; ++kb) st[kb] = MFMA(kf[2 * s + kb], qf[s], st[kb]); } \
      __builtin_amdgcn_s_setprio(0); \
      if ((kt) == 0) { \
        _Pragma("unroll") for (int kb = 0; kb < 2; ++kb) \
          _Pragma("unroll") for (int i = 0; i < 16; ++i) if (32 * kb + crow(i, h) < POFF) st[kb][i] = -1e30f; } \
      softmax_pv<2>(st, o, m, l, negm, (kt) == 0, Vb + (buf) * 64 * VP, VP, 0, lane); }
  __syncthreads();
  ATT_GLOAD0(0);
  ATT_GLOAD1(1);
  ATT_LSTORE0(0);
  const int lastt = ntile - 1;
  ATT_GLOAD0(min(2, lastt));
  __syncthreads();
  for (int kt = 0; kt < ntile; kt += 2) {
    ATT_COMPUTE(kt, 0);
    ATT_LSTORE1(1);
    ATT_GLOAD1(min(kt + 3, lastt));
    __syncthreads();
    ATT_COMPUTE(kt + 1, 1);
    ATT_LSTORE0(0);
    ATT_GLOAD0(min(kt + 4, lastt));
    __syncthreads();
  }
#undef ATT_GLOAD0
#undef ATT_GLOAD1
#undef ATT_LSTORE0
#undef ATT_LSTORE1
#undef ATT_COMPUTE
  const float inv = 1.f / swap_sum(l);
#pragma unroll
  for (int db = 0; db < 2; ++db)
#pragma unroll
    for (int g = 0; g < 4; ++g)
      *(uint2*)(MIX + (size_t)qrow * 1024 + head * 64 + 32 * db + 8 * g + 4 * h) =
          make_uint2(pk2(o[db][4 * g] * inv, o[db][4 * g + 1] * inv), pk2(o[db][4 * g + 2] * inv, o[db][4 * g + 3] * inv));
}

DI void attn_sample(const Params& P, int l, int b, int sp, int hg, char* smem) {
  const ushort_t* QF = (const ushort_t*)(P.ws + O_QF); const ushort_t* QL = (const ushort_t*)(P.ws + O_QL);
  const ushort_t* CKV = (const ushort_t*)(P.ws + O_CKV); const ushort_t* KPE = (const ushort_t*)(P.ws + O_KPE);
  float* PO = (float*)(P.ws + O_PO); float* PML = (float*)(P.ws + O_PML);
  constexpr int KP = 296;
  ushort_t* Qs = (ushort_t*)smem;
  ushort_t* Kt = Qs + 64 * KP;
  const int tid = get_tid(), lane = tid & 63, wave = tid >> 6, r = lane & 31, h = lane >> 5;
  const int qb = wave & 1, dvh = wave >> 1;
  __syncthreads();
#pragma unroll
  for (int i = 0; i < 9; ++i) {
    const int c = tid + 256 * i, q = c / 36, cc = c % 36;
    const int hh = q >> 4, tok = q & 15, head = 4 * hg + hh, srow = 16 * b + tok;
    uint4 v;
    if (cc < 32) v = *(const uint4*)(QL + (size_t)srow * 2048 + head * 256 + cc * 8);
    else v = *(const uint4*)(QF + (size_t)(SOFF + srow) * 768 + head * 96 + 64 + (cc - 32) * 8);
    *(uint4*)(Qs + q * KP + cc * 8) = v;
  }
  f32x16 o[4]; o[0] = zero16(); o[1] = zero16(); o[2] = zero16(); o[3] = zero16();
  float m = -1e30f, lsum = 0.f;
  const int nt = (sp == 7) ? 9 : 8;
  const float* clat = P.cache_lat + (((size_t)l * 32 + b) * PAST + (size_t)sp * 512) * 256;
  const float* cpe = P.cache_pe + (((size_t)l * 32 + b) * PAST + (size_t)sp * 512) * 32;
  for (int ti = 0; ti < nt; ++ti) {
    __syncthreads();
    if (ti < 8) {
      const float* lat = clat + (size_t)ti * 64 * 256;
#pragma unroll
      for (int bt = 0; bt < 4; ++bt) {
        float4 t[4];
#pragma unroll
        for (int i = 0; i < 4; ++i) t[i] = *(const float4*)(lat + (size_t)(tid + 256 * (4 * bt + i)) * 4);
#pragma unroll
        for (int i = 0; i < 4; ++i) {
          const int c = tid + 256 * (4 * bt + i), row = c >> 6, c4 = (c & 63) * 4;
          *(uint2*)(Kt + row * KP + c4) = make_uint2(pk2(t[i].x, t[i].y), pk2(t[i].z, t[i].w));
        }
      }
      const float* pe = cpe + (size_t)ti * 64 * 32;
#pragma unroll
      for (int i = 0; i < 2; ++i) {
        const int c = tid + 256 * i, row = c >> 3, c4 = (c & 7) * 4;
        const float4 t = *(const float4*)(pe + (size_t)c * 4);
        *(uint2*)(Kt + row * KP + 256 + c4) = make_uint2(pk2(t.x, t.y), pk2(t.z, t.w));
      }
    } else {
#pragma unroll
      for (int i = 0; i < 9; ++i) {
        const int c = tid + 256 * i, row = c / 36, cc = c % 36;
        uint4 v = make_uint4(0u, 0u, 0u, 0u);
        if (row < 16) {
          if (cc < 32) v = *(const uint4*)(CKV + (size_t)(SOFF + 16 * b + row) * 256 + cc * 8);
          else v = *(const uint4*)(KPE + (size_t)(SOFF + 16 * b + row) * 32 + (cc - 32) * 8);
        }
        *(uint4*)(Kt + row * KP + cc * 8) = v;
      }
    }
    __syncthreads();
    f32x16 st[2]; st[0] = zero16(); st[1] = zero16();
#pragma unroll
    for (int s = 0; s < 18; ++s) {
      const bf16x8 qv = *(const bf16x8*)(Qs + (32 * qb + r) * KP + 16 * s + 8 * h);
#pragma unroll
      for (int kb = 0; kb < 2; ++kb) st[kb] = MFMA(*(const bf16x8*)(Kt + (32 * kb + r) * KP + 16 * s + 8 * h), qv, st[kb]);
    }
    if (ti == 8) {
#pragma unroll
      for (int kb = 0; kb < 2; ++kb)
#pragma unroll
        for (int i = 0; i < 16; ++i) if (32 * kb + crow(i, h) >= 16) st[kb][i] = -1e30f;
    }
    softmax_pv_simple<4>(st, o, m, lsum, Kt, KP, 128 * dvh, lane);
  }
  const float lt = swap_sum(lsum);
  const int gq = 64 * hg + 32 * qb + r;
  const size_t pbase = ((size_t)(b * 8 + sp) * 128 + gq);
  if (dvh == 0 && h == 0) { PML[pbase * 2] = m; PML[pbase * 2 + 1] = lt; }
#pragma unroll
  for (int db = 0; db < 4; ++db)
#pragma unroll
    for (int g = 0; g < 4; ++g)
      *(float4*)(PO + pbase * 256 + 128 * dvh + 32 * db + 8 * g + 4 * h) = make_float4(o[db][4 * g], o[db][4 * g + 1], o[db][4 * g + 2], o[db][4 * g + 3]);
}


DI bool tile_swz(int t, int MT, int NT, int& mt, int& nt) {
  const int G = gridDim.x, b = blockIdx.x;
  int u = t;
  if ((G & 7) == 0) u = (t / G) * G + (b & 7) * (G >> 3) + (b >> 3);
  if (u >= MT * NT) return false;
  const int full = (NT >> 3) * MT * 8;
  if (u < full) { const int g = u / (MT * 8), rem = u % (MT * 8); mt = rem >> 3; nt = g * 8 + (rem & 7); }
  else { const int rem = u - full, w = NT & 7; mt = rem / w; nt = (NT >> 3) * 8 + rem % w; }
  return true;
}
DI int round_up_grid(int n) { const int G = gridDim.x; return ((n + G - 1) / G) * G; }

DI void phase_g1(const Params& P, int l, char* smem) {
  const ushort_t* Wl = (const ushort_t*)(P.ws + O_W) + (size_t)l * E_WL;
  for (int t = blockIdx.x; t < round_up_grid(133 * 11); t += gridDim.x) {
    int mt, nt; if (!tile_swz(t, 133, 11, mt, nt)) continue;
    gemm_tile_w((const ushort_t*)(P.ws + O_XN), 1024, Wl + E_WT_IN, 1024, 1024, mt * 128, nt * 256, smem, EpiBF16{(ushort_t*)(P.ws + O_PROJ), INP, 1.f});
  }
}

DI void phase_mid(const Params& P, int l, char* smem, int flags) {
  const ushort_t* Wl = (const ushort_t*)(P.ws + O_W) + (size_t)l * E_WL;
  const ushort_t* CQN = (const ushort_t*)(P.ws + O_CQN);
  constexpr int N_G2 = 133 * 6, N_G2S = 4 * 16, N_G3 = 129 * 8, N_PREP = NITEM, N_GS = 128;
  constexpr int TOT = N_G2 + N_G2S + N_G3 + N_PREP + N_GS;
  for (int t0 = blockIdx.x; t0 < TOT; t0 += gridDim.x) {
    int t = t0;
    if (t < N_GS) { if (flags == 0 || flags == 5) gdn_sample(P, l, t, smem); continue; }
    t -= N_GS;
    if (t < N_PREP) { if (flags == 0 || flags == 4) gdn_prep(P, t, smem); continue; }
    if (!(flags == 0 || flags == 6)) continue;
    t -= N_PREP;
    if (t < N_G3) { gemm_tile((const ushort_t*)(P.ws + O_CKV), 256, Wl + E_WT_UKV, 256, 256, (t / 8) * 128, (t % 8) * 128, smem, EpiKV{(ushort_t*)(P.ws + O_KF), (ushort_t*)(P.ws + O_VV)}); continue; }
    t -= N_G3;
    if (t < N_G2) { gemm_tile(CQN, 384, Wl + E_WT_UQ, 384, 384, (t / 6) * 128, (t % 6) * 128, smem, EpiQ{(ushort_t*)(P.ws + O_QF)}); continue; }
    t -= N_G2;
    gemm_tile(CQN, 384, Wl + E_WABS, 384, 384, SOFF + (t / 16) * 128, (t % 16) * 128, smem, EpiBF16{(ushort_t*)(P.ws + O_QL) - (size_t)SOFF * 2048, 2048, QSCALE});
  }
}

DI void phase_mix(const Params& P, int l, char* smem, int flags) {
  int* ctr = (int*)(P.ws + O_CTR) + l * 16;
  volatile int* slot = (volatile int*)(smem + 75776);
  const int myq = (int)(xcc_id_early() & 7u);
  if (threadIdx.x == 0) slot[1] = 0;
  while (true) {
    __syncthreads();
    if (threadIdx.x == 0) {
      int stg = slot[1], code = -1;
      while (stg < 10) {
        if (stg == 0) { const int t = atomicAdd(&ctr[0], 1); if (t < 16) { code = t; break; } stg = 1; }
        else if (stg == 2) { const int t = atomicAdd(&ctr[9], 1); if (t < 512) { code = 16 + 1032 + t; break; } stg = 3; }
        else { const int q = (stg == 1) ? myq : ((myq + stg - 2) & 7); const int t = atomicAdd(&ctr[1 + q], 1); if (t < 129) { code = 16 + (128 - t) * 8 + q; break; } ++stg; }
      }
      slot[1] = stg; slot[0] = code;
    }
    __syncthreads();
    int t = slot[0];
    if (t < 0) break;
    if (t < 16) { if (flags == 0 || flags == 1) gdn_scan(P, l, t, smem); continue; }
    t -= 16;
    if (t < 1032) { if (flags == 0 || flags == 2) attn_prompt(P, t >> 3, t & 7, smem); continue; }
    t -= 1032;
    if (flags == 0 || flags == 3) attn_sample(P, l, t >> 4, (t >> 1) & 7, t & 1, smem);
  }
}

DI void phase_gate(const Params& P, int l, char* smem) {
  const float* OG = (const float*)(P.ws + O_OG); const ushort_t* PROJ = (const ushort_t*)(P.ws + O_PROJ);
  ushort_t* MIX = (ushort_t*)(P.ws + O_MIX); ushort_t* MIXS = (ushort_t*)(P.ws + O_MIXS);
  const float* PO = (const float*)(P.ws + O_PO); const float* PML = (const float*)(P.ws + O_PML);
  const int tid = get_tid(), lane = tid & 63, gw = blockIdx.x * 4 + (tid >> 6), nw = gridDim.x * 4;
  for (int t = blockIdx.x; t < NITEM; t += gridDim.x) gdn_out(P, l, t, smem);
  for (int row = SOFF + gw; row < MTOT; row += nw) {
    const bool valid = row_valid(row);
#pragma unroll
    for (int hd = 0; hd < 4; ++hd) {
      float o0 = 0.f, o1 = 0.f, z0 = 0.f, z1 = 0.f;
      if (valid) {
        o0 = OG[(size_t)row * 512 + hd * 128 + lane]; o1 = OG[(size_t)row * 512 + hd * 128 + 64 + lane];
        z0 = bf2f(PROJ[(size_t)row * INP + OFF_Z + hd * 128 + lane]); z1 = bf2f(PROJ[(size_t)row * INP + OFF_Z + hd * 128 + 64 + lane]);
      }
      const float ss = wave_sum(o0 * o0 + o1 * o1);
      const float rstd = rsqrtf(ss * (1.f / 128.f) + EPS);
      const float v0 = o0 * rstd * P.gdn_norm[l * 128 + lane] * siluf(z0);
      const float v1 = o1 * rstd * P.gdn_norm[l * 128 + 64 + lane] * siluf(z1);
      if (row < SOFF) { MIX[(size_t)row * 1024 + 512 + hd * 128 + lane] = f2bf(v0); MIX[(size_t)row * 1024 + 512 + hd * 128 + 64 + lane] = f2bf(v1); }
      else { MIXS[(size_t)(row - SOFF) * 2560 + 2048 + hd * 128 + lane] = f2bf(v0); MIXS[(size_t)(row - SOFF) * 2560 + 2048 + hd * 128 + 64 + lane] = f2bf(v1); }
    }
  }
  for (int it = gw; it < 32 * 128; it += nw) {
    const int b = it >> 7, gq = it & 127, head = gq >> 4, tok = gq & 15;
    float ms[8], mx = -1e30f;
#pragma unroll
    for (int sp = 0; sp < 8; ++sp) { ms[sp] = PML[((size_t)(b * 8 + sp) * 128 + gq) * 2]; mx = fmaxf(mx, ms[sp]); }
    float L = 0.f; float4 acc = make_float4(0.f, 0.f, 0.f, 0.f);
#pragma unroll
    for (int sp = 0; sp < 8; ++sp) {
      const float w = __builtin_amdgcn_exp2f(ms[sp] - mx);
      L += w * PML[((size_t)(b * 8 + sp) * 128 + gq) * 2 + 1];
      const float4 t = *(const float4*)(PO + ((size_t)(b * 8 + sp) * 128 + gq) * 256 + lane * 4);
      acc.x += w * t.x; acc.y += w * t.y; acc.z += w * t.z; acc.w += w * t.w;
    }
    const float inv = 1.f / L;
    *(uint2*)(MIXS + (size_t)(16 * b + tok) * 2560 + head * 256 + lane * 4) = make_uint2(pk2(acc.x * inv, acc.y * inv), pk2(acc.z * inv, acc.w * inv));
  }
}

DI void phase_g6(const Params& P, int l, char* smem) {
  const ushort_t* Wl = (const ushort_t*)(P.ws + O_W) + (size_t)l * E_WL;
  ushort_t* OMIX = (ushort_t*)(P.ws + O_OMIX);
  for (int t = blockIdx.x; t < round_up_grid(133 * 16); t += gridDim.x) {
    int mt, n2; if (!tile_swz(t, 133, 16, mt, n2)) continue;
    const int nt = n2 >> 1, ks = n2 & 1;
    ushort_t* dst = OMIX + (size_t)ks * MTOT * 1024;
    if (mt < 129) gemm_tile((const ushort_t*)(P.ws + O_MIX) + ks * 512, 1024, Wl + E_WT_O + ks * 512, 1024, 512, mt * 128, nt * 128, smem, EpiBF16{dst, 1024, 1.f});
    else gemm_tile((const ushort_t*)(P.ws + O_MIXS) - (size_t)SOFF * 2560 + ks * 1280, 2560, Wl + E_WT_OS + ks * 1280, 2560, 1280, mt * 128, nt * 128, smem, EpiBF16{dst, 1024, 1.f});
  }
}

DI void phase_resid(const Params& P, const float* w1, const float* w2, bool final_out, bool first) {
  const ushort_t* __restrict__ OMIX = (const ushort_t*)(P.ws + O_OMIX);
  const ushort_t* __restrict__ X = (const ushort_t*)(P.ws + (first ? O_X : O_X2)); ushort_t* XO = (ushort_t*)(P.ws + (first ? O_X2 : O_X)); ushort_t* XN = (ushort_t*)(P.ws + O_XN);
  const int tid = get_tid(), lane = tid & 63, gw = blockIdx.x * 4 + (tid >> 6), nw = gridDim.x * 4;
  f32x4v w1v[4], w2v[4];
#pragma unroll
  for (int j = 0; j < 4; ++j) { w1v[j] = *(const f32x4v*)(w1 + 4 * lane + 256 * j); w2v[j] = *(const f32x4v*)(w2 + 4 * lane + 256 * j); }
  constexpr int NR = 3;
  for (int row0 = gw; row0 < MTOT; row0 += NR * nw) {
    uint2 ta[NR][4], tb[NR][4], xv[NR][4];
#pragma unroll
    for (int rr = 0; rr < NR; ++rr) {
      const int row = min(row0 + rr * nw, MTOT - 1);
#pragma unroll
      for (int j = 0; j < 4; ++j) {
        ta[rr][j] = *(const uint2*)(OMIX + (size_t)row * 1024 + 4 * lane + 256 * j);
        tb[rr][j] = *(const uint2*)(OMIX + (size_t)MTOT * 1024 + (size_t)row * 1024 + 4 * lane + 256 * j);
        xv[rr][j] = *(const uint2*)(X + (size_t)row * 1024 + 4 * lane + 256 * j);
      }
    }
#pragma unroll
    for (int rr = 0; rr < NR; ++rr) {
      const int row = row0 + rr * nw;
      if (row >= MTOT) break;
      const bool valid = row_valid(row);
      float v[16], ss = 0.f;
#pragma unroll
      for (int j = 0; j < 4; ++j) {
        v[4 * j] = bflo(ta[rr][j].x) + bflo(tb[rr][j].x); v[4 * j + 1] = bfhi(ta[rr][j].x) + bfhi(tb[rr][j].x);
        v[4 * j + 2] = bflo(ta[rr][j].y) + bflo(tb[rr][j].y); v[4 * j + 3] = bfhi(ta[rr][j].y) + bfhi(tb[rr][j].y);
      }
#pragma unroll
      for (int i = 0; i < 16; ++i) { v[i] = valid ? v[i] : 0.f; ss += v[i] * v[i]; }
      ss = wave_sum(ss);
      const float rstd = rsqrtf(ss * (1.f / 1024.f) + EPS);
      float s2 = 0.f;
#pragma unroll
      for (int j = 0; j < 4; ++j) {
        v[4 * j] = bflo(xv[rr][j].x) + v[4 * j] * rstd * w1v[j].x; v[4 * j + 1] = bfhi(xv[rr][j].x) + v[4 * j + 1] * rstd * w1v[j].y;
        v[4 * j + 2] = bflo(xv[rr][j].y) + v[4 * j + 2] * rstd * w1v[j].z; v[4 * j + 3] = bfhi(xv[rr][j].y) + v[4 * j + 3] * rstd * w1v[j].w;
      }
#pragma unroll
      for (int i = 0; i < 16; ++i) { v[i] = valid ? v[i] : 0.f; s2 += v[i] * v[i]; }
      if (final_out) {
        if (valid) {
          float* dst = nullptr;
          if (row >= SOFF) dst = P.out + OUT_YS + (size_t)(row - SOFF) * 1024;
          else if (row >= POFF + 16) dst = P.out + OUT_YP + (size_t)(row - POFF - 16) * 1024;
          if (dst) {
#pragma unroll
            for (int j = 0; j < 4; ++j) *(float4*)(dst + 4 * lane + 256 * j) = make_float4(v[4 * j], v[4 * j + 1], v[4 * j + 2], v[4 * j + 3]);
          }
        }
      } else {
        s2 = wave_sum(s2);
        const float rs2 = rsqrtf(s2 * (1.f / 1024.f) + EPS);
#pragma unroll
        for (int j = 0; j < 4; ++j) {
          const int c = 4 * lane + 256 * j;
          *(uint2*)(XO + (size_t)row * 1024 + c) = make_uint2(pk2(v[4 * j], v[4 * j + 1]), pk2(v[4 * j + 2], v[4 * j + 3]));
          *(uint2*)(XN + (size_t)row * 1024 + c) = make_uint2(pk2(v[4 * j] * rs2 * w2v[j].x, v[4 * j + 1] * rs2 * w2v[j].y), pk2(v[4 * j + 2] * rs2 * w2v[j].z, v[4 * j + 3] * rs2 * w2v[j].w));
        }
      }
    }
  }
}

DI void phase_g7(const Params& P, int l, char* smem) {
  const ushort_t* Wl = (const ushort_t*)(P.ws + O_W) + (size_t)l * E_WL;
  for (int t = blockIdx.x; t < round_up_grid(133 * 22); t += gridDim.x) {
    int mt, nt; if (!tile_swz(t, 133, 22, mt, nt)) continue;
    gemm_tile_w((const ushort_t*)(P.ws + O_XN), 1024, Wl + E_WT_GU, 1024, 1024, mt * 128, nt * 256, smem, EpiSwiGLU{(ushort_t*)(P.ws + O_ACT)});
  }
}
DI void phase_g8(const Params& P, int l, char* smem) {
  const ushort_t* Wl = (const ushort_t*)(P.ws + O_W) + (size_t)l * E_WL;
  for (int t = blockIdx.x; t < round_up_grid(133 * 16); t += gridDim.x) {
    int mt, n2; if (!tile_swz(t, 133, 16, mt, n2)) continue;
    const int nt = n2 >> 1, ks = n2 & 1;
    gemm_tile((const ushort_t*)(P.ws + O_ACT) + ks * 1408, DFF, Wl + E_WT_DOWN + ks * 1408, DFF, 1408, mt * 128, nt * 128, smem,
              EpiBF16{(ushort_t*)(P.ws + O_OMIX) + (size_t)ks * MTOT * 1024, 1024, 1.f});
  }
}

#define XB_TMO      128
#define XB_XCNT(j)  (256  + 64 * (j))
#define XB_XSUB(j)  (1280 + 64 * (j))
#define XB_XGEN(j)  (2304 + 64 * (j))
#define XB_TOP      3328
#define XB_TOPGEN   3392
#define XCD_BAR_WORDS 3456
#define XB_SPIN_CAP (1u << 22)
#define LAS __attribute__((address_space(3)))
DI unsigned xb_ld(unsigned* p) { return __hip_atomic_load(p, __ATOMIC_RELAXED, __HIP_MEMORY_SCOPE_AGENT); }
DI unsigned xb_add(unsigned* p, unsigned v) { return __hip_atomic_fetch_add(p, v, __ATOMIC_RELAXED, __HIP_MEMORY_SCOPE_AGENT); }
DI unsigned xb_xcc_id() { return (unsigned)__builtin_amdgcn_s_getreg((3 << 11) | 20) & 0xFu; }
#define XB_SPIN(cond, bar) do { unsigned _sp = 0; while (cond) { __builtin_amdgcn_s_sleep(1); \
    if ((++_sp & 255u) == 0u) { if (xb_ld(&(bar)[XB_TMO])) break; if (_sp > XB_SPIN_CAP) { atomicAdd(&(bar)[XB_TMO], 1u); break; } } } } while (0)
struct XcdBarrier { unsigned* bar; unsigned x; volatile LAS unsigned* st; };
DI XcdBarrier xcd_barrier_post(unsigned* bar, volatile LAS unsigned* st) {
  XcdBarrier b; b.bar = bar; b.x = xb_xcc_id(); b.st = st;
  if (threadIdx.x == 0) (void)xb_add(&bar[XB_XCNT(b.x)], 1u);
  return b;
}
DI void xcd_barrier_complete(unsigned* bar, unsigned x, unsigned& nloc, unsigned& nx) {
  const unsigned G = gridDim.x * gridDim.y * gridDim.z;
  unsigned sum, cnt, mine, sp = 0u;
  for (;;) {
    sum = 0u; cnt = 0u; mine = 0u;
#pragma unroll
    for (unsigned j = 0; j < 16; ++j) { const unsigned c = xb_ld(&bar[XB_XCNT(j)]); sum += c; cnt += (c > 0u) ? 1u : 0u; mine = (j == x) ? c : mine; }
    if (sum == G) break;
    __builtin_amdgcn_s_sleep(1);
    if ((++sp & 255u) == 0u) { if (xb_ld(&bar[XB_TMO])) break; if (sp > XB_SPIN_CAP) { atomicAdd(&bar[XB_TMO], 1u); break; } }
  }
  nloc = mine > 0u ? mine : 1u; nx = cnt > 0u ? cnt : 1u;
}
DI void xcd_barrier(const XcdBarrier& b) {
  asm volatile("s_waitcnt vmcnt(0)" ::: "memory");
  __syncthreads();
  if (threadIdx.x == 0) {
    unsigned* bar = b.bar;
    __builtin_amdgcn_s_waitcnt(0);
    unsigned nloc = b.st[0], nx = b.st[1];
    if (nloc == 0u) { xcd_barrier_complete(bar, b.x, nloc, nx); b.st[0] = nloc; b.st[1] = nx; }
    const unsigned old = xb_add(&bar[XB_XSUB(b.x)], 1u);
    const unsigned gen = old / nloc;
    if (old + 1u == (gen + 1u) * nloc) {
      __builtin_amdgcn_fence(__ATOMIC_RELEASE, "agent");
      asm volatile("s_waitcnt vmcnt(0)" ::: "memory");
      const unsigned og = xb_add(&bar[XB_TOP], 1u);
      const unsigned tg = og / nx;
      if (og + 1u == (tg + 1u) * nx) xb_add(&bar[XB_TOPGEN], 1u);
      else XB_SPIN(xb_ld(&bar[XB_TOPGEN]) == tg, bar);
      __builtin_amdgcn_fence(__ATOMIC_ACQUIRE, "agent");
      xb_add(&bar[XB_XGEN(b.x)], 1u);
      asm volatile("s_waitcnt vmcnt(0)" ::: "memory");
    } else {
      XB_SPIN(xb_ld(&bar[XB_XGEN(b.x)]) == gen, bar);
      __builtin_amdgcn_fence(__ATOMIC_ACQUIRE, "agent");
      asm volatile("s_waitcnt vmcnt(0)" ::: "memory");
    }
  }
  __syncthreads();
}

constexpr int NPHASE = 2 + 10 * DEPTH;

DI void run_phase(const Params& P, int ph, char* smem, int flags) {
  if (ph == 0) { phase_prep0(P, smem); return; }
  if (ph == 1) { phase_prep1(P, smem); return; }
  const int l = (ph - 2) / 10, sub = (ph - 2) % 10;
  switch (sub) {
    case 0: phase_g1(P, l, smem); break;
    case 1: phase_rowpass(P, l); break;
    case 2: phase_mid(P, l, smem, flags); break;
    case 3: phase_mix(P, l, smem, flags); break;
    case 4: phase_gate(P, l, smem); break;
    case 5: phase_g6(P, l, smem); break;
    case 6: phase_resid(P, P.post_mix + l * 1024, P.pre_ffn + l * 1024, false, true); break;
    case 7: phase_g7(P, l, smem); break;
    case 8: phase_g8(P, l, smem); break;
    default: phase_resid(P, P.post_ffn + l * 1024, P.pre_mix + (l < 3 ? l + 1 : 0) * 1024, l == 3, false); break;
  }
}

template <bool COOP>
__global__ void __launch_bounds__(256, 2) mega_kernel(Params P, int ph0, int ph1, int flags) {
  __shared__ __attribute__((aligned(16))) char smem[SMEM_BYTES];
  if (COOP) {
    __shared__ uint4 xb_words;
    if (threadIdx.x == 0) xb_words = make_uint4(0u, 0u, 0u, 0u);
    __syncthreads();
    XcdBarrier xb = xcd_barrier_post((unsigned*)(P.ws + O_BAR), (volatile LAS unsigned*)&xb_words);
    for (int ph = ph0; ph < ph1; ++ph) {
      run_phase(P, ph, smem, flags);
      if (ph + 1 < ph1) {
        if (flags == 0x7fffffff) cg::this_grid().sync();
        xcd_barrier(xb);
      }
    }
  } else {
    for (int ph = ph0; ph < ph1; ++ph) run_phase(P, ph, smem, flags);
  }
}

extern "C" void kernel_launch(void* const* d_in, const int* in_sizes, int n_in, void* d_out, int out_size, void* d_ws,
                              size_t ws_size, hipStream_t stream) {
  Params P{};
  const float** pp = (const float**)&P;
  for (int i = 0; i < 25; ++i) pp[i] = (const float*)d_in[i];
  P.out = (float*)d_out;
  P.ws = (char*)d_ws;
  if (ws_size < O_END) { fprintf(stderr, "workspace too small: %zu < %zu\n", ws_size, (size_t)O_END); return; }
#if ONE_LAUNCH
  static int grid_blocks = 0;
  if (!grid_blocks) {
    int dev = 0, cus = 0, per_cu = 0;
    hipGetDevice(&dev);
    hipDeviceGetAttribute(&cus, hipDeviceAttributeMultiprocessorCount, dev);
    hipOccupancyMaxActiveBlocksPerMultiprocessor(&per_cu, mega_kernel<true>, 256, 0);
    if (per_cu > 2) per_cu = 2;
    grid_blocks = cus * per_cu;
  }
  hipMemsetAsync((char*)d_ws + O_BAR, 0, XCD_BAR_WORDS * 4, stream);
  int ph0 = 0, ph1 = NPHASE, flags = 0;
  void* args[] = {&P, &ph0, &ph1, &flags};
  hipError_t e = hipLaunchCooperativeKernel((void*)mega_kernel<true>, dim3(grid_blocks), dim3(256), args, 0, stream);
  if (e != hipSuccess) fprintf(stderr, "cooperative launch failed: %s (grid %d)\n", hipGetErrorString(e), grid_blocks);
#else
  for (int ph = 0; ph < NPHASE; ++ph) {
    mega_kernel<false><<<512, 256, 0, stream>>>(P, ph, ph + 1, 0);
    if ((ph >= 2 && ((PROBE_MASK >> ((ph - 2) % 10)) & 1)) || (ph < 2 && ((PROBE_MASK >> (10 + ph)) & 1))) {
      if (ph >= 2 && (ph - 2) % 10 == 3) hipMemsetAsync((char*)d_ws + O_CTR, 0, 256, stream);
      mega_kernel<false><<<512, 256, 0, stream>>>(P, ph, ph + 1, PROBE_FLAGS);
    }
  }
#endif
}
```
